# Optimizing an MI355X kernel written in HIP

```python
import math
import jax, jax.numpy as jnp
from jax import lax
import numpy as np

D_MODEL = 1024
BATCH = 16
SEQ = 2048
DEPTH = 1

HEAD_DIM = 64
POOL_WINDOWS = (2, 4, 8, 16)
POOL_GROUP = 64
POOL_WIDTH = POOL_GROUP * len(POOL_WINDOWS)
ATTN_CONFIGS = ((128, 1), (512, 4), (2048, 16))
HEADS_PER_GROUP = 4
N_ATTN_HEADS = HEADS_PER_GROUP * len(ATTN_CONFIGS)
ATTN_WIDTH = N_ATTN_HEADS * HEAD_DIM
MIX_WIDTH = POOL_WIDTH + ATTN_WIDTH
IN_PROJ_WIDTH = POOL_WIDTH + 3 * ATTN_WIDTH
ATTN_BLOCK = 64
PEER_HEADS = 8
PEER_N_KEYS = 128
PEER_N_EXPERTS = PEER_N_KEYS * PEER_N_KEYS
PEER_HALF = 128
PEER_QUERY_DIM = 2 * PEER_HALF
PEER_TOPK = 16
PEER_CHUNK = 128
RMS_EPS = 1e-6
NEG_INF = -1e30

kernel_name = "hybrid_pool_dilated_alibi_peer_block"


def rms_norm(x, g):
    xf = x.astype(jnp.float32)
    y = xf * lax.rsqrt(jnp.mean(xf * xf, axis=-1, keepdims=True) + RMS_EPS)
    return (y * g.astype(jnp.float32)).astype(x.dtype)


def alibi_slopes():
    return jnp.asarray(2.0 ** (-8.0 * np.arange(1, N_ATTN_HEADS + 1) / N_ATTN_HEADS), dtype=jnp.float32)


def multiscale_pool(p, w_pool, pool_scale):
    B, S, C = p.shape
    pf = p.astype(jnp.float32)
    csum = jnp.concatenate([jnp.zeros((B, 1, C), jnp.float32), jnp.cumsum(pf, axis=1)], axis=1)
    pos = jnp.arange(S)
    outs = []
    for gi, w in enumerate(POOL_WINDOWS):
        sl = slice(gi * POOL_GROUP, (gi + 1) * POOL_GROUP)
        lo = jnp.clip(pos - w // 2, 0, S)
        hi = jnp.clip(pos + w // 2, 0, S)
        cg = csum[..., sl]
        mean = (cg[:, hi] - cg[:, lo]) / (hi - lo).astype(jnp.float32)[None, :, None]
        outs.append(mean - pf[..., sl])
    pooled = jnp.stack(outs, axis=2)
    mixed = jnp.einsum('bsgc,gcd->bsgd', pooled, w_pool.astype(jnp.float32))
    return (mixed.reshape(B, S, C) * pool_scale.astype(jnp.float32)).astype(p.dtype)


def dilated_window_attention(q, k, v, window, dilation, slopes):
    B, S, H, Dh = q.shape
    L = S // dilation
    half = window // (2 * dilation)
    nb = -(-L // ATTN_BLOCK)
    Lp = nb * ATTN_BLOCK

    def to_sub(t):
        return t.reshape(B, L, dilation, H, Dh).transpose(0, 2, 1, 3, 4)

    qs = jnp.pad(to_sub(q), ((0, 0), (0, 0), (0, Lp - L), (0, 0), (0, 0)))
    qb = qs.reshape(B, dilation, nb, ATTN_BLOCK, H, Dh)

    def key_blocks(t):
        ts = jnp.pad(to_sub(t), ((0, 0), (0, 0), (ATTN_BLOCK, Lp - L + ATTN_BLOCK), (0, 0), (0, 0)))
        ts = ts.reshape(B, dilation, nb + 2, ATTN_BLOCK, H, Dh)
        return jnp.concatenate([ts[:, :, :-2], ts[:, :, 1:-1], ts[:, :, 2:]], axis=3)

    kb = key_blocks(k)
    vb = key_blocks(v)

    scale = 1.0 / math.sqrt(Dh)
    scores = jnp.einsum('brnqhc,brnkhc->brnhqk', qb.astype(jnp.float32), kb.astype(jnp.float32)) * scale
    qi = jnp.arange(nb)[:, None] * ATTN_BLOCK + jnp.arange(ATTN_BLOCK)[None, :]
    kj = jnp.arange(nb)[:, None] * ATTN_BLOCK - ATTN_BLOCK + jnp.arange(3 * ATTN_BLOCK)[None, :]
    rel = kj[:, None, :] - qi[:, :, None]
    valid = (jnp.abs(rel) <= half) & (kj[:, None, :] >= 0) & (kj[:, None, :] < L)
    dist = (dilation * jnp.abs(rel)).astype(jnp.float32)
    bias = -slopes[None, :, None, None] * dist[:, None]
    scores = jnp.where(valid[:, None], scores + bias, NEG_INF)
    m = jnp.max(scores, axis=-1, keepdims=True)
    pexp = jnp.exp(scores - m)
    den = jnp.sum(pexp, axis=-1, keepdims=True)
    lse = (m + jnp.log(den))[..., 0]
    o = jnp.einsum('brnhqk,brnkhc->brnqhc', (pexp / den).astype(v.dtype), vb)
    o = o.reshape(B, dilation, Lp, H, Dh)[:, :, :L].transpose(0, 2, 1, 3, 4).reshape(B, S, H, Dh)
    lse = lse.transpose(0, 1, 2, 4, 3).reshape(B, dilation, Lp, H)[:, :, :L]
    lse = lse.transpose(0, 2, 1, 3).reshape(B, S, H)
    return o, lse


def peer_ffn(h, w_q, subkeys, u, v):
    B, S, D = h.shape
    n_chunks = (B * S) // PEER_CHUNK
    hc = h.reshape(n_chunks, PEER_CHUNK, D)

    def chunk(ht):
        q = (ht @ w_q).reshape(PEER_CHUNK, PEER_HEADS, 2, PEER_HALF)
        s = jnp.einsum('thpc,hpnc->thpn', q.astype(jnp.float32), subkeys.astype(jnp.float32))
        sv, si = lax.top_k(s, PEER_TOPK)
        cand_s = sv[:, :, 0, :, None] + sv[:, :, 1, None, :]
        cand_i = si[:, :, 0, :, None] * PEER_N_KEYS + si[:, :, 1, None, :]
        cand_s = cand_s.reshape(PEER_CHUNK, PEER_HEADS, PEER_TOPK * PEER_TOPK)
        cand_i = cand_i.reshape(PEER_CHUNK, PEER_HEADS, PEER_TOPK * PEER_TOPK)
        top_s, top_pos = lax.top_k(cand_s, PEER_TOPK)
        expert = jnp.take_along_axis(cand_i, top_pos, axis=-1)
        gate = jax.nn.softmax(top_s, axis=-1)
        ue = u[expert]
        ve = v[expert]
        act = jax.nn.gelu(jnp.einsum('thkd,td->thk', ue, ht).astype(jnp.float32), approximate=False)
        return jnp.einsum('thk,thkd->td', (gate * act).astype(ht.dtype), ve)

    return lax.map(chunk, hc).reshape(B, S, D)


def setup_inputs(seed: int = 0) -> dict:
    key = jax.random.key(seed)
    ks = jax.random.split(key, 12)
    f32 = jnp.float32
    x = jax.random.normal(ks[0], (BATCH, SEQ, D_MODEL), f32)
    g_mix = 1.0 + 0.02 * jax.random.normal(ks[1], (DEPTH, D_MODEL), f32)
    w_in = jax.random.normal(ks[2], (DEPTH, D_MODEL, IN_PROJ_WIDTH), f32) * D_MODEL ** -0.5
    w_pool = jax.random.normal(ks[3], (DEPTH, len(POOL_WINDOWS), POOL_GROUP, POOL_GROUP), f32) * POOL_GROUP ** -0.5
    pool_scale = 1.0 + 0.02 * jax.random.normal(ks[4], (DEPTH, POOL_WIDTH), f32)
    w_out = jax.random.normal(ks[5], (DEPTH, MIX_WIDTH, D_MODEL), f32) * MIX_WIDTH ** -0.5
    g_ffn = 1.0 + 0.02 * jax.random.normal(ks[6], (DEPTH, D_MODEL), f32)
    w_peer_q = jax.random.normal(ks[7], (DEPTH, D_MODEL, PEER_HEADS * PEER_QUERY_DIM), f32) * D_MODEL ** -0.5
    peer_subkeys = jax.random.normal(ks[8], (DEPTH, PEER_HEADS, 2, PEER_N_KEYS, PEER_HALF), f32) * PEER_HALF ** -0.5
    peer_u = jax.random.normal(ks[9], (DEPTH, PEER_N_EXPERTS, D_MODEL), f32) * D_MODEL ** -0.5
    peer_v = jax.random.normal(ks[10], (DEPTH, PEER_N_EXPERTS, D_MODEL), f32) * PEER_HEADS ** -0.5
    g_final = 1.0 + 0.02 * jax.random.normal(ks[11], (D_MODEL,), f32)
    return {"x": x, "g_mix": g_mix, "w_in": w_in, "w_pool": w_pool, "pool_scale": pool_scale,
            "w_out": w_out, "g_ffn": g_ffn, "w_peer_q": w_peer_q, "peer_subkeys": peer_subkeys,
            "peer_u": peer_u, "peer_v": peer_v, "g_final": g_final}


def reference(x, g_mix, w_in, w_pool, pool_scale, w_out, g_ffn, w_peer_q, peer_subkeys,
              peer_u, peer_v, g_final):
    B, S, D = x.shape
    slopes = alibi_slopes()
    for layer in range(DEPTH):
        h = rms_norm(x, g_mix[layer])
        proj = h @ w_in[layer]
        p = proj[..., :POOL_WIDTH]
        q = proj[..., POOL_WIDTH:POOL_WIDTH + ATTN_WIDTH].reshape(B, S, N_ATTN_HEADS, HEAD_DIM)
        k = proj[..., POOL_WIDTH + ATTN_WIDTH:POOL_WIDTH + 2 * ATTN_WIDTH].reshape(B, S, N_ATTN_HEADS, HEAD_DIM)
        v = proj[..., POOL_WIDTH + 2 * ATTN_WIDTH:].reshape(B, S, N_ATTN_HEADS, HEAD_DIM)

        pool_out = multiscale_pool(p, w_pool[layer], pool_scale[layer])

        outs, lses = [], []
        for gi, (window, dilation) in enumerate(ATTN_CONFIGS):
            hs = slice(gi * HEADS_PER_GROUP, (gi + 1) * HEADS_PER_GROUP)
            o, lse = dilated_window_attention(q[:, :, hs], k[:, :, hs], v[:, :, hs],
                                              window, dilation, slopes[hs])
            outs.append(o)
            lses.append(lse)
        alpha = jax.nn.softmax(jnp.stack(lses, axis=2), axis=2)
        attn = (jnp.stack(outs, axis=2).astype(jnp.float32) * alpha[..., None]).astype(x.dtype)
        attn = attn.reshape(B, S, ATTN_WIDTH)

        mixed = jnp.concatenate([pool_out, attn], axis=-1) @ w_out[layer]
        x = x + mixed

        x = x + peer_ffn(rms_norm(x, g_ffn[layer]), w_peer_q[layer], peer_subkeys[layer],
                         peer_u[layer], peer_v[layer])
    return rms_norm(x, g_final)
```

```cpp
#include <hip/hip_runtime.h>
#include <cstdio>
#include <cstdint>
__device__ __forceinline__ int lane_now() { int l; asm volatile("v_mbcnt_lo_u32_b32 %0, -1, 0\n\tv_mbcnt_hi_u32_b32 %0, -1, %0" : "=v"(l)); return l; }
namespace pg8 {
#define PG8_LAS __attribute__((address_space(3)))
typedef unsigned short bf16_t;
typedef short bf16x8 __attribute__((ext_vector_type(8)));
typedef float f32x4 __attribute__((ext_vector_type(4)));
typedef unsigned u32x4 __attribute__((ext_vector_type(4)));
typedef int i32x4 __attribute__((ext_vector_type(4)));
constexpr int BM = 256, BK = 64, HALF = 128, HTB = HALF * BK * 2  , STAGE_BYTES = 8 * HTB, NXCD = 8, WGM = 8;

__host__ __device__ __forceinline__ int lds_byte(int r, int c) { const int st = (r >> 4) * 2 + (c >> 5), rr = r & 15, cc = c & 31, ob = rr * 64 + cc * 2; return st * 1024 + (ob ^ (((ob >> 9) & 1) << 5)); }
__host__ __device__ __forceinline__ void stage_rc(int b, int& R, int& C) { const int st = b / 1024, sb = b % 1024, swz = sb ^ (((sb >> 9) & 1) << 5); R = (st >> 1) * 16 + swz / 64; C = (st & 1) * 32 + (swz % 64) / 2; }
__host__ __device__ __forceinline__ int perm32(int rho) { const int n = rho >> 4, i = rho & 15; return 8 * (i >> 2) + 4 * n + (i & 3); }

struct Unit { int pm, pn; };
struct Gemm { const bf16_t* A; const bf16_t* Bt; int M, N, K; };

struct StaticOrder {
    int nM, nN, nwg, G, c;
    __host__ __device__ void init(int M, int N, int G_, int c_) { nM = M / BM; nN = N / BM; nwg = nM * nN; G = G_; c = c_; }
    __host__ __device__ bool next(int i, Unit& u) const {
        const long L = (long)i * G + c; if (L >= nwg) return false;
        int wgid = (int)L; { const int q = nwg / NXCD, r = nwg % NXCD, xcd = wgid % NXCD, off = wgid / NXCD; wgid = (xcd < r ? xcd * (q + 1) : r * (q + 1) + (xcd - r) * q) + off; }
        const int nig = WGM * nN, gid = wgid / nig, fm = gid * WGM, gsz = (nM - fm) < WGM ? (nM - fm) : WGM;
        u.pm = fm + ((wgid % nig) % gsz); u.pn = (wgid % nig) / gsz; return true;
    }
    __device__ __forceinline__ void a_ready(const Unit&) const {}
    __device__ __forceinline__ void done(const Unit&) const {}
};

__device__ __forceinline__ unsigned cvt_pk_bf16(float lo, float hi) { unsigned r; asm volatile("v_cvt_pk_bf16_f32 %0, %1, %2" : "=v"(r) : "v"(lo), "v"(hi)); return r; }
typedef unsigned u32x2 __attribute__((ext_vector_type(2)));
constexpr float C2Q = 0.125f * 1.4426950408889634f;
struct EpiInProj {
    static constexpr bool PERM = true, AFTER_DRAIN = false;
    bf16_t* P; bf16_t* QKV; size_t ty_stride; const float* sa; const float* sw;
    __device__ __forceinline__ void operator()(const f32x4 (&acc)[2][2][4][2], const Unit& u, int wr, int wc, int fr, int fq) const {
        const int row0 = u.pm * BM + wr * 64 + fr;
        f32x4 swv[2][2];
#pragma unroll
        for (int bj = 0; bj < 2; ++bj)
#pragma unroll
            for (int n = 0; n < 2; ++n) swv[bj][n] = *(const f32x4*)(sw + u.pn * BM + bj * HALF + wc * 32 + 8 * fq + 4 * n);
#define PG8_I2F(x) __builtin_convertvector(__builtin_bit_cast(i32x4, (x)), f32x4)
        if (u.pn == 0) {
#pragma unroll
            for (int ai = 0; ai < 2; ++ai)
#pragma unroll
                for (int m = 0; m < 4; ++m) { bf16_t* rowp = P + (size_t)(row0 + ai * HALF + m * 16) * 256 + wc * 32 + 8 * fq; const float sar = sa[row0 + ai * HALF + m * 16];
#pragma unroll
                    for (int bj = 0; bj < 2; ++bj) { const f32x4 v0 = PG8_I2F(acc[ai][bj][m][0]) * swv[bj][0] * sar, v1 = PG8_I2F(acc[ai][bj][m][1]) * swv[bj][1] * sar;
                        u32x4 w; w.x = cvt_pk_bf16(v0[0], v0[1]); w.y = cvt_pk_bf16(v0[2], v0[3]); w.z = cvt_pk_bf16(v1[0], v1[1]); w.w = cvt_pk_bf16(v1[2], v1[3]);
                        *(u32x4*)(rowp + bj * HALF) = w; } }
        } else {
            const int ty = (u.pn - 1) / 3, g = (u.pn - 1) % 3, sh = 2 * g;
            const float sc = (ty == 0) ? C2Q : 1.f;
            bf16_t* base = QKV + (size_t)ty * ty_stride;
#pragma unroll
            for (int ai = 0; ai < 2; ++ai)
#pragma unroll
                for (int m = 0; m < 4; ++m) { const int row = row0 + ai * HALF + m * 16, b = row >> 11, pos = row & 2047;
                    const int seqp = ((pos & ((1 << sh) - 1)) << (11 - sh)) | (pos >> sh); const float sar = sa[row] * sc;
#pragma unroll
                    for (int bj = 0; bj < 2; ++bj) { const int cl = bj * HALF + wc * 32 + 8 * fq, hd = 4 * g + (cl >> 6), c = cl & 63;
                        const f32x4 v0 = PG8_I2F(acc[ai][bj][m][0]) * swv[bj][0] * sar, v1 = PG8_I2F(acc[ai][bj][m][1]) * swv[bj][1] * sar;
                        u32x4 w; w.x = cvt_pk_bf16(v0[0], v0[1]); w.y = cvt_pk_bf16(v0[2], v0[3]); w.z = cvt_pk_bf16(v1[0], v1[1]); w.w = cvt_pk_bf16(v1[2], v1[3]);
                        *(u32x4*)(base + ((size_t)((b * 12 + hd) * 2048 + seqp)) * 64 + c) = w; } }
        }
#undef PG8_I2F
    }
};
struct EpiOutProj {
    static constexpr bool PERM = true, AFTER_DRAIN = false;
    const float* x; bf16_t* x2b; float* rowss;
    __device__ __forceinline__ void operator()(const f32x4 (&acc)[2][2][4][2], const Unit& u, int wr, int wc, int fr, int fq) const {
        const int col0 = u.pn * BM + wc * 32 + 8 * fq;
#pragma unroll
        for (int ai = 0; ai < 2; ++ai) {
            f32x4 xr[4][2][2];
#pragma unroll
            for (int m = 0; m < 4; ++m)
#pragma unroll
                for (int bj = 0; bj < 2; ++bj) { const size_t o2 = (size_t)(u.pm * BM + ai * HALF + wr * 64 + m * 16 + fr) * 1024 + col0 + bj * HALF;
                    xr[m][bj][0] = *(const f32x4*)(x + o2); xr[m][bj][1] = *(const f32x4*)(x + o2 + 4); }
#pragma unroll
            for (int m = 0; m < 4; ++m) { const int row = u.pm * BM + ai * HALF + wr * 64 + m * 16 + fr; const size_t off = (size_t)row * 1024 + col0; float ss = 0.f;
#pragma unroll
                for (int bj = 0; bj < 2; ++bj) { const size_t o2 = off + bj * HALF;
                    const f32x4 o0 = xr[m][bj][0] + acc[ai][bj][m][0], o1 = xr[m][bj][1] + acc[ai][bj][m][1];
                    ss += ((o0[0] * o0[0] + o0[1] * o0[1]) + (o0[2] * o0[2] + o0[3] * o0[3])) + ((o1[0] * o1[0] + o1[1] * o1[1]) + (o1[2] * o1[2] + o1[3] * o1[3]));
                    u32x4 w; w.x = cvt_pk_bf16(o0[0], o0[1]); w.y = cvt_pk_bf16(o0[2], o0[3]); w.z = cvt_pk_bf16(o1[0], o1[1]); w.w = cvt_pk_bf16(o1[2], o1[3]);
                    *(u32x4*)(x2b + o2) = w; }
                ss += __shfl_xor(ss, 16); ss += __shfl_xor(ss, 32);
                if (fq == 0) atomicAdd(rowss + row, ss); } }
    }
};
struct EpiPeerQ {
    static constexpr bool PERM = true, AFTER_DRAIN = false;
    bf16_t* O; const float* rowss;
    __device__ __forceinline__ void operator()(const f32x4 (&acc)[2][2][4][2], const Unit& u, int wr, int wc, int fr, int fq) const {
        const int row0 = u.pm * BM + wr * 64 + fr, col0 = u.pn * BM + wc * 32 + 8 * fq;
#pragma unroll
        for (int ai = 0; ai < 2; ++ai)
#pragma unroll
            for (int m = 0; m < 4; ++m) { const int row = row0 + ai * HALF + m * 16; const float rs = rsqrtf(rowss[row] * (1.f / 1024.f) + 1e-6f);
                bf16_t* rowp = O + (size_t)row * 2048 + col0;
#pragma unroll
                for (int bj = 0; bj < 2; ++bj) { const f32x4 v0 = acc[ai][bj][m][0] * rs, v1 = acc[ai][bj][m][1] * rs;
                    u32x4 w; w.x = cvt_pk_bf16(v0[0], v0[1]); w.y = cvt_pk_bf16(v0[2], v0[3]); w.z = cvt_pk_bf16(v1[0], v1[1]); w.w = cvt_pk_bf16(v1[2], v1[3]);
                    *(u32x4*)(rowp + bj * HALF) = w; } }
    }
};
template <class Epi, class Sched, bool ALIGN_EPI = false, bool SP2 = false, bool I8 = false>
__device__ __forceinline__ void gemm_phase(PG8_LAS unsigned char* lds, const Gemm g, const Sched& S, const Epi& E, int wid) {
    const int lane = lane_now(), tid = wid * 64 + lane, wr = wid >> 2, wc = wid & 3, fr = lane & 15, fq = lane >> 4;
    const int K = g.K, nt = K / BK;
    unsigned voffA[2], voffB[2];
#pragma unroll
    for (int i = 0; i < 2; ++i) { int R, C; stage_rc(tid * 16 + i * 8192, R, C); const int Rb = Epi::PERM ? ((R & ~31) + perm32(R & 31)) : R;
        voffA[i] = (unsigned)(R * K + C) * 2u; voffB[i] = (unsigned)(Rb * K + C) * 2u; }
    const size_t kstep = (size_t)(BK * 2);
    const size_t hstep = (size_t)HALF * K * 2;
    const size_t tstep = 2 * hstep;
    const unsigned ldsw = (unsigned)wid * 1024u;
    const int aoff = lds_byte(wr * 64 + fr, fq * 8), boff = lds_byte(wc * 32 + fr, fq * 8);
#define PG8_SA(b, h) (((b) * 2 + (h)) * HTB)
#define PG8_SB(b, h) ((4 + (b) * 2 + (h)) * HTB)
#define PG8_STAGE(bufoff, gbase, voff) do { _Pragma("unroll") for (int _i = 0; _i < 2; ++_i) \
        __builtin_amdgcn_global_load_lds((const unsigned*)((const char*)(gbase) + (voff)[_i]), (PG8_LAS unsigned*)(lds + (bufoff) + ldsw + _i * 8192), 16, 0, 0); } while (0)
#define PG8_LDA(dst, b, h) do { _Pragma("unroll") for (int m = 0; m < 4; ++m) _Pragma("unroll") for (int k = 0; k < 2; ++k) dst[m][k] = *(const PG8_LAS bf16x8*)(lds + PG8_SA(b, h) + aoff + m * 2048 + k * 1024); } while (0)
#define PG8_LDB(dst, b, h) do { _Pragma("unroll") for (int n = 0; n < 2; ++n) _Pragma("unroll") for (int k = 0; k < 2; ++k) dst[n][k] = *(const PG8_LAS bf16x8*)(lds + PG8_SB(b, h) + boff + n * 2048 + k * 1024); } while (0)
#define PG8_MMA(ai, bj, At, Bt) do { __builtin_amdgcn_s_setprio(1); _Pragma("unroll") for (int m = 0; m < 4; ++m) _Pragma("unroll") for (int n = 0; n < 2; ++n) _Pragma("unroll") for (int k = 0; k < 2; ++k) \
        { if constexpr (I8) acc[ai][bj][m][n] = __builtin_bit_cast(f32x4, __builtin_amdgcn_mfma_i32_16x16x64_i8(__builtin_bit_cast(i32x4, Bt[n][k]), __builtin_bit_cast(i32x4, At[m][k]), __builtin_bit_cast(i32x4, acc[ai][bj][m][n]), 0, 0, 0)); \
          else acc[ai][bj][m][n] = __builtin_amdgcn_mfma_f32_16x16x32_bf16(Bt[n][k], At[m][k], acc[ai][bj][m][n], 0, 0, 0); } __builtin_amdgcn_s_setprio(0); } while (0)
#define PG8_WAIT_V(n) asm volatile("s_waitcnt vmcnt(" #n ")" ::: "memory")
#define PG8_WAIT_L(n) asm volatile("s_waitcnt lgkmcnt(" #n ")" ::: "memory")
#define PG8_BAR __builtin_amdgcn_s_barrier()
#define PG8_SCHED __builtin_amdgcn_sched_barrier(0)
    Unit cur, nxt; int ui = 0;
    if (!S.next(0, cur)) return;
    f32x4 acc[2][2][4][2];
#pragma unroll
    for (int a = 0; a < 2; ++a)
#pragma unroll
        for (int b = 0; b < 2; ++b)
#pragma unroll
            for (int m = 0; m < 4; ++m)
#pragma unroll
                for (int n = 0; n < 2; ++n) acc[a][b][m][n] = (f32x4){0.f, 0.f, 0.f, 0.f};
    bf16x8 At[4][2], B0[2][2], B1[2][2];
    const char* cA = (const char*)g.A + (size_t)cur.pm * tstep; const char* cB = (const char*)g.Bt + (size_t)cur.pn * tstep;
    S.a_ready(cur);
    if constexpr (SP2) {
        PG8_STAGE(PG8_SB(0, 0), cB, voffB); PG8_STAGE(PG8_SB(0, 1), cB + hstep, voffB); PG8_STAGE(PG8_SA(0, 0), cA, voffA); PG8_STAGE(PG8_SA(0, 1), cA + hstep, voffA);
        if (wr == 1) PG8_BAR;
        PG8_WAIT_V(2); PG8_BAR;
        PG8_STAGE(PG8_SB(1, 0), cB + kstep, voffB); PG8_STAGE(PG8_SA(1, 0), cA + kstep, voffA); PG8_STAGE(PG8_SB(1, 1), cB + hstep + kstep, voffB);
        PG8_WAIT_V(6); PG8_BAR;
    } else {
        PG8_STAGE(PG8_SB(0, 0), cB, voffB); PG8_STAGE(PG8_SA(0, 0), cA, voffA); PG8_STAGE(PG8_SB(0, 1), cB + hstep, voffB); PG8_STAGE(PG8_SA(0, 1), cA + hstep, voffA);
        if (wr == 1) PG8_BAR;
        PG8_WAIT_V(4); PG8_BAR;
        PG8_STAGE(PG8_SB(1, 0), cB + kstep, voffB); PG8_STAGE(PG8_SA(1, 0), cA + kstep, voffA); PG8_STAGE(PG8_SB(1, 1), cB + hstep + kstep, voffB);
        PG8_WAIT_V(6); PG8_BAR;
    }
    for (;;) {
        const bool has_next = S.next(ui + 1, nxt);
        const char* nA = has_next ? (const char*)g.A + (size_t)nxt.pm * tstep : cA; const char* nB = has_next ? (const char*)g.Bt + (size_t)nxt.pn * tstep : cB;
        for (int t = 0; t < nt; t += 2) {
            const bool last = (t == nt - 2);
            const char* a1 = cA + (size_t)(t + 1) * kstep;
            const char* a2 = last ? nA : cA + (size_t)(t + 2) * kstep; const char* b2 = last ? nB : cB + (size_t)(t + 2) * kstep;
            const char* a3 = a2 + kstep; const char* b3 = b2 + kstep;
            if (last && has_next) S.a_ready(nxt);
            if constexpr (SP2) {
            PG8_LDB(B0, 0, 0); PG8_LDB(B1, 0, 1); PG8_SCHED; PG8_LDA(At, 0, 0); PG8_STAGE(PG8_SA(1, 1), a1 + hstep, voffA);
            PG8_WAIT_V(8); PG8_WAIT_L(0); PG8_BAR; PG8_MMA(0, 0, At, B0); PG8_MMA(0, 1, At, B1); PG8_BAR; PG8_SCHED;
            PG8_LDA(At, 0, 1); PG8_STAGE(PG8_SB(0, 0), b2, voffB); PG8_STAGE(PG8_SB(0, 1), b2 + hstep, voffB); PG8_STAGE(PG8_SA(0, 0), a2, voffA);
            PG8_WAIT_V(8); PG8_WAIT_L(0); PG8_BAR; PG8_MMA(1, 0, At, B0); PG8_MMA(1, 1, At, B1); PG8_BAR; PG8_SCHED;
            PG8_LDB(B0, 1, 0); PG8_LDB(B1, 1, 1); PG8_SCHED; PG8_LDA(At, 1, 0); PG8_STAGE(PG8_SA(0, 1), a2 + hstep, voffA);
            PG8_WAIT_V(8); PG8_WAIT_L(0); PG8_BAR; PG8_MMA(0, 0, At, B0); PG8_MMA(0, 1, At, B1); PG8_BAR; PG8_SCHED;
            PG8_LDA(At, 1, 1); PG8_STAGE(PG8_SB(1, 0), b3, voffB); PG8_STAGE(PG8_SB(1, 1), b3 + hstep, voffB); PG8_STAGE(PG8_SA(1, 0), a3, voffA);
            PG8_WAIT_V(8); PG8_WAIT_L(0); PG8_BAR; PG8_MMA(1, 0, At, B0); PG8_MMA(1, 1, At, B1); PG8_BAR; PG8_SCHED;
            } else {
            PG8_LDB(B0, 0, 0); PG8_SCHED; PG8_LDA(At, 0, 0); PG8_STAGE(PG8_SA(1, 1), a1 + hstep, voffA);
            PG8_WAIT_L(8); PG8_BAR; PG8_WAIT_L(0); PG8_MMA(0, 0, At, B0); PG8_BAR; PG8_SCHED;
            PG8_LDB(B1, 0, 1); PG8_STAGE(PG8_SB(0, 0), b2, voffB);
            PG8_BAR; PG8_WAIT_L(0); PG8_MMA(0, 1, At, B1); PG8_BAR;
            PG8_LDA(At, 0, 1); PG8_STAGE(PG8_SA(0, 0), a2, voffA);
            PG8_BAR; PG8_WAIT_L(0); PG8_MMA(1, 0, At, B0); PG8_BAR; PG8_SCHED;
            PG8_STAGE(PG8_SB(0, 1), b2 + hstep, voffB);
            PG8_WAIT_V(6); PG8_BAR; PG8_MMA(1, 1, At, B1); PG8_BAR;
            PG8_LDB(B0, 1, 0); PG8_SCHED; PG8_LDA(At, 1, 0); PG8_STAGE(PG8_SA(0, 1), a2 + hstep, voffA);
            PG8_WAIT_L(8); PG8_BAR; PG8_WAIT_L(0); PG8_MMA(0, 0, At, B0); PG8_BAR; PG8_SCHED;
            PG8_LDB(B1, 1, 1); PG8_STAGE(PG8_SB(1, 0), b3, voffB);
            PG8_BAR; PG8_WAIT_L(0); PG8_MMA(0, 1, At, B1); PG8_BAR;
            PG8_LDA(At, 1, 1); PG8_STAGE(PG8_SA(1, 0), a3, voffA);
            PG8_BAR; PG8_WAIT_L(0); PG8_MMA(1, 0, At, B0); PG8_BAR; PG8_SCHED;
            PG8_STAGE(PG8_SB(1, 1), b3 + hstep, voffB);
            PG8_WAIT_V(6); PG8_BAR; PG8_MMA(1, 1, At, B1); PG8_BAR;
            }
        }
        if constexpr (ALIGN_EPI) { if (wr == 0) PG8_BAR; }
        if constexpr (!Epi::AFTER_DRAIN) { E(acc, cur, wr, wc, fr, fq); S.done(cur); }
        if (!has_next) break;
#pragma unroll
        for (int a = 0; a < 2; ++a)
#pragma unroll
            for (int b = 0; b < 2; ++b)
#pragma unroll
                for (int m = 0; m < 4; ++m)
#pragma unroll
                    for (int n = 0; n < 2; ++n) acc[a][b][m][n] = (f32x4){0.f, 0.f, 0.f, 0.f};
        cur = nxt; cA = nA; cB = nB; ++ui;
        if constexpr (ALIGN_EPI) { if (wr == 1) PG8_BAR; }
    }
    PG8_WAIT_V(0);
    if constexpr (!ALIGN_EPI) { if (wr == 0) PG8_BAR; }
    PG8_BAR;
    if constexpr (Epi::AFTER_DRAIN) { E.fused(acc, cur, wr, wc, fr, fq, lds, wid, lane); S.done(cur); }
#undef PG8_SA
#undef PG8_SB
#undef PG8_STAGE
#undef PG8_LDA
#undef PG8_LDB
#undef PG8_MMA
#undef PG8_WAIT_V
#undef PG8_WAIT_L
#undef PG8_BAR
#undef PG8_SCHED
}
}
constexpr int M = 32768, D = 1024, S = 2048;
constexpr int NPROJ = 2560, NQ = 2048, NEXP = 16384;
typedef unsigned short bf16;
constexpr size_t MiB = 1u << 20;
constexpr size_t WS_CTL = 0, CTL_ZERO_BYTES = 1 * MiB;
constexpr size_t WS_WIN = 2 * MiB, WS_WOUT = 8 * MiB, WS_WQ = 10 * MiB;
constexpr size_t WS_SK = 14 * MiB, WS_WPT = 14 * MiB + 512 * 1024;
constexpr size_t WS_SA = 15 * MiB + 640 * 1024, WS_SWIN = 15 * MiB + 768 * 1024;
constexpr size_t WS_SU = 15 * MiB, WS_SV = 15 * MiB + 64 * 1024, WS_ROWSS = 15 * MiB + 512 * 1024;
constexpr size_t WS_U8 = 16 * MiB, WS_V8 = 32 * MiB;
constexpr size_t WS_XN = 48 * MiB;
constexpr size_t WS_P = 112 * MiB;
constexpr size_t WS_Q = 128 * MiB, WS_K = 176 * MiB, WS_V = 224 * MiB;
constexpr size_t WS_ORAW = 272 * MiB, WS_LSE = 320 * MiB, WS_MIXIN = 322 * MiB, WS_END = 386 * MiB;
constexpr size_t WS_QP = 128 * MiB, WS_IDX = 256 * MiB, WS_GATE = 264 * MiB, WS_X8 = 280 * MiB;
constexpr size_t WS_PROJ = 386 * MiB;
constexpr int CW_BAR = 4096;
constexpr int CW_CMAX = CW_BAR + 2 * 3456, CW_CCNT = CW_CMAX + NPROJ, CW_END = CW_CCNT + NPROJ / 32;

constexpr int RING_BYTES = 147456;
constexpr int LDSCTL_OFF = RING_BYTES, MISC_OFF = LDSCTL_OFF;
constexpr int LDS_BYTES = RING_BYTES + 128;
constexpr int NWAVES = 8;

#define GAS __attribute__((address_space(1)))
#define LAS __attribute__((address_space(3)))
typedef unsigned v4u __attribute__((ext_vector_type(4)));
typedef float f32x4 __attribute__((ext_vector_type(4)));
typedef GAS unsigned gu32;
#define LDS_WAIT() asm volatile("s_waitcnt lgkmcnt(0)" ::: "memory")
#define VM_WAIT() asm volatile("s_waitcnt vmcnt(0)" ::: "memory")
__device__ __forceinline__ unsigned f2bf(float f) { unsigned u = __builtin_bit_cast(unsigned, f); return (u + 0x7fffu + ((u >> 16) & 1u)) >> 16; }
__device__ __forceinline__ unsigned pk2(float lo, float hi) { return f2bf(lo) | (f2bf(hi) << 16); }
__device__ __forceinline__ float bf2f(unsigned short b) { return __builtin_bit_cast(float, (unsigned)b << 16); }
template <int CTRL> __device__ __forceinline__ float dpp_mov(float v) { return __builtin_bit_cast(float, __builtin_amdgcn_mov_dpp(__builtin_bit_cast(int, v), CTRL, 0xF, 0xF, true)); }
__device__ __forceinline__ float lane_val(float v, int l) { return __builtin_bit_cast(float, __builtin_amdgcn_readlane(__builtin_bit_cast(int, v), l)); }
__device__ __forceinline__ float wave_sum(float v) {
    v += dpp_mov<0xB1>(v); v += dpp_mov<0x4E>(v); v += dpp_mov<0x141>(v); v += dpp_mov<0x140>(v);
    return (lane_val(v, 0) + lane_val(v, 16)) + (lane_val(v, 32) + lane_val(v, 48));
}
__device__ __forceinline__ float wave_max(float v) {
    v = fmaxf(v, dpp_mov<0xB1>(v)); v = fmaxf(v, dpp_mov<0x4E>(v)); v = fmaxf(v, dpp_mov<0x141>(v)); v = fmaxf(v, dpp_mov<0x140>(v));
    return fmaxf(fmaxf(lane_val(v, 0), lane_val(v, 16)), fmaxf(lane_val(v, 32), lane_val(v, 48)));
}
#define XB_TMO      128
#define XB_XCNT(j)  (256  + 64 * (j))
#define XB_XSUB(j)  (1280 + 64 * (j))
#define XB_XGEN(j)  (2304 + 64 * (j))
#define XB_TOP      3328
#define XB_TOPGEN   3392
#define XCD_BAR_WORDS 3456
#define XB_SPIN_CAP (1u << 18)

__device__ __forceinline__ unsigned xb_ld(unsigned* p)              { return __hip_atomic_load(p, __ATOMIC_RELAXED, __HIP_MEMORY_SCOPE_AGENT); }
__device__ __forceinline__ unsigned xb_add(unsigned* p, unsigned v) { return __hip_atomic_fetch_add(p, v, __ATOMIC_RELAXED, __HIP_MEMORY_SCOPE_AGENT); }
__device__ __forceinline__ unsigned xb_xcc_id() { return (unsigned)__builtin_amdgcn_s_getreg((3 << 11) | 20) & 0xFu; }
#define XB_SPIN(cond, bar) do { unsigned _sp = 0; while (cond) { __builtin_amdgcn_s_sleep(1); \
    if ((++_sp & 255u) == 0u) { if (xb_ld(&(bar)[XB_TMO])) break; if (_sp > XB_SPIN_CAP) { atomicAdd(&(bar)[XB_TMO], 1u); break; } } } } while (0)

struct XcdBarrier {
    unsigned* bar; unsigned x;
    volatile LAS unsigned* st;
};

__device__ __forceinline__ XcdBarrier xcd_barrier_post(unsigned* bar, volatile LAS unsigned* st) {
    XcdBarrier b; b.bar = bar; b.x = xb_xcc_id(); b.st = st;
    if (threadIdx.x == 0) (void)xb_add(&bar[XB_XCNT(b.x)], 1u);
    return b;
}
__device__ __forceinline__ void xcd_barrier_complete(unsigned* bar, unsigned x, unsigned& nloc, unsigned& nx) {
    const unsigned G = gridDim.x * gridDim.y * gridDim.z;
    unsigned sum, cnt, mine, sp = 0u;
    for (;;) {
        sum = 0u; cnt = 0u; mine = 0u;
#pragma unroll
        for (unsigned j = 0; j < 16; ++j) { const unsigned c = xb_ld(&bar[XB_XCNT(j)]); sum += c; cnt += (c > 0u) ? 1u : 0u; mine = (j == x) ? c : mine; }
        if (sum == G) break;
        __builtin_amdgcn_s_sleep(1);
        if ((++sp & 255u) == 0u) { if (xb_ld(&bar[XB_TMO])) break; if (sp > XB_SPIN_CAP) { atomicAdd(&bar[XB_TMO], 1u); break; } }
    }
    nloc = mine > 0u ? mine : 1u; nx = cnt > 0u ? cnt : 1u;
}

__device__ __forceinline__ void xcd_barrier(const XcdBarrier& b, int wave_) {
    asm volatile("s_waitcnt vmcnt(0)" ::: "memory");
    __syncthreads();
    if (wave_ == 0 && lane_now() == 0) {
        unsigned* bar = b.bar;
        __builtin_amdgcn_s_waitcnt(0);
        unsigned nloc = b.st[0], nx = b.st[1];
        if (nloc == 0u) { xcd_barrier_complete(bar, b.x, nloc, nx); b.st[0] = nloc; b.st[1] = nx; }
        const unsigned old = xb_add(&bar[XB_XSUB(b.x)], 1u);
        const unsigned gen = old / nloc;
        if (old + 1u == (gen + 1u) * nloc) {
            __builtin_amdgcn_fence(__ATOMIC_RELEASE, "agent");
            asm volatile("s_waitcnt vmcnt(0)" ::: "memory");
            const unsigned og = xb_add(&bar[XB_TOP], 1u);
            const unsigned tg = og / nx;
            if (og + 1u == (tg + 1u) * nx) xb_add(&bar[XB_TOPGEN], 1u);
            else XB_SPIN(xb_ld(&bar[XB_TOPGEN]) == tg, bar);
            __builtin_amdgcn_fence(__ATOMIC_ACQUIRE, "agent");
            xb_add(&bar[XB_XGEN(b.x)], 1u);
            asm volatile("s_waitcnt vmcnt(0)" ::: "memory");
        } else {
            XB_SPIN(xb_ld(&bar[XB_XGEN(b.x)]) == gen, bar);
            __builtin_amdgcn_fence(__ATOMIC_ACQUIRE, "agent");
            asm volatile("s_waitcnt vmcnt(0)" ::: "memory");
        }
    }
    __syncthreads();
}
struct Args { const float* in[12]; float* out; unsigned char* ws; int ph_lo, ph_hi, li, pad; };

__device__ __forceinline__ void p0_transpose_item(const float* W, int K, int N, bf16* WT, const float* kscale, LAS float* scr, int item, int lane) {
    const int nblk = N / 32, kb = item / nblk, nb = item % nblk, k0 = 64 * kb, n0 = 32 * nb;
#pragma unroll 8
    for (int i = 0; i < 32; ++i) { const int kk = 2 * i + (lane >> 5); float w = W[(size_t)(k0 + kk) * N + n0 + (lane & 31)]; if (kscale) w *= kscale[k0 + kk]; scr[kk * 33 + (lane & 31)] = w; }
    LDS_WAIT(); asm volatile("" ::: "memory");
    const int c = lane & 7;
#pragma unroll
    for (int j = 0; j < 4; ++j) { const int n = (lane >> 3) + 8 * j; const LAS float* s = scr + (8 * c) * 33 + n;
        v4u o; o.x = pk2(s[0 * 33], s[1 * 33]); o.y = pk2(s[2 * 33], s[3 * 33]); o.z = pk2(s[4 * 33], s[5 * 33]); o.w = pk2(s[6 * 33], s[7 * 33]);
        *(GAS v4u*)(WT + (size_t)(n0 + n) * K + k0 + 8 * c) = o; }
    LDS_WAIT(); asm volatile("" ::: "memory");
}
__device__ __forceinline__ void p0_quant_item(const float* W, int N, signed char* W8, float* sw, unsigned* cmax, unsigned* ccnt, LAS float* scr, int item, int lane) {
    const int nblk = N / 32, kb = item / nblk, nb = item % nblk, k0 = 64 * kb, n0 = 32 * nb;
    float mx = 0.f;
#pragma unroll 8
    for (int i = 0; i < 32; ++i) { const int kk = 2 * i + (lane >> 5); const float w = W[(size_t)(k0 + kk) * N + n0 + (lane & 31)]; scr[kk * 33 + (lane & 31)] = w; mx = fmaxf(mx, fabsf(w)); }
    { const auto rr = __builtin_amdgcn_permlane32_swap(__builtin_bit_cast(unsigned, mx), __builtin_bit_cast(unsigned, mx), false, false);
      mx = fmaxf(__builtin_bit_cast(float, (unsigned)rr[0]), __builtin_bit_cast(float, (unsigned)rr[1])); }
    if (lane < 32) __hip_atomic_fetch_max(cmax + n0 + lane, __builtin_bit_cast(unsigned, mx), __ATOMIC_RELAXED, __HIP_MEMORY_SCOPE_AGENT);
    asm volatile("s_waitcnt vmcnt(0)" ::: "memory");
    if (lane == 0) { __hip_atomic_fetch_add(ccnt + nb, 1u, __ATOMIC_RELAXED, __HIP_MEMORY_SCOPE_AGENT);
        unsigned sp = 0; while (__hip_atomic_load(ccnt + nb, __ATOMIC_RELAXED, __HIP_MEMORY_SCOPE_AGENT) < 16u) { __builtin_amdgcn_s_sleep(1); if (++sp > (1u << 22)) break; } }
    asm volatile("s_waitcnt vmcnt(0) lgkmcnt(0)" ::: "memory");
    __builtin_amdgcn_wave_barrier();
#pragma unroll
    for (int j = 0; j < 2; ++j) { const int n = 16 * j + (lane >> 2), ck = lane & 3;
        const float cm = __builtin_bit_cast(float, __hip_atomic_load(cmax + n0 + n, __ATOMIC_RELAXED, __HIP_MEMORY_SCOPE_AGENT));
        const float inv = cm > 0.f ? 127.f / cm : 0.f;
        if (kb == 0 && ck == 0) sw[n0 + n] = cm > 0.f ? cm * (1.f / 127.f) : 1.f;
        v4u o;
#pragma unroll
        for (int q = 0; q < 4; ++q) { const LAS float* sp_ = scr + (16 * ck + 4 * q) * 33 + n;
            const int a = (int)rintf(sp_[0] * inv), b = (int)rintf(sp_[33] * inv), c = (int)rintf(sp_[66] * inv), d = (int)rintf(sp_[99] * inv);
            o[q] = (unsigned)(a & 0xff) | ((unsigned)(b & 0xff) << 8) | ((unsigned)(c & 0xff) << 16) | ((unsigned)(d & 0xff) << 24); }
        *(GAS v4u*)(W8 + (size_t)(n0 + n) * 1024 + k0 + 16 * ck) = o; }
    LDS_WAIT(); asm volatile("" ::: "memory");
}
__device__ __forceinline__ void rms_row_to_bf16(const float* xrow, const float* g, bf16* orow, int lane) {
    const GAS f32x4* xr = (const GAS f32x4*)xrow + lane;
    f32x4 v[4]; float s = 0.f;
#pragma unroll
    for (int j = 0; j < 4; ++j) { v[j] = xr[64 * j]; s += (v[j].x * v[j].x + v[j].y * v[j].y) + (v[j].z * v[j].z + v[j].w * v[j].w); }
    const float r = rsqrtf(wave_sum(s) * (1.f / D) + 1e-6f);
    GAS unsigned long long* o8 = (GAS unsigned long long*)orow + lane;
#pragma unroll
    for (int j = 0; j < 4; ++j) { const f32x4 gg = ((const GAS f32x4*)g)[lane + 64 * j];
        o8[64 * j] = (unsigned long long)pk2(v[j].x * r * gg.x, v[j].y * r * gg.y) | ((unsigned long long)pk2(v[j].z * r * gg.z, v[j].w * r * gg.w) << 32); }
}
__device__ __forceinline__ void quant_row_i8(const float* src, const float* gsc, signed char* dst, float* scale_out, int lane) {
    const GAS f32x4* p = (const GAS f32x4*)src + 4 * lane;
    f32x4 v[4]; float amax = 0.f;
#pragma unroll
    for (int j = 0; j < 4; ++j) { v[j] = p[j]; if (gsc) v[j] = v[j] * ((const GAS f32x4*)gsc)[4 * lane + j];
        amax = fmaxf(amax, fmaxf(fmaxf(fabsf(v[j].x), fabsf(v[j].y)), fmaxf(fabsf(v[j].z), fabsf(v[j].w)))); }
    amax = wave_max(amax);
    const float inv = amax > 0.f ? 127.f / amax : 0.f;
    v4u w;
#pragma unroll
    for (int j = 0; j < 4; ++j) { const int a = (int)rintf(v[j].x * inv), b = (int)rintf(v[j].y * inv), c = (int)rintf(v[j].z * inv), d = (int)rintf(v[j].w * inv);
        w[j] = (unsigned)(a & 0xff) | ((unsigned)(b & 0xff) << 8) | ((unsigned)(c & 0xff) << 16) | ((unsigned)(d & 0xff) << 24); }
    *(GAS v4u*)(dst + (size_t)(lane >> 3) * ((size_t)NEXP * 128) + 16 * (lane & 7)) = w;
    if (lane == 0) *scale_out = amax > 0.f ? amax * (1.f / 127.f) : 1.f;
}
__device__ __forceinline__ void quant_row_load(const float* src, f32x4 (&v)[4], int lane) {
    const GAS f32x4* p = (const GAS f32x4*)src + 4 * lane;
#pragma unroll
    for (int j = 0; j < 4; ++j) v[j] = p[j];
}
__device__ __forceinline__ void quant_row_finish(f32x4 (&v)[4], const float* gsc, signed char* dst, float* scale_out, int lane) {
    float amax = 0.f;
#pragma unroll
    for (int j = 0; j < 4; ++j) { if (gsc) v[j] = v[j] * ((const GAS f32x4*)gsc)[4 * lane + j];
        amax = fmaxf(amax, fmaxf(fmaxf(fabsf(v[j].x), fabsf(v[j].y)), fmaxf(fabsf(v[j].z), fabsf(v[j].w)))); }
    amax = wave_max(amax);
    const float inv = amax > 0.f ? 127.f / amax : 0.f;
    v4u w;
#pragma unroll
    for (int j = 0; j < 4; ++j) { const int a = (int)rintf(v[j].x * inv), b = (int)rintf(v[j].y * inv), c = (int)rintf(v[j].z * inv), d = (int)rintf(v[j].w * inv);
        w[j] = (unsigned)(a & 0xff) | ((unsigned)(b & 0xff) << 8) | ((unsigned)(c & 0xff) << 16) | ((unsigned)(d & 0xff) << 24); }
    *(GAS v4u*)(dst + (size_t)(lane >> 3) * ((size_t)NEXP * 128) + 16 * (lane & 7)) = w;
    if (lane == 0) *scale_out = amax > 0.f ? amax * (1.f / 127.f) : 1.f;
}
__device__ __forceinline__ void p0_prologue(const Args& a, LAS unsigned char* lds, int gw, int NGW, int wave, int lane) {
    unsigned char* ws = a.ws;
    LAS float* scr = (LAS float*)(lds + wave * 16384);
    const float* w_in = a.in[2]; const float* w_pool = a.in[3]; const float* w_out = a.in[5]; const float* g_ffn = a.in[6]; const float* w_q = a.in[7];
    constexpr int I_IN = (D / 64) * (NPROJ / 32), I_OUT = (D / 64) * (D / 32), I_Q = (D / 64) * (NQ / 32), I_P = 4 * 2;
    constexpr int NITEMS = I_IN + I_OUT + I_Q + I_P;
    for (int it = gw; it < NITEMS; it += NGW) {
        int r = it;
        if (r < I_IN) { p0_quant_item(w_in, NPROJ, (signed char*)(ws + WS_WIN), (float*)(ws + WS_SWIN), (unsigned*)(ws + WS_CTL) + CW_CMAX, (unsigned*)(ws + WS_CTL) + CW_CCNT, scr, r, lane); continue; } r -= I_IN;
        if (r < I_OUT) { p0_transpose_item(w_out, D, D, (bf16*)(ws + WS_WOUT), nullptr, scr, r, lane); continue; } r -= I_OUT;
        if (r < I_Q) { p0_transpose_item(w_q, D, NQ, (bf16*)(ws + WS_WQ), g_ffn, scr, r, lane); continue; } r -= I_Q;
        p0_transpose_item(w_pool + (r >> 1) * 4096, 64, 64, (bf16*)(ws + WS_WPT) + (r >> 1) * 4096, nullptr, scr, r & 1, lane);
    }
    constexpr int R_X = M, R_SK = 256, R_Z = 32, NROWS = R_X + R_SK + R_Z;
    for (int c4 = gw; c4 < R_X / 4; c4 += NGW) {
        const GAS f32x4* xr = (const GAS f32x4*)(a.in[0] + (size_t)c4 * 4 * D) + lane;
        f32x4 v[4][4]; float ssq[4];
#pragma unroll
        for (int rr = 0; rr < 4; ++rr)
#pragma unroll
            for (int j = 0; j < 4; ++j) v[rr][j] = xr[rr * (D / 4) + 64 * j];
#pragma unroll
        for (int rr = 0; rr < 4; ++rr) { float s_ = 0.f;
#pragma unroll
            for (int j = 0; j < 4; ++j) s_ += (v[rr][j].x * v[rr][j].x + v[rr][j].y * v[rr][j].y) + (v[rr][j].z * v[rr][j].z + v[rr][j].w * v[rr][j].w);
            ssq[rr] = s_; }
#pragma unroll
        for (int rr = 0; rr < 4; ++rr) ssq[rr] = wave_sum(ssq[rr]);
#pragma unroll
        for (int rr = 0; rr < 4; ++rr) { const float rs = rsqrtf(ssq[rr] * (1.f / D) + 1e-6f);
            GAS unsigned* o4 = (GAS unsigned*)((signed char*)(ws + WS_XN) + ((size_t)c4 * 4 + rr) * D) + lane;
            f32x4 y[4]; float am = 0.f;
#pragma unroll
            for (int j = 0; j < 4; ++j) { const f32x4 gg = ((const GAS f32x4*)a.in[1])[lane + 64 * j]; y[j] = v[rr][j] * gg * rs;
                am = fmaxf(am, fmaxf(fmaxf(fabsf(y[j].x), fabsf(y[j].y)), fmaxf(fabsf(y[j].z), fabsf(y[j].w)))); }
            am = wave_max(am); const float qi = am > 0.f ? 127.f / am : 0.f;
#pragma unroll
            for (int j = 0; j < 4; ++j) { const int q0 = (int)rintf(y[j].x * qi), q1 = (int)rintf(y[j].y * qi), q2 = (int)rintf(y[j].z * qi), q3 = (int)rintf(y[j].w * qi);
                o4[64 * j] = (unsigned)(q0 & 0xff) | ((unsigned)(q1 & 0xff) << 8) | ((unsigned)(q2 & 0xff) << 16) | ((unsigned)q3 << 24); }
            if (lane == 0) ((float*)(ws + WS_SA))[(size_t)c4 * 4 + rr] = am > 0.f ? am * (1.f / 127.f) : 1.f; }
    }
    for (int it = R_X + gw; it < NROWS; it += NGW) {
        int r = it - R_X;
        if (r < R_SK) { const GAS f32x4* p = (const GAS f32x4*)(a.in[8] + (size_t)r * 1024) + lane; GAS unsigned long long* o8 = (GAS unsigned long long*)((bf16*)(ws + WS_SK) + (size_t)r * 1024) + lane;
#pragma unroll
            for (int j = 0; j < 4; ++j) { const f32x4 v = p[64 * j]; o8[64 * j] = (unsigned long long)pk2(v.x, v.y) | ((unsigned long long)pk2(v.z, v.w) << 32); }
            continue; } r -= R_SK;
        { GAS f32x4* z = (GAS f32x4*)((float*)(ws + WS_ROWSS) + (size_t)r * 1024) + lane;
#pragma unroll
          for (int j = 0; j < 4; ++j) z[64 * j] = (f32x4){0.f, 0.f, 0.f, 0.f}; }
    }
}
namespace attn {
typedef short bf16x8 __attribute__((ext_vector_type(8)));
typedef short s16x4 __attribute__((ext_vector_type(4)));
typedef float f32x16 __attribute__((ext_vector_type(16)));
typedef float f32x2_t __attribute__((ext_vector_type(2)));
typedef __bf16 bf16x2_t __attribute__((ext_vector_type(2)));
typedef unsigned u32x4 __attribute__((ext_vector_type(4)));
typedef unsigned u32x2 __attribute__((ext_vector_type(2)));
constexpr int KROW = 144;
constexpr int SLOT = 2 * 256 * KROW;
__device__ __forceinline__ unsigned cvtpk(float lo, float hi) { f32x2_t v = {lo, hi}; bf16x2_t b = __builtin_convertvector(v, bf16x2_t); return __builtin_bit_cast(unsigned, b); }
__device__ __forceinline__ s16x4 vtr(LAS const unsigned char* p) { return __builtin_bit_cast(s16x4, __builtin_amdgcn_ds_read_tr16_b64_v4i16((LAS s16x4*)p)); }

__device__ __forceinline__ void attn_phase(unsigned char* ws, LAS unsigned char* lds, int vcu, int G, int tid) {
    const int lane = tid & 63, wv = __builtin_amdgcn_readfirstlane(tid >> 6), grp = wv >> 2, w = wv & 3, tl = tid & 255;
    const int ql = lane & 31, h = lane >> 5;
    LAS unsigned char* Ks = lds + grp * SLOT; LAS unsigned char* Vs = Ks + 256 * KROW;
    const bf16* Qd = (const bf16*)(ws + WS_Q); const bf16* Kd = (const bf16*)(ws + WS_K); const bf16* Vd = (const bf16*)(ws + WS_V);
    bf16* ORAW = (bf16*)(ws + WS_ORAW); float* LSE = (float*)(ws + WS_LSE);
#define ATT_UNIT(pi_) const int uid = 2 * (pi_) + grp, bh = uid >> 4, cu = uid & 15, hd = bh % 12, b = bh / 12, sh = 2 * (hd >> 2), L = 2048 >> sh; \
        const int r = cu >> (4 - sh), n = cu & ((16 >> sh) - 1), q0 = 128 * n; const size_t pbase = ((size_t)bh * 2048 + (size_t)r * L) * 64;
#define ATT_LOAD(pi_) do { ATT_UNIT(pi_) (void)b; (void)hd; const bf16* Kp = Kd + pbase; const bf16* Vp = Vd + pbase; const bf16* Qp = Qd + pbase; \
        _Pragma("unroll") for (int j = 0; j < 8; ++j) { const int id = tl + 256 * j, row = id >> 3, ch = id & 7; int kr = q0 - 64 + row; kr = kr < 0 ? 0 : (kr > L - 1 ? L - 1 : kr); \
            kreg[j] = *(const u32x4*)(Kp + (size_t)kr * 64 + ch * 8); vreg[j] = *(const u32x4*)(Vp + (size_t)kr * 64 + ch * 8); } \
        _Pragma("unroll") for (int ks = 0; ks < 4; ++ks) qn[ks] = *(const bf16x8*)(Qp + (size_t)(q0 + 32 * w + ql) * 64 + 16 * ks + 8 * h); } while (0)
    u32x4 kreg[8], vreg[8]; bf16x8 qn[4];
    if (vcu < 1536) ATT_LOAD(vcu);
    for (int pi = vcu; pi < 1536; pi += G) {
        ATT_UNIT(pi)
        __syncthreads();
        int hh = h, qll = ql; asm volatile("" : "+v"(hh), "+v"(qll));
#pragma unroll
        for (int j = 0; j < 8; ++j) { const int id = tl + 256 * j, row = id >> 3, ch = id & 7; *(LAS u32x4*)(Ks + row * KROW + ch * 16) = kreg[j]; *(LAS u32x4*)(Vs + row * KROW + ch * 16) = vreg[j]; }
        bf16x8 qf[4];
#pragma unroll
        for (int ks = 0; ks < 4; ++ks) qf[ks] = qn[ks];
        __syncthreads();
        if (pi + G < 1536) ATT_LOAD(pi + G);
        const float slope2 = exp2f(-8.f * (float)(hd + 1) / 12.f) * (float)(1 << sh) * 1.4426950408889634f;
        const int nb = qll - 4 * hh;
        const float sbp = -slope2 * (float)nb;
        bool tv[5];
#pragma unroll
        for (int kt = 0; kt < 5; ++kt) { const int klo = q0 + 32 * w + 32 * kt - 64; tv[kt] = (klo >= 0) && (klo + 32 <= L); }
        f32x16 sT[5]; float mx = -1e30f;
#pragma unroll
        for (int kt = 0; kt < 5; ++kt) {
            if (tv[kt]) {
                const float c0 = kt < 2 ? sbp : (kt == 2 ? 0.f : -sbp);
                f32x16 acc;
#pragma unroll
                for (int rr = 0; rr < 16; ++rr) acc[rr] = c0;
#pragma unroll
                for (int ks = 0; ks < 4; ++ks) { const bf16x8 af = *(LAS const bf16x8*)(Ks + (32 * w + 32 * kt + ql) * KROW + ks * 32 + h * 16);
                    acc = __builtin_amdgcn_mfma_f32_32x32x16_bf16(af, qf[ks], acc, 0, 0, 0); }
#pragma unroll
                for (int rr = 0; rr < 16; ++rr) { const int c = (rr & 3) + 8 * (rr >> 2); float sv = acc[rr];
                    if (kt < 2) sv = fmaf(slope2, (float)(32 * kt - 64 + c), sv);
                    else if (kt > 2) sv = fmaf(-slope2, (float)(32 * kt - 64 + c), sv);
                    else sv = fmaf(-slope2, fabsf((float)c - (float)nb), sv);
                    if (kt == 0) sv = (c >= nb) ? sv : -1e30f;
                    if (kt == 4) sv = (c <= nb) ? sv : -1e30f;
                    acc[rr] = sv; mx = fmaxf(mx, sv); }
                sT[kt] = acc; } }
        { const auto rr_ = __builtin_amdgcn_permlane32_swap(__builtin_bit_cast(unsigned, mx), __builtin_bit_cast(unsigned, mx), false, false); mx = fmaxf(__builtin_bit_cast(float, (unsigned)rr_[0]), __builtin_bit_cast(float, (unsigned)rr_[1])); }
        float den = 0.f;
#pragma unroll
        for (int kt = 0; kt < 5; ++kt)
            if (tv[kt]) {
#pragma unroll
                for (int rr = 0; rr < 16; ++rr) { const float p = __builtin_amdgcn_exp2f(sT[kt][rr] - mx); sT[kt][rr] = p; den += p; } }
        { const auto rr_ = __builtin_amdgcn_permlane32_swap(__builtin_bit_cast(unsigned, den), __builtin_bit_cast(unsigned, den), false, false); den = __builtin_bit_cast(float, (unsigned)rr_[0]) + __builtin_bit_cast(float, (unsigned)rr_[1]); }
        f32x16 o[2]; o[0] = f32x16{}; o[1] = f32x16{};
        const int g4 = lane >> 4, i16 = lane & 15, qq = i16 >> 2, pp = i16 & 3;
        LAS const unsigned char* vb = Vs + (32 * w + 4 * h + qq) * KROW + (16 * (g4 & 1) + 4 * pp) * 2;
#pragma unroll
        for (int s2 = 0; s2 < 10; ++s2) { const int kt = s2 >> 1, rb = 8 * (s2 & 1);
            if (tv[kt]) {
            u32x4 pw; pw.x = cvtpk(sT[kt][rb + 0], sT[kt][rb + 1]); pw.y = cvtpk(sT[kt][rb + 2], sT[kt][rb + 3]); pw.z = cvtpk(sT[kt][rb + 4], sT[kt][rb + 5]); pw.w = cvtpk(sT[kt][rb + 6], sT[kt][rb + 7]);
            const bf16x8 pf = __builtin_bit_cast(bf16x8, pw);
#pragma unroll
            for (int ct = 0; ct < 2; ++ct) { const s16x4 lo = vtr(vb + (16 * s2) * KROW + ct * 64), hi4 = vtr(vb + (16 * s2 + 8) * KROW + ct * 64);
                const bf16x8 af = (bf16x8){lo[0], lo[1], lo[2], lo[3], hi4[0], hi4[1], hi4[2], hi4[3]};
                o[ct] = __builtin_amdgcn_mfma_f32_32x32x16_bf16(af, pf, o[ct], 0, 0, 0); } } }
        const float inv = 1.f / den;
        __syncthreads();
        LAS unsigned char* ost = Ks + w * (32 * KROW);
#pragma unroll
        for (int ct = 0; ct < 2; ++ct)
#pragma unroll
            for (int a4 = 0; a4 < 4; ++a4) { u32x2 wv2; wv2.x = cvtpk(o[ct][4 * a4] * inv, o[ct][4 * a4 + 1] * inv); wv2.y = cvtpk(o[ct][4 * a4 + 2] * inv, o[ct][4 * a4 + 3] * inv);
                *(LAS u32x2*)(ost + ql * KROW + (32 * ct + 8 * a4 + 4 * h) * 2) = wv2; }
        {   const int pos = ((q0 + 32 * w + ql) << sh) + r; const size_t t = (size_t)b * 2048 + pos;
            if (h == 0) LSE[t * 12 + hd] = 0.6931471805599453f * (mx + __builtin_amdgcn_logf(den)); }
        asm volatile("s_waitcnt lgkmcnt(0)" ::: "memory");
#pragma unroll
        for (int i = 0; i < 4; ++i) { const int qr = 8 * i + (lane >> 3), ch = lane & 7;
            const u32x4 v = *(LAS const u32x4*)(ost + qr * KROW + ch * 16);
            const size_t t = (size_t)b * 2048 + (((q0 + 32 * w + qr) << sh) + r);
            *(u32x4*)(ORAW + t * 768 + hd * 64 + ch * 8) = v; }
    }
    __syncthreads();
#undef ATT_UNIT
#undef ATT_LOAD
}
}
namespace mixp {
typedef short bf16x8 __attribute__((ext_vector_type(8)));
typedef unsigned u32x4 __attribute__((ext_vector_type(4)));
__device__ __forceinline__ void unpack8(const u32x4 v, float (&f)[8]) {
#pragma unroll
    for (int i = 0; i < 4; ++i) { f[2 * i] = __builtin_bit_cast(float, v[i] << 16); f[2 * i + 1] = __builtin_bit_cast(float, v[i] & 0xffff0000u); }
}
__device__ __forceinline__ void mix_phase(const Args& a, LAS unsigned char* lds, int gw, int NGW, int wave, int lane) {
    unsigned char* ws = a.ws;
    LAS float* al = (LAS float*)(lds + wave * 1024);
    constexpr int PROW = 528;
    LAS unsigned char* pst = lds + 8192 + wave * (32 * PROW);
    const bf16* P = (const bf16*)(ws + WS_P); const bf16* ORAW = (const bf16*)(ws + WS_ORAW); const float* LSE = (const float*)(ws + WS_LSE);
    bf16* MIXIN = (bf16*)(ws + WS_MIXIN); const bf16* WpT = (const bf16*)(ws + WS_WPT); const float* pool_scale = a.in[4];
    for (int u = gw; u < M / 16; u += NGW) {
        const int t0 = 16 * u;
#pragma unroll
        for (int j = 0; j < 3; ++j) { const int id = lane + 64 * j, tk = id / 12, hd = id % 12, s = hd & 3, g = hd >> 2;
            const float* lp = LSE + (size_t)(t0 + tk) * 12 + s; const float l0 = lp[0], l1 = lp[4], l2 = lp[8];
            const float mx = fmaxf(l0, fmaxf(l1, l2)); const float e0 = __expf(l0 - mx), e1 = __expf(l1 - mx), e2 = __expf(l2 - mx);
            al[id] = (g == 0 ? e0 : (g == 1 ? e1 : e2)) / (e0 + e1 + e2); }
        asm volatile("s_waitcnt lgkmcnt(0)" ::: "memory");
#pragma unroll 12
        for (int it = 0; it < 24; ++it) { const int id = lane + 64 * it, tk = id / 96, ch = id % 96, hd = ch >> 3;
            const u32x4 v = *(const u32x4*)(ORAW + (size_t)(t0 + tk) * 768 + ch * 8); const float alpha = al[tk * 12 + hd];
            float f[8]; unpack8(v, f); u32x4 o;
#pragma unroll
            for (int i = 0; i < 4; ++i) o[i] = pk2(f[2 * i] * alpha, f[2 * i + 1] * alpha);
            *(u32x4*)(MIXIN + (size_t)(t0 + tk) * D + 256 + ch * 8) = o; }
        asm volatile("s_waitcnt lgkmcnt(0)" ::: "memory");
        const int ti = lane & 15, kq = lane >> 4, pos = (t0 + ti) & 2047, b0 = t0 - (t0 & 2047);
#pragma unroll
        for (int j = 0; j < 16; ++j) { const int rr = 2 * j + (lane >> 5), ch = lane & 31; int tr = t0 - 8 + rr; tr = tr < b0 ? b0 : (tr > b0 + 2047 ? b0 + 2047 : tr);
            const u32x4 v = *(const u32x4*)(P + (size_t)tr * 256 + ch * 8); *(LAS u32x4*)(pst + rr * PROW + ch * 16) = v; }
        asm volatile("s_waitcnt lgkmcnt(0)" ::: "memory");
        f32x4 acc[4][4];
#pragma unroll
        for (int gi = 0; gi < 4; ++gi) { const int hw = 1 << gi;
#pragma unroll
            for (int dt = 0; dt < 4; ++dt) acc[gi][dt] = (f32x4){0.f, 0.f, 0.f, 0.f};
#pragma unroll
            for (int kk = 0; kk < 2; ++kk) { const int cg = 64 * gi + 32 * kk + 8 * kq;
                float sum[8]; int cnt = 0;
#pragma unroll
                for (int i = 0; i < 8; ++i) sum[i] = 0.f;
#pragma unroll
                for (int dj = -hw; dj < hw; ++dj) { const int p2 = pos + dj; const bool ok = (p2 >= 0) && (p2 < 2048);
                    const u32x4 v = *(LAS const u32x4*)(pst + (ti + 8 + dj) * PROW + cg * 2); float f[8]; unpack8(v, f);
                    if (ok) {
#pragma unroll
                        for (int i = 0; i < 8; ++i) sum[i] += f[i];
                        ++cnt; } }
                const u32x4 ov = *(LAS const u32x4*)(pst + (ti + 8) * PROW + cg * 2); float own[8]; unpack8(ov, own);
                const float rc = 1.f / (float)cnt; u32x4 aw;
#pragma unroll
                for (int i = 0; i < 4; ++i) aw[i] = pk2(sum[2 * i] * rc - own[2 * i], sum[2 * i + 1] * rc - own[2 * i + 1]);
                const bf16x8 af = __builtin_bit_cast(bf16x8, aw);
#pragma unroll
                for (int dt = 0; dt < 4; ++dt) { const bf16x8 bfr = *(const bf16x8*)(WpT + gi * 4096 + (16 * dt + ti) * 64 + 32 * kk + 8 * kq);
                    acc[gi][dt] = __builtin_amdgcn_mfma_f32_16x16x32_bf16(af, bfr, acc[gi][dt], 0, 0, 0); } } }
        asm volatile("s_waitcnt lgkmcnt(0)" ::: "memory");
#pragma unroll
        for (int gi = 0; gi < 4; ++gi)
#pragma unroll
            for (int dt = 0; dt < 4; ++dt) { const int d = 64 * gi + 16 * dt + ti; const float sc = pool_scale[d];
#pragma unroll
                for (int rg = 0; rg < 4; ++rg) { const float fv = acc[gi][dt][rg]; *(LAS unsigned short*)(pst + (4 * kq + rg) * PROW + d * 2) = (unsigned short)f2bf(fv * sc); } }
        asm volatile("s_waitcnt lgkmcnt(0)" ::: "memory");
#pragma unroll
        for (int j = 0; j < 8; ++j) { const int rr = 2 * j + (lane >> 5), ch = lane & 31;
            const u32x4 v = *(LAS const u32x4*)(pst + rr * PROW + ch * 16); *(u32x4*)(MIXIN + (size_t)(t0 + rr) * D + ch * 8) = v; }
        asm volatile("s_waitcnt lgkmcnt(0)" ::: "memory");
    }
}
}
namespace peer {
typedef unsigned u32x4 __attribute__((ext_vector_type(4)));
typedef unsigned u32x2 __attribute__((ext_vector_type(2)));
typedef int i32x4 __attribute__((ext_vector_type(4)));
constexpr int TOK_PER_BLK = 128, TOK_PER_WAVE = 16;
constexpr int L_IDX = 0, L_ZW = 32768, L_TOK = 98304, L_SS = 100352;
constexpr size_t SLICE_BYTES = (size_t)NEXP * 128;
__device__ __forceinline__ float gelu_erf(float v) { return 0.5f * v * (1.f + erff(v * 0.70710678118654752f)); }
__device__ __forceinline__ int lane_xor1(int v) { return __builtin_amdgcn_mov_dpp(v, 0xB1, 0xF, 0xF, true); }
__device__ __forceinline__ int lane_xor2(int v) { return __builtin_amdgcn_mov_dpp(v, 0x4E, 0xF, 0xF, true); }
__device__ __forceinline__ int lane_hmirror(int v) { return __builtin_amdgcn_mov_dpp(v, 0x141, 0xF, 0xF, true); }
__device__ __forceinline__ float bf_lo(unsigned w) { return __builtin_bit_cast(float, w << 16); }
__device__ __forceinline__ float bf_hi(unsigned w) { return __builtin_bit_cast(float, w & 0xffff0000u); }

__device__ __forceinline__ void gather_phase(const Args& a, LAS unsigned char* lds, int vcu, int G, int wave, int lane) {
    unsigned char* ws = a.ws; float* out = a.out;
    const unsigned char* U8 = ws + WS_U8; const unsigned char* V8 = ws + WS_V8;
    const float* SU = (const float*)(ws + WS_SU); const float* SV = (const float*)(ws + WS_SV);
    const unsigned short* IDX = (const unsigned short*)(ws + WS_IDX); const float* GATE = (const float*)(ws + WS_GATE);
    unsigned char* X8 = ws + WS_X8; const float* g_final = a.in[11];
    bf16* X2B = (bf16*)(ws + WS_XN);
    for (int tb = vcu; tb < M / TOK_PER_BLK; tb += G) {
        const int T0 = tb * TOK_PER_BLK + wave * TOK_PER_WAVE, tl0 = wave * TOK_PER_WAVE;
        LAS unsigned short* idxl = (LAS unsigned short*)(lds + L_IDX) + tl0 * 128;
        LAS int* zw = (LAS int*)(lds + L_ZW) + tl0 * 128;
        LAS float* tokf = (LAS float*)(lds + L_TOK) + tl0 * 2;
        LAS float* ssl = (LAS float*)(lds + L_SS) + tl0 * 8;
        for (int tk4 = 0; tk4 < TOK_PER_WAVE; tk4 += 4) {
          u32x4 xbA[4], xbB[4]; unsigned short ix0[4], ix1[4];
#pragma unroll
          for (int u = 0; u < 4; ++u) { const int t = T0 + tk4 + u; xbA[u] = *(const u32x4*)(X2B + (size_t)t * D + 16 * lane); xbB[u] = *(const u32x4*)(X2B + (size_t)t * D + 16 * lane + 8);
              ix0[u] = IDX[(size_t)t * 128 + lane]; ix1[u] = IDX[(size_t)t * 128 + 64 + lane]; }
#pragma unroll
          for (int u = 0; u < 4; ++u) { const int tk = tk4 + u, t = T0 + tk;
            f32x4 x2[4]; float ss = 0.f, amax = 0.f;
            const u32x4 xb0 = xbA[u], xb1 = xbB[u];
#pragma unroll
            for (int j = 0; j < 4; ++j) { const unsigned w0 = (j < 2 ? xb0 : xb1)[2 * (j & 1)], w1 = (j < 2 ? xb0 : xb1)[2 * (j & 1) + 1];
                x2[j] = (f32x4){bf_lo(w0), bf_hi(w0), bf_lo(w1), bf_hi(w1)};
                ss += (x2[j].x * x2[j].x + x2[j].y * x2[j].y) + (x2[j].z * x2[j].z + x2[j].w * x2[j].w);
                amax = fmaxf(amax, fmaxf(fmaxf(fabsf(x2[j].x), fabsf(x2[j].y)), fmaxf(fabsf(x2[j].z), fabsf(x2[j].w)))); }
            ss = wave_sum(ss); amax = wave_max(amax);
            const float rstd = rsqrtf(ss * (1.f / D) + 1e-6f), inv = amax > 0.f ? 127.f / amax : 0.f, sx = amax * (1.f / 127.f);
            u32x4 xq;
#pragma unroll
            for (int j = 0; j < 4; ++j) { const int q0 = (int)rintf(x2[j].x * inv), q1 = (int)rintf(x2[j].y * inv), q2 = (int)rintf(x2[j].z * inv), q3 = (int)rintf(x2[j].w * inv);
                xq[j] = (unsigned)(q0 & 0xff) | ((unsigned)(q1 & 0xff) << 8) | ((unsigned)(q2 & 0xff) << 16) | ((unsigned)q3 << 24); }
            *(u32x4*)(X8 + (size_t)t * D + 16 * lane) = xq;
            idxl[tk * 128 + lane] = ix0[u]; idxl[tk * 128 + 64 + lane] = ix1[u];
            zw[tk * 128 + lane] = 0; zw[tk * 128 + 64 + lane] = 0;
            if (lane < 8) ssl[tk * 8 + lane] = 0.f;
            if (lane == 0) { tokf[tk * 2] = sx * rstd; tokf[tk * 2 + 1] = 0.f; } } }
        asm volatile("s_waitcnt vmcnt(0) lgkmcnt(0)" ::: "memory");
        { const int g = lane >> 3, i8 = lane & 7;
#define PEER_ULOAD(buf, v, h) do { const int s_ = (v) >> 4, tk_ = (v) & 15; const unsigned char* Us_ = U8 + (size_t)s_ * SLICE_BYTES; \
            _Pragma("unroll") for (int it = 0; it < 8; ++it) { const unsigned e = idxl[tk_ * 128 + 64 * (h) + 8 * it + g]; buf[it] = *(const u32x4*)(Us_ + ((e << 7) | lo16u)); } } while (0)
#define PEER_XLOAD(xv, v) do { const int s_ = (v) >> 4, tk_ = (v) & 15; xv = *(const u32x4*)(X8 + (size_t)(T0 + tk_) * D + 128 * s_ + 16 * i8); } while (0)
#define PEER_UCOMP(buf, xv, v, h) do { const int tk_ = (v) & 15; int d_[8], a_[4], b_[2]; \
            _Pragma("unroll") for (int it = 0; it < 8; ++it) { int d = __builtin_amdgcn_sdot4((int)buf[it].x, (int)xv.x, 0, false); d = __builtin_amdgcn_sdot4((int)buf[it].y, (int)xv.y, d, false); \
                d = __builtin_amdgcn_sdot4((int)buf[it].z, (int)xv.z, d, false); d_[it] = __builtin_amdgcn_sdot4((int)buf[it].w, (int)xv.w, d, false); } \
              \
              \
            _Pragma("unroll") for (int p = 0; p < 4; ++p) { const int keep = q2 ? d_[4 + p] : d_[p], send = q2 ? d_[p] : d_[4 + p]; a_[p] = keep + lane_hmirror(send); } \
            _Pragma("unroll") for (int p = 0; p < 2; ++p) { const int keep = q0 ? a_[2 * p + 1] : a_[2 * p], send = q0 ? a_[2 * p] : a_[2 * p + 1]; b_[p] = keep + lane_xor1(send); } \
            { const int keep = q1 ? b_[1] : b_[0], send = q1 ? b_[0] : b_[1]; const int c_ = keep + lane_xor2(send); \
              __hip_atomic_fetch_add(zw + tk_ * 128 + 64 * (h) + 8 * i8 + g, c_, __ATOMIC_RELAXED, __HIP_MEMORY_SCOPE_WORKGROUP); } } while (0)
        {   const bool q0 = lane & 1, q1 = lane & 2, q2 = lane & 4; const unsigned lo16u = (unsigned)i8 << 4;
            u32x4 u0[8], u1[8], u2[8], x0, x1, x2;
            PEER_XLOAD(x0, 0); PEER_ULOAD(u0, 0, 0); PEER_ULOAD(u1, 0, 1);
            for (int i = 0; i < 42; ++i) {
                PEER_XLOAD(x1, 3 * i + 1); PEER_ULOAD(u2, 3 * i + 1, 0); PEER_UCOMP(u0, x0, 3 * i + 0, 0);
                PEER_ULOAD(u0, 3 * i + 1, 1); PEER_UCOMP(u1, x0, 3 * i + 0, 1);
                PEER_XLOAD(x2, 3 * i + 2); PEER_ULOAD(u1, 3 * i + 2, 0); PEER_UCOMP(u2, x1, 3 * i + 1, 0);
                PEER_ULOAD(u2, 3 * i + 2, 1); PEER_UCOMP(u0, x1, 3 * i + 1, 1);
                PEER_XLOAD(x0, 3 * i + 3); PEER_ULOAD(u0, 3 * i + 3, 0); PEER_UCOMP(u1, x2, 3 * i + 2, 0);
                PEER_ULOAD(u1, 3 * i + 3, 1); PEER_UCOMP(u2, x2, 3 * i + 2, 1);
            }
            PEER_XLOAD(x1, 127); PEER_ULOAD(u2, 127, 0); PEER_UCOMP(u0, x0, 126, 0);
            PEER_ULOAD(u0, 127, 1); PEER_UCOMP(u1, x0, 126, 1);
            PEER_UCOMP(u2, x1, 127, 0);
            PEER_UCOMP(u0, x1, 127, 1);
        }
#undef PEER_ULOAD
#undef PEER_XLOAD
#undef PEER_UCOMP
        }
        asm volatile("s_waitcnt lgkmcnt(0)" ::: "memory");
        for (int tk = 0; tk < TOK_PER_WAVE; ++tk) { const int t = T0 + tk; const float cs = tokf[tk * 2];
            float w[2];
#pragma unroll
            for (int hf = 0; hf < 2; ++hf) { const int k = lane + 64 * hf; const unsigned e = idxl[tk * 128 + k];
                const float z = (float)zw[tk * 128 + k] * (SU[e] * cs);
                w[hf] = GATE[(size_t)t * 128 + k] * gelu_erf(z) * SV[e]; }
            const float wm = wave_max(fmaxf(fabsf(w[0]), fabsf(w[1]))), winv = wm > 0.f ? 127.f / wm : 0.f;
            asm volatile("s_waitcnt lgkmcnt(0)" ::: "memory");
            LAS signed char* wpb = (LAS signed char*)(zw + tk * 128);
            wpb[lane] = (signed char)(int)rintf(w[0] * winv); wpb[64 + lane] = (signed char)(int)rintf(w[1] * winv);
            if (lane == 0) tokf[tk * 2 + 1] = wm * (1.f / 127.f); }
        asm volatile("s_waitcnt lgkmcnt(0)" ::: "memory");
        {   const int g = lane >> 3, i8 = lane & 7; const unsigned lo16 = (unsigned)i8 << 4;
#define PEER_DLOAD(QB, WP, qi) do { const int s_ = (qi) >> 6, tok_ = 8 * (((qi) >> 5) & 1) + g, q_ = (qi) & 31; \
            const u32x2 id_ = *(LAS const u32x2*)(idxl + tok_ * 128 + 4 * q_); WP = zw[tok_ * 128 + q_]; const unsigned char* Vs_ = V8 + (size_t)s_ * SLICE_BYTES; \
            QB[0] = *(const u32x4*)(Vs_ + (((id_.x << 7) & 0x7fff80u) | lo16)); QB[1] = *(const u32x4*)(Vs_ + (((id_.x >> 9) & 0x7fff80u) | lo16)); \
            QB[2] = *(const u32x4*)(Vs_ + (((id_.y << 7) & 0x7fff80u) | lo16)); QB[3] = *(const u32x4*)(Vs_ + (((id_.y >> 9) & 0x7fff80u) | lo16)); } while (0)
#define PEER_DACC(QB, WP) do { \
            _Pragma("unroll") for (int j = 0; j < 4; ++j) { const unsigned A_ = QB[0][j], B_ = QB[1][j], C_ = QB[2][j], D_ = QB[3][j]; \
                const unsigned t0 = __builtin_amdgcn_perm(B_, A_, 0x05010400u), t1 = __builtin_amdgcn_perm(B_, A_, 0x07030602u); \
                const unsigned u0 = __builtin_amdgcn_perm(D_, C_, 0x05010400u), u1 = __builtin_amdgcn_perm(D_, C_, 0x07030602u); \
                acc[4 * j + 0] = __builtin_amdgcn_sdot4((int)__builtin_amdgcn_perm(u0, t0, 0x05040100u), WP, acc[4 * j + 0], false); \
                acc[4 * j + 1] = __builtin_amdgcn_sdot4((int)__builtin_amdgcn_perm(u0, t0, 0x07060302u), WP, acc[4 * j + 1], false); \
                acc[4 * j + 2] = __builtin_amdgcn_sdot4((int)__builtin_amdgcn_perm(u1, t1, 0x05040100u), WP, acc[4 * j + 2], false); \
                acc[4 * j + 3] = __builtin_amdgcn_sdot4((int)__builtin_amdgcn_perm(u1, t1, 0x07060302u), WP, acc[4 * j + 3], false); } } while (0)
#define PEER_DX2(qi) do { const int s_ = (qi) >> 6, tok_ = 8 * (((qi) >> 5) & 1) + g; const bf16* xp_ = X2B + (size_t)(T0 + tok_) * D + 128 * s_ + 16 * i8; \
            x2a = *(const u32x4*)xp_; x2b = *(const u32x4*)(xp_ + 8); } while (0)
#define PEER_DFIN(qi) do { const int s_ = (qi) >> 6, tok_ = 8 * (((qi) >> 5) & 1) + g; const float wsc = tokf[tok_ * 2 + 1]; float ssq = 0.f; u32x4 oa, ob; \
            _Pragma("unroll") for (int j = 0; j < 4; ++j) { const unsigned w_ = x2a[j]; const float f0 = bf_lo(w_) + (float)acc[2 * j] * wsc, f1 = bf_hi(w_) + (float)acc[2 * j + 1] * wsc; ssq += f0 * f0 + f1 * f1; oa[j] = pk2(f0, f1); } \
            _Pragma("unroll") for (int j = 0; j < 4; ++j) { const unsigned w_ = x2b[j]; const float f0 = bf_lo(w_) + (float)acc[8 + 2 * j] * wsc, f1 = bf_hi(w_) + (float)acc[8 + 2 * j + 1] * wsc; ssq += f0 * f0 + f1 * f1; ob[j] = pk2(f0, f1); } \
            bf16* xp_ = X2B + (size_t)(T0 + tok_) * D + 128 * s_ + 16 * i8; *(u32x4*)xp_ = oa; *(u32x4*)(xp_ + 8) = ob; \
            __hip_atomic_fetch_add(ssl + tok_ * 8 + i8, ssq, __ATOMIC_RELAXED, __HIP_MEMORY_SCOPE_WORKGROUP); } while (0)
            u32x4 q0[4], q1[4], q2[4], q3[4], q4[4], q5[4], q6[4], q7[4], x2a, x2b; int w0, w1, w2, w3, w4, w5, w6, w7, acc[16];
            PEER_DLOAD(q0, w0, 0); PEER_DLOAD(q1, w1, 1); PEER_DLOAD(q2, w2, 2); PEER_DLOAD(q3, w3, 3); PEER_DLOAD(q4, w4, 4); PEER_DLOAD(q5, w5, 5); PEER_DLOAD(q6, w6, 6);
            for (int i = 0; i < 512 / 8 - 1; ++i) {
                const int qi = 8 * i;
                if ((i & 3) == 0) {
#pragma unroll
                    for (int c = 0; c < 16; ++c) acc[c] = 0; }
                if ((i & 3) == 3) PEER_DX2(qi);
                PEER_DLOAD(q7, w7, qi + 7); PEER_DACC(q0, w0); PEER_DLOAD(q0, w0, qi + 8); PEER_DACC(q1, w1); PEER_DLOAD(q1, w1, qi + 9); PEER_DACC(q2, w2); PEER_DLOAD(q2, w2, qi + 10); PEER_DACC(q3, w3); PEER_DLOAD(q3, w3, qi + 11); PEER_DACC(q4, w4); PEER_DLOAD(q4, w4, qi + 12); PEER_DACC(q5, w5); PEER_DLOAD(q5, w5, qi + 13); PEER_DACC(q6, w6); PEER_DLOAD(q6, w6, qi + 14); PEER_DACC(q7, w7);
                if ((i & 3) == 3) PEER_DFIN(qi);
            }
            PEER_DX2(504); PEER_DLOAD(q7, w7, 511); PEER_DACC(q0, w0); PEER_DACC(q1, w1); PEER_DACC(q2, w2); PEER_DACC(q3, w3); PEER_DACC(q4, w4); PEER_DACC(q5, w5); PEER_DACC(q6, w6); PEER_DACC(q7, w7); PEER_DFIN(504);
#undef PEER_DLOAD
#undef PEER_DACC
#undef PEER_DX2
#undef PEER_DFIN
#undef PEER_DSTEP
        }
        asm volatile("s_waitcnt vmcnt(0) lgkmcnt(0)" ::: "memory");
        {   f32x4 gg[4];
#pragma unroll
            for (int j = 0; j < 4; ++j) gg[j] = ((const f32x4*)g_final)[lane + 64 * j];
            for (int tk4 = 0; tk4 < TOK_PER_WAVE; tk4 += 4) { u32x2 xb[4][4];
#pragma unroll
                for (int u = 0; u < 4; ++u)
#pragma unroll
                    for (int j = 0; j < 4; ++j) xb[u][j] = *(const u32x2*)(X2B + (size_t)(T0 + tk4 + u) * D + 4 * (lane + 64 * j));
#pragma unroll
                for (int u = 0; u < 4; ++u) { const int tk = tk4 + u, t = T0 + tk;
                    float sq = ssl[tk * 8 + (lane & 7)]; sq += dpp_mov<0xB1>(sq); sq += dpp_mov<0x4E>(sq); sq += dpp_mov<0x141>(sq);
                    const float r3 = rsqrtf(sq * (1.f / D) + 1e-6f);
#pragma unroll
                    for (int j = 0; j < 4; ++j) { const u32x2 w_ = xb[u][j]; const f32x4 x3 = (f32x4){bf_lo(w_.x), bf_hi(w_.x), bf_lo(w_.y), bf_hi(w_.y)};
                        *((f32x4*)(out + (size_t)t * D) + lane + 64 * j) = x3 * gg[j] * r3; } } } }
    }
}
}
namespace topk {
typedef short bf16x8 __attribute__((ext_vector_type(8)));
typedef float f32x16 __attribute__((ext_vector_type(16)));
typedef unsigned u32x4 __attribute__((ext_vector_type(4)));
constexpr int SKROW = 272;
__device__ __forceinline__ float fmax_(float a, float b) { float t; asm("v_max_f32 %0, %1, %2" : "=v"(t) : "v"(a), "v"(b)); return t; }
__device__ __forceinline__ void cswap(float& a, float& b) { float t, u; asm("v_max_f32 %0, %1, %2" : "=v"(t) : "v"(a), "v"(b)); asm("v_min_f32 %0, %1, %2" : "=v"(u) : "v"(a), "v"(b)); a = t; b = u; }
__device__ __forceinline__ void merge16(float (&c)[16]) {
#pragma unroll
    for (int j = 8; j > 0; j >>= 1)
#pragma unroll
        for (int i = 0; i < 16; ++i) { const int l = i ^ j; if (l > i) cswap(c[i], c[l]); }
}
__device__ __forceinline__ void sort16(float (&v)[16]) {
    constexpr int SA[60] = {0,1,2,3,4,5,7,9, 0,1,2,3,6,8,10,11, 0,2,4,6,7,10,12,14, 0,1,4,5,6,8,12,13, 1,3,4,5,8,9,13, 1,2,5,7,9,11, 2,3,9,11, 3,6,7,10, 3,5,7,9,11, 6,8};
    constexpr int SB[60] = {13,12,15,14,8,6,11,10, 5,7,9,4,13,14,15,12, 1,3,5,8,9,11,13,15, 2,3,10,11,7,9,14,15, 2,12,6,7,10,11,14, 4,6,8,10,13,14, 4,6,12,13, 5,8,9,12, 4,6,8,10,12, 7,9};
#pragma unroll
    for (int i = 0; i < 60; ++i) cswap(v[SA[i]], v[SB[i]]);
}
__device__ __forceinline__ void topmerge(float (&a)[16], const float (&b)[16]) {
#pragma unroll
    for (int i = 0; i < 16; ++i) a[i] = fmax_(a[i], b[15 - i]);
    merge16(a);
}
__device__ __forceinline__ void insert16(float (&a)[16], float x) {
#pragma unroll
    for (int i = 0; i < 16; ++i) cswap(a[i], x);
}
__device__ __forceinline__ float cand(float a, float b, unsigned ca, unsigned cb) { return __builtin_bit_cast(float, (__builtin_bit_cast(unsigned, a + b) & ~0x3fffu) | ca | cb); }

__device__ __forceinline__ void qhalf_load(u32x4 (&q)[8], const bf16* QPw, int lane) {
#pragma unroll
    for (int j = 0; j < 8; ++j) q[j] = *(const u32x4*)(QPw + (size_t)(4 * j + (lane >> 4)) * NQ + (lane & 15) * 8);
}
__device__ __forceinline__ void qhalf_stage(const u32x4 (&q)[8], LAS unsigned char* qst, int lane) {
#pragma unroll
    for (int j = 0; j < 8; ++j) *(LAS u32x4*)(qst + (4 * j + (lane >> 4)) * SKROW + (lane & 15) * 16) = q[j];
}
__device__ __forceinline__ void half_top16(float (&e)[16], LAS const unsigned char* qst, LAS const unsigned char* sk, int ql, int hh) {
    unsigned qoff = (unsigned)(ql * SKROW + hh * 16);
    float m0[16], m1[16];
#pragma unroll
    for (int kt = 0; kt < 4; ++kt) { f32x16 acc = {}; float v[16];
        asm volatile("" : "+v"(qoff));
#pragma unroll
        for (int ks = 0; ks < 8; ++ks) { const bf16x8 af = *(LAS const bf16x8*)(sk + (32 * kt + ql) * SKROW + ks * 32 + hh * 16);
            const bf16x8 bfr = *(LAS const bf16x8*)(qst + qoff + ks * 32);
            acc = __builtin_amdgcn_mfma_f32_32x32x16_bf16(af, bfr, acc, 0, 0, 0); }
#pragma unroll
        for (int rr = 0; rr < 16; ++rr) { const unsigned key = (unsigned)(32 * kt + (rr & 3) + 8 * (rr >> 2)) + 4u * (unsigned)hh;
            const float fv = acc[rr];
            v[rr] = __builtin_bit_cast(float, (__builtin_bit_cast(unsigned, fv) & ~0x7fu) | key); }
        sort16(v);
        if (kt == 0) {
#pragma unroll
            for (int i = 0; i < 16; ++i) m0[i] = v[i]; }
        else if (kt == 1) topmerge(m0, v);
        else if (kt == 2) {
#pragma unroll
            for (int i = 0; i < 16; ++i) m1[i] = v[i]; }
        else topmerge(m1, v); }
    topmerge(m0, m1);
#pragma unroll
    for (int i = 0; i < 16; ++i) { const unsigned x = __builtin_bit_cast(unsigned, m0[15 - i]);
        const auto rr = __builtin_amdgcn_permlane32_swap(x, x, false, false);
        const unsigned lo_ = rr[0], hi_ = rr[1];
        e[i] = fmax_(m0[i], __builtin_bit_cast(float, hh ? lo_ : hi_)); }
    merge16(e);
}

__device__ __forceinline__ void topk_phase(const Args& a, LAS unsigned char* lds, int bx, int G, int tid) {
    unsigned char* ws = a.ws;
    const int lane = tid & 63, wave = __builtin_amdgcn_readfirstlane(tid >> 6);
    const bf16* QP = (const bf16*)(ws + WS_QP); const bf16* SK = (const bf16*)(ws + WS_SK);
    unsigned short* IDX = (unsigned short*)(ws + WS_IDX); float* GATE = (float*)(ws + WS_GATE);
    const float* pu = a.in[9]; const float* pv = a.in[10]; const float* g_ffn = a.in[6];
    signed char* U8 = (signed char*)(ws + WS_U8); signed char* V8 = (signed char*)(ws + WS_V8); float* SU = (float*)(ws + WS_SU); float* SV = (float*)(ws + WS_SV);
    pg8::StaticOrder So; So.init(M, NQ, G, bx); pg8::Unit un;
    int h_staged = -1;
    int nun = 0; while (So.next(nun, un)) ++nun;
    const int ne = (nun + 1) >> 1;
    LAS unsigned char* qst = lds + 256 * SKROW + wave * (32 * SKROW);
    u32x4 qa[8], qb[8];
    if (nun > 0) { So.next(0, un); qhalf_load(qa, QP + (size_t)(256 * un.pm + 32 * wave) * NQ + un.pn * 256, lane); }
    for (int uo = 0; uo < nun; ++uo) {
        const int ui = uo < ne ? 2 * uo : 2 * (uo - ne) + 1; So.next(ui, un);
        const int h = un.pn, tt = un.pm;
        int lane_ = lane; asm volatile("" : "+v"(lane_));
        const int ql = lane_ & 31, hh = lane_ >> 5, tid_ = wave * 64 + lane_;
        const int er0 = ((ui * G + bx) * 8 + wave) * 2;
        if (h != h_staged) {
            __syncthreads();
#pragma unroll
            for (int j = 0; j < 8; ++j) { const int id = tid_ + 512 * j, row = id >> 4, ch = id & 15;
                const u32x4 v = *(const u32x4*)(SK + ((size_t)h * 256 + row) * 128 + ch * 8); *(LAS u32x4*)(lds + row * SKROW + ch * 16) = v; }
            __syncthreads(); h_staged = h;
        }
        const int t = 256 * tt + 32 * wave + ql;
        const bf16* QPw = QP + (size_t)(256 * tt + 32 * wave) * NQ + h * 256;
        float A[16], B[16];
        f32x4 rw[4];
        qhalf_stage(qa, qst, lane_);
        qhalf_load(qb, QPw + 128, lane_);
        quant_row_load(pu + (size_t)er0 * D, rw, lane_);
        half_top16(A, qst, lds, ql, hh);
        quant_row_finish(rw, g_ffn, U8 + (size_t)er0 * 128, SU + er0, lane_);
        qhalf_stage(qb, qst, lane_);
        if (uo + 1 < nun) { const int un_ = uo + 1, ui2 = un_ < ne ? 2 * un_ : 2 * (un_ - ne) + 1; pg8::Unit u2; So.next(ui2, u2);
            qhalf_load(qa, QP + (size_t)(256 * u2.pm + 32 * wave) * NQ + u2.pn * 256, lane_); }
        quant_row_load(pv + (size_t)er0 * D, rw, lane_);
        half_top16(B, qst, lds + 128 * SKROW, ql, hh);
        quant_row_finish(rw, nullptr, V8 + (size_t)er0 * 128, SV + er0, lane_);
        f32x4 rw2[4];
        quant_row_load(pu + (size_t)(er0 + 1) * D, rw, lane_); quant_row_load(pv + (size_t)(er0 + 1) * D, rw2, lane_);
        unsigned ca[16], cb[16];
#pragma unroll
        for (int i = 0; i < 16; ++i) { ca[i] = (__builtin_bit_cast(unsigned, A[i]) & 0x7fu) << 7; cb[i] = __builtin_bit_cast(unsigned, B[i]) & 0x7fu; }
        float X0[16], X1[16], X2[16];
#pragma unroll
        for (int j = 0; j < 16; ++j) X0[j] = cand(A[0], B[j], ca[0], cb[j]);
#pragma unroll
        for (int j = 0; j < 8; ++j) X1[j] = cand(A[1], B[j], ca[1], cb[j]);
#pragma unroll
        for (int j = 0; j < 5; ++j) X1[8 + j] = cand(A[2], B[j], ca[2], cb[j]);
#pragma unroll
        for (int j = 0; j < 3; ++j) X1[13 + j] = cand(A[4], B[j], ca[4], cb[j]);
#pragma unroll
        for (int j = 0; j < 4; ++j) X2[j] = cand(A[3], B[j], ca[3], cb[j]);
#pragma unroll
        for (int i = 5; i < 8; ++i)
#pragma unroll
            for (int j = 0; j < 2; ++j) X2[4 + 2 * (i - 5) + j] = cand(A[i], B[j], ca[i], cb[j]);
#pragma unroll
        for (int i = 8; i < 14; ++i) X2[10 + (i - 8)] = cand(A[i], B[0], ca[i], cb[0]);
        const float x14 = cand(A[14], B[0], ca[14], cb[0]), x15 = cand(A[15], B[0], ca[15], cb[0]);
        sort16(X1); sort16(X2);
        topmerge(X1, X2); topmerge(X0, X1); insert16(X0, x14); insert16(X0, x15);
        float sc[16]; float den = 0.f;
#pragma unroll
        for (int i = 0; i < 16; ++i) { sc[i] = __builtin_bit_cast(float, __builtin_bit_cast(unsigned, X0[i]) & ~0x3fffu); }
        const float m0 = sc[0];
#pragma unroll
        for (int i = 0; i < 16; ++i) { sc[i] = __expf(sc[i] - m0); den += sc[i]; }
        const float rd = 1.f / den;
        if (hh == 0) { u32x4 w0, w1;
#pragma unroll
            for (int i = 0; i < 4; ++i) { w0[i] = (__builtin_bit_cast(unsigned, X0[2 * i]) & 0x3fffu) | ((__builtin_bit_cast(unsigned, X0[2 * i + 1]) & 0x3fffu) << 16);
                w1[i] = (__builtin_bit_cast(unsigned, X0[8 + 2 * i]) & 0x3fffu) | ((__builtin_bit_cast(unsigned, X0[8 + 2 * i + 1]) & 0x3fffu) << 16); }
            u32x4* ip = (u32x4*)(IDX + (size_t)t * 128 + h * 16); ip[0] = w0; ip[1] = w1;
        } else { f32x4* gp = (f32x4*)(GATE + (size_t)t * 128 + h * 16);
#pragma unroll
            for (int i = 0; i < 4; ++i) gp[i] = (f32x4){sc[4 * i] * rd, sc[4 * i + 1] * rd, sc[4 * i + 2] * rd, sc[4 * i + 3] * rd}; }
        quant_row_finish(rw, g_ffn, U8 + (size_t)(er0 + 1) * 128, SU + er0 + 1, lane_); quant_row_finish(rw2, nullptr, V8 + (size_t)(er0 + 1) * 128, SV + er0 + 1, lane_);
    }
    __syncthreads();
}
}
__global__ void __launch_bounds__(NWAVES * 64, 2) mega_fwd(Args a) {
    extern __shared__ __attribute__((aligned(16))) unsigned char lds_raw[];
    LAS unsigned char* lds = (LAS unsigned char*)lds_raw;
    volatile LAS unsigned* MISC = (volatile LAS unsigned*)(lds + MISC_OFF);
    const int wave = __builtin_amdgcn_readfirstlane((int)threadIdx.x >> 6);
#define TID_NOW (wave * 64 + lane_now())
    const int G = gridDim.x, bx = blockIdx.x, vcu = (G % 8 == 0) ? (bx % 8) * (G / 8) + bx / 8 : bx;
    unsigned char* ws = a.ws;
    if (threadIdx.x < 32) ((LAS unsigned*)(lds + LDSCTL_OFF))[threadIdx.x] = 0u;
    __syncthreads();
    XcdBarrier bar = xcd_barrier_post((unsigned*)(ws + WS_CTL) + CW_BAR + a.li * XCD_BAR_WORDS, MISC + 8);
    const int lo = a.ph_lo, hi = a.ph_hi;
#define IN(k) (lo <= (k) && (k) < hi)
#define BOTH(k) (IN(k) && IN((k) + 1))
    if (IN(0)) { p0_prologue(a, lds, vcu * NWAVES + wave, G * NWAVES, wave, lane_now()); if (BOTH(0)) xcd_barrier(bar, wave); }
    if (IN(1)) {
        pg8::Gemm g{(const bf16*)(ws + WS_XN), (const bf16*)(ws + WS_WIN), M, NPROJ, D / 2}; pg8::StaticOrder So; So.init(M, NPROJ, G, bx);
        pg8::EpiInProj E{(bf16*)(ws + WS_P), (bf16*)(ws + WS_Q), (size_t)(WS_K - WS_Q) / 2, (const float*)(ws + WS_SA), (const float*)(ws + WS_SWIN)};
        pg8::gemm_phase<pg8::EpiInProj, pg8::StaticOrder, true, true, true>(lds, g, So, E, wave);
        if (BOTH(1)) xcd_barrier(bar, wave);
    }
    if (IN(2)) { attn::attn_phase(ws, lds, vcu, G, TID_NOW); if (BOTH(2)) xcd_barrier(bar, wave); }
    if (IN(3)) { mixp::mix_phase(a, lds, vcu * NWAVES + wave, G * NWAVES, wave, lane_now()); if (BOTH(3)) xcd_barrier(bar, wave); }
    if (IN(4)) {
        pg8::Gemm g{(const bf16*)(ws + WS_MIXIN), (const bf16*)(ws + WS_WOUT), M, D, D}; pg8::StaticOrder So; So.init(M, D, G, bx);
        pg8::EpiOutProj E{a.in[0], (bf16*)(ws + WS_XN), (float*)(ws + WS_ROWSS)};
        pg8::gemm_phase<pg8::EpiOutProj, pg8::StaticOrder, true, true>(lds, g, So, E, wave);
        if (BOTH(4)) xcd_barrier(bar, wave);
    }
    if (IN(5)) {
        pg8::Gemm g{(const bf16*)(ws + WS_XN), (const bf16*)(ws + WS_WQ), M, NQ, D}; pg8::StaticOrder So; So.init(M, NQ, G, bx);
        pg8::EpiPeerQ E{(bf16*)(ws + WS_QP), (const float*)(ws + WS_ROWSS)};
        pg8::gemm_phase<pg8::EpiPeerQ, pg8::StaticOrder, true, true>(lds, g, So, E, wave);
    }
    if (IN(6)) { topk::topk_phase(a, lds, bx, G, TID_NOW); if (BOTH(6)) xcd_barrier(bar, wave); }
    if (IN(7)) { peer::gather_phase(a, lds, vcu, G, wave, lane_now()); }
#undef IN
#undef BOTH
#undef TID_NOW
}
extern "C" void kernel_launch(void* const* d_in, const int* in_sizes, int n_in, void* d_out, int out_size, void* d_ws, size_t ws_size, hipStream_t stream) {
    static int grid = 0;
    if (grid == 0) {
        if (n_in != 12 || in_sizes[0] != M * D || out_size != M * D || ws_size < WS_END) { fprintf(stderr, "kernel_launch: unexpected shapes (n_in %d, in0 %d, out %d, ws %zu)\n", n_in, n_in > 0 ? in_sizes[0] : -1, out_size, ws_size); grid = -1; return; }
        int dev = 0, cus = 0, per_cu = 0;
        if (hipGetDevice(&dev) != hipSuccess || hipDeviceGetAttribute(&cus, hipDeviceAttributeMultiprocessorCount, dev) != hipSuccess) { fprintf(stderr, "kernel_launch: device query failed\n"); grid = -1; return; }
        if (hipFuncSetAttribute((const void*)mega_fwd, hipFuncAttributeMaxDynamicSharedMemorySize, LDS_BYTES) != hipSuccess) { fprintf(stderr, "kernel_launch: hipFuncSetAttribute failed\n"); grid = -1; return; }
        if (hipOccupancyMaxActiveBlocksPerMultiprocessor(&per_cu, (const void*)mega_fwd, NWAVES * 64, LDS_BYTES) != hipSuccess || per_cu < 1) { fprintf(stderr, "kernel_launch: occupancy query says %d blocks per CU\n", per_cu); grid = -1; (void)hipGetLastError(); return; }
        grid = cus;
    }
    if (grid < 0) return;
    (void)hipMemsetAsync((char*)d_ws + WS_CTL + CW_BAR * 4, 0, (CW_END - CW_BAR) * 4, stream);
    Args a{};
    for (int i = 0; i < 12; ++i) a.in[i] = (const float*)d_in[i];
    a.out = (float*)d_out; a.ws = (unsigned char*)d_ws; a.ph_lo = 0; a.ph_hi = 8; a.li = 0;
    hipLaunchKernelGGL(mega_fwd, dim3(grid), dim3(NWAVES * 64), LDS_BYTES, stream, a);
#ifdef PROBE_LO
    a.ph_lo = PROBE_LO; a.ph_hi = PROBE_HI; a.li = 1;
    hipLaunchKernelGGL(mega_fwd, dim3(grid), dim3(NWAVES * 64), LDS_BYTES, stream, a);
#endif
}
```

```cpp
#include <hip/hip_runtime.h>
#include <cstdio>
#include <cstdint>
__device__ __forceinline__ int lane_now() { int l; asm volatile("v_mbcnt_lo_u32_b32 %0, -1, 0\n\tv_mbcnt_hi_u32_b32 %0, -1, %0" : "=v"(l)); return l; }
namespace pg8 {
#define PG8_LAS __attribute__((address_space(3)))
typedef unsigned short bf16_t;
typedef short bf16x8 __attribute__((ext_vector_type(8)));
typedef float f32x4 __attribute__((ext_vector_type(4)));
typedef unsigned u32x4 __attribute__((ext_vector_type(4)));
typedef int i32x4 __attribute__((ext_vector_type(4)));
constexpr int BM = 256, BK = 64, HALF = 128, HTB = HALF * BK * 2  , STAGE_BYTES = 8 * HTB, NXCD = 8, WGM = 8;

__host__ __device__ __forceinline__ int lds_byte(int r, int c) { const int st = (r >> 4) * 2 + (c >> 5), rr = r & 15, cc = c & 31, ob = rr * 64 + cc * 2; return st * 1024 + (ob ^ (((ob >> 9) & 1) << 5)); }
__host__ __device__ __forceinline__ void stage_rc(int b, int& R, int& C) { const int st = b / 1024, sb = b % 1024, swz = sb ^ (((sb >> 9) & 1) << 5); R = (st >> 1) * 16 + swz / 64; C = (st & 1) * 32 + (swz % 64) / 2; }
__host__ __device__ __forceinline__ int perm32(int rho) { const int n = rho >> 4, i = rho & 15; return 8 * (i >> 2) + 4 * n + (i & 3); }

struct Unit { int pm, pn; };
struct Gemm { const bf16_t* A; const bf16_t* Bt; int M, N, K; };

struct StaticOrder {
    int nM, nN, nwg, G, c;
    __host__ __device__ void init(int M, int N, int G_, int c_) { nM = M / BM; nN = N / BM; nwg = nM * nN; G = G_; c = c_; }
    __host__ __device__ bool next(int i, Unit& u) const {
        const long L = (long)i * G + c; if (L >= nwg) return false;
        int wgid = (int)L; { const int q = nwg / NXCD, r = nwg % NXCD, xcd = wgid % NXCD, off = wgid / NXCD; wgid = (xcd < r ? xcd * (q + 1) : r * (q + 1) + (xcd - r) * q) + off; }
        const int nig = WGM * nN, gid = wgid / nig, fm = gid * WGM, gsz = (nM - fm) < WGM ? (nM - fm) : WGM;
        u.pm = fm + ((wgid % nig) % gsz); u.pn = (wgid % nig) / gsz; return true;
    }
    __device__ __forceinline__ void a_ready(const Unit&) const {}
    __device__ __forceinline__ void done(const Unit&) const {}
};

__device__ __forceinline__ unsigned cvt_pk_bf16(float lo, float hi) { unsigned r; asm volatile("v_cvt_pk_bf16_f32 %0, %1, %2" : "=v"(r) : "v"(lo), "v"(hi)); return r; }
typedef unsigned u32x2 __attribute__((ext_vector_type(2)));
constexpr float C2Q = 0.125f * 1.4426950408889634f;
struct EpiInProj {
    static constexpr bool PERM = true, AFTER_DRAIN = false;
    bf16_t* P; bf16_t* QKV; size_t ty_stride; const float* sa; const float* sw;
    __device__ __forceinline__ void operator()(const f32x4 (&acc)[2][2][4][2], const Unit& u, int wr, int wc, int fr, int fq) const {
        const int row0 = u.pm * BM + wr * 64 + fr;
        f32x4 swv[2][2];
#pragma unroll
        for (int bj = 0; bj < 2; ++bj)
#pragma unroll
            for (int n = 0; n < 2; ++n) swv[bj][n] = *(const f32x4*)(sw + u.pn * BM + bj * HALF + wc * 32 + 8 * fq + 4 * n);
#define PG8_I2F(x) __builtin_convertvector(__builtin_bit_cast(i32x4, (x)), f32x4)
        if (u.pn == 0) {
#pragma unroll
            for (int ai = 0; ai < 2; ++ai)
#pragma unroll
                for (int m = 0; m < 4; ++m) { bf16_t* rowp = P + (size_t)(row0 + ai * HALF + m * 16) * 256 + wc * 32 + 8 * fq; const float sar = sa[row0 + ai * HALF + m * 16];
#pragma unroll
                    for (int bj = 0; bj < 2; ++bj) { const f32x4 v0 = PG8_I2F(acc[ai][bj][m][0]) * swv[bj][0] * sar, v1 = PG8_I2F(acc[ai][bj][m][1]) * swv[bj][1] * sar;
                        u32x4 w; w.x = cvt_pk_bf16(v0[0], v0[1]); w.y = cvt_pk_bf16(v0[2], v0[3]); w.z = cvt_pk_bf16(v1[0], v1[1]); w.w = cvt_pk_bf16(v1[2], v1[3]);
                        *(u32x4*)(rowp + bj * HALF) = w; } }
        } else {
            const int ty = (u.pn - 1) / 3, g = (u.pn - 1) % 3, sh = 2 * g;
            const float sc = (ty == 0) ? C2Q : 1.f;
            bf16_t* base = QKV + (size_t)ty * ty_stride;
#pragma unroll
            for (int ai = 0; ai < 2; ++ai)
#pragma unroll
                for (int m = 0; m < 4; ++m) { const int row = row0 + ai * HALF + m * 16, b = row >> 11, pos = row & 2047;
                    const int seqp = ((pos & ((1 << sh) - 1)) << (11 - sh)) | (pos >> sh); const float sar = sa[row] * sc;
#pragma unroll
                    for (int bj = 0; bj < 2; ++bj) { const int cl = bj * HALF + wc * 32 + 8 * fq, hd = 4 * g + (cl >> 6), c = cl & 63;
                        const f32x4 v0 = PG8_I2F(acc[ai][bj][m][0]) * swv[bj][0] * sar, v1 = PG8_I2F(acc[ai][bj][m][1]) * swv[bj][1] * sar;
                        u32x4 w; w.x = cvt_pk_bf16(v0[0], v0[1]); w.y = cvt_pk_bf16(v0[2], v0[3]); w.z = cvt_pk_bf16(v1[0], v1[1]); w.w = cvt_pk_bf16(v1[2], v1[3]);
                        *(u32x4*)(base + ((size_t)((b * 12 + hd) * 2048 + seqp)) * 64 + c) = w; } }
        }
#undef PG8_I2F
    }
};
struct EpiOutProj {
    static constexpr bool PERM = true, AFTER_DRAIN = false;
    const float* x; bf16_t* x2b; float* rowss;
    __device__ __forceinline__ void operator()(const f32x4 (&acc)[2][2][4][2], const Unit& u, int wr, int wc, int fr, int fq) const {
        const int col0 = u.pn * BM + wc * 32 + 8 * fq;
#pragma unroll
        for (int ai = 0; ai < 2; ++ai)
#pragma unroll
            for (int m = 0; m < 4; ++m) { const int row = u.pm * BM + ai * HALF + wr * 64 + m * 16 + fr; const size_t off = (size_t)row * 1024 + col0; float ss = 0.f;
#pragma unroll
                for (int bj = 0; bj < 2; ++bj) { const size_t o2 = off + bj * HALF;
                    const f32x4 o0 = *(const f32x4*)(x + o2) + acc[ai][bj][m][0], o1 = *(const f32x4*)(x + o2 + 4) + acc[ai][bj][m][1];
                    ss += ((o0[0] * o0[0] + o0[1] * o0[1]) + (o0[2] * o0[2] + o0[3] * o0[3])) + ((o1[0] * o1[0] + o1[1] * o1[1]) + (o1[2] * o1[2] + o1[3] * o1[3]));
                    u32x4 w; w.x = cvt_pk_bf16(o0[0], o0[1]); w.y = cvt_pk_bf16(o0[2], o0[3]); w.z = cvt_pk_bf16(o1[0], o1[1]); w.w = cvt_pk_bf16(o1[2], o1[3]);
                    *(u32x4*)(x2b + o2) = w; }
                ss += __shfl_xor(ss, 16); ss += __shfl_xor(ss, 32);
                if (fq == 0) atomicAdd(rowss + row, ss); }
    }
};
struct EpiPeerQ {
    static constexpr bool PERM = true, AFTER_DRAIN = false;
    bf16_t* O; const float* rowss;
    __device__ __forceinline__ void operator()(const f32x4 (&acc)[2][2][4][2], const Unit& u, int wr, int wc, int fr, int fq) const {
        const int row0 = u.pm * BM + wr * 64 + fr, col0 = u.pn * BM + wc * 32 + 8 * fq;
#pragma unroll
        for (int ai = 0; ai < 2; ++ai)
#pragma unroll
            for (int m = 0; m < 4; ++m) { const int row = row0 + ai * HALF + m * 16; const float rs = rsqrtf(rowss[row] * (1.f / 1024.f) + 1e-6f);
                bf16_t* rowp = O + (size_t)row * 2048 + col0;
#pragma unroll
                for (int bj = 0; bj < 2; ++bj) { const f32x4 v0 = acc[ai][bj][m][0] * rs, v1 = acc[ai][bj][m][1] * rs;
                    u32x4 w; w.x = cvt_pk_bf16(v0[0], v0[1]); w.y = cvt_pk_bf16(v0[2], v0[3]); w.z = cvt_pk_bf16(v1[0], v1[1]); w.w = cvt_pk_bf16(v1[2], v1[3]);
                    *(u32x4*)(rowp + bj * HALF) = w; } }
    }
};
template <class Epi, class Sched, bool ALIGN_EPI = false, bool SP2 = false, bool I8 = false>
__device__ __forceinline__ void gemm_phase(PG8_LAS unsigned char* lds, const Gemm g, const Sched& S, const Epi& E, int wid) {
    const int lane = lane_now(), tid = wid * 64 + lane, wr = wid >> 2, wc = wid & 3, fr = lane & 15, fq = lane >> 4;
    const int K = g.K, nt = K / BK;
    unsigned voffA[2], voffB[2];
#pragma unroll
    for (int i = 0; i < 2; ++i) { int R, C; stage_rc(tid * 16 + i * 8192, R, C); const int Rb = Epi::PERM ? ((R & ~31) + perm32(R & 31)) : R;
        voffA[i] = (unsigned)(R * K + C) * 2u; voffB[i] = (unsigned)(Rb * K + C) * 2u; }
    const size_t kstep = (size_t)(BK * 2);
    const size_t hstep = (size_t)HALF * K * 2;
    const size_t tstep = 2 * hstep;
    const unsigned ldsw = (unsigned)wid * 1024u;
    const int aoff = lds_byte(wr * 64 + fr, fq * 8), boff = lds_byte(wc * 32 + fr, fq * 8);
#define PG8_SA(b, h) (((b) * 2 + (h)) * HTB)
#define PG8_SB(b, h) ((4 + (b) * 2 + (h)) * HTB)
#define PG8_STAGE(bufoff, gbase, voff) do { _Pragma("unroll") for (int _i = 0; _i < 2; ++_i) \
        __builtin_amdgcn_global_load_lds((const unsigned*)((const char*)(gbase) + (voff)[_i]), (PG8_LAS unsigned*)(lds + (bufoff) + ldsw + _i * 8192), 16, 0, 0); } while (0)
#define PG8_LDA(dst, b, h) do { _Pragma("unroll") for (int m = 0; m < 4; ++m) _Pragma("unroll") for (int k = 0; k < 2; ++k) dst[m][k] = *(const PG8_LAS bf16x8*)(lds + PG8_SA(b, h) + aoff + m * 2048 + k * 1024); } while (0)
#define PG8_LDB(dst, b, h) do { _Pragma("unroll") for (int n = 0; n < 2; ++n) _Pragma("unroll") for (int k = 0; k < 2; ++k) dst[n][k] = *(const PG8_LAS bf16x8*)(lds + PG8_SB(b, h) + boff + n * 2048 + k * 1024); } while (0)
#define PG8_MMA(ai, bj, At, Bt) do { __builtin_amdgcn_s_setprio(1); _Pragma("unroll") for (int m = 0; m < 4; ++m) _Pragma("unroll") for (int n = 0; n < 2; ++n) _Pragma("unroll") for (int k = 0; k < 2; ++k) \
        { if constexpr (I8) acc[ai][bj][m][n] = __builtin_bit_cast(f32x4, __builtin_amdgcn_mfma_i32_16x16x64_i8(__builtin_bit_cast(i32x4, Bt[n][k]), __builtin_bit_cast(i32x4, At[m][k]), __builtin_bit_cast(i32x4, acc[ai][bj][m][n]), 0, 0, 0)); \
          else acc[ai][bj][m][n] = __builtin_amdgcn_mfma_f32_16x16x32_bf16(Bt[n][k], At[m][k], acc[ai][bj][m][n], 0, 0, 0); } __builtin_amdgcn_s_setprio(0); } while (0)
#define PG8_WAIT_V(n) asm volatile("s_waitcnt vmcnt(" #n ")" ::: "memory")
#define PG8_WAIT_L(n) asm volatile("s_waitcnt lgkmcnt(" #n ")" ::: "memory")
#define PG8_BAR __builtin_amdgcn_s_barrier()
#define PG8_SCHED __builtin_amdgcn_sched_barrier(0)
    Unit cur, nxt; int ui = 0;
    if (!S.next(0, cur)) return;
    f32x4 acc[2][2][4][2];
#pragma unroll
    for (int a = 0; a < 2; ++a)
#pragma unroll
        for (int b = 0; b < 2; ++b)
#pragma unroll
            for (int m = 0; m < 4; ++m)
#pragma unroll
                for (int n = 0; n < 2; ++n) acc[a][b][m][n] = (f32x4){0.f, 0.f, 0.f, 0.f};
    bf16x8 At[4][2], B0[2][2], B1[2][2];
    const char* cA = (const char*)g.A + (size_t)cur.pm * tstep; const char* cB = (const char*)g.Bt + (size_t)cur.pn * tstep;
    S.a_ready(cur);
    if constexpr (SP2) {
        PG8_STAGE(PG8_SB(0, 0), cB, voffB); PG8_STAGE(PG8_SB(0, 1), cB + hstep, voffB); PG8_STAGE(PG8_SA(0, 0), cA, voffA); PG8_STAGE(PG8_SA(0, 1), cA + hstep, voffA);
        if (wr == 1) PG8_BAR;
        PG8_WAIT_V(2); PG8_BAR;
        PG8_STAGE(PG8_SB(1, 0), cB + kstep, voffB); PG8_STAGE(PG8_SA(1, 0), cA + kstep, voffA); PG8_STAGE(PG8_SB(1, 1), cB + hstep + kstep, voffB);
        PG8_WAIT_V(6); PG8_BAR;
    } else {
        PG8_STAGE(PG8_SB(0, 0), cB, voffB); PG8_STAGE(PG8_SA(0, 0), cA, voffA); PG8_STAGE(PG8_SB(0, 1), cB + hstep, voffB); PG8_STAGE(PG8_SA(0, 1), cA + hstep, voffA);
        if (wr == 1) PG8_BAR;
        PG8_WAIT_V(4); PG8_BAR;
        PG8_STAGE(PG8_SB(1, 0), cB + kstep, voffB); PG8_STAGE(PG8_SA(1, 0), cA + kstep, voffA); PG8_STAGE(PG8_SB(1, 1), cB + hstep + kstep, voffB);
        PG8_WAIT_V(6); PG8_BAR;
    }
    for (;;) {
        const bool has_next = S.next(ui + 1, nxt);
        const char* nA = has_next ? (const char*)g.A + (size_t)nxt.pm * tstep : cA; const char* nB = has_next ? (const char*)g.Bt + (size_t)nxt.pn * tstep : cB;
        for (int t = 0; t < nt; t += 2) {
            const bool last = (t == nt - 2);
            const char* a1 = cA + (size_t)(t + 1) * kstep;
            const char* a2 = last ? nA : cA + (size_t)(t + 2) * kstep; const char* b2 = last ? nB : cB + (size_t)(t + 2) * kstep;
            const char* a3 = a2 + kstep; const char* b3 = b2 + kstep;
            if (last && has_next) S.a_ready(nxt);
            if constexpr (SP2) {
            PG8_LDB(B0, 0, 0); PG8_LDB(B1, 0, 1); PG8_SCHED; PG8_LDA(At, 0, 0); PG8_STAGE(PG8_SA(1, 1), a1 + hstep, voffA);
            PG8_WAIT_V(8); PG8_WAIT_L(0); PG8_BAR; PG8_MMA(0, 0, At, B0); PG8_MMA(0, 1, At, B1); PG8_BAR; PG8_SCHED;
            PG8_LDA(At, 0, 1); PG8_STAGE(PG8_SB(0, 0), b2, voffB); PG8_STAGE(PG8_SB(0, 1), b2 + hstep, voffB); PG8_STAGE(PG8_SA(0, 0), a2, voffA);
            PG8_WAIT_V(8); PG8_WAIT_L(0); PG8_BAR; PG8_MMA(1, 0, At, B0); PG8_MMA(1, 1, At, B1); PG8_BAR; PG8_SCHED;
            PG8_LDB(B0, 1, 0); PG8_LDB(B1, 1, 1); PG8_SCHED; PG8_LDA(At, 1, 0); PG8_STAGE(PG8_SA(0, 1), a2 + hstep, voffA);
            PG8_WAIT_V(8); PG8_WAIT_L(0); PG8_BAR; PG8_MMA(0, 0, At, B0); PG8_MMA(0, 1, At, B1); PG8_BAR; PG8_SCHED;
            PG8_LDA(At, 1, 1); PG8_STAGE(PG8_SB(1, 0), b3, voffB); PG8_STAGE(PG8_SB(1, 1), b3 + hstep, voffB); PG8_STAGE(PG8_SA(1, 0), a3, voffA);
            PG8_WAIT_V(8); PG8_WAIT_L(0); PG8_BAR; PG8_MMA(1, 0, At, B0); PG8_MMA(1, 1, At, B1); PG8_BAR; PG8_SCHED;
            } else {
            PG8_LDB(B0, 0, 0); PG8_SCHED; PG8_LDA(At, 0, 0); PG8_STAGE(PG8_SA(1, 1), a1 + hstep, voffA);
            PG8_WAIT_L(8); PG8_BAR; PG8_WAIT_L(0); PG8_MMA(0, 0, At, B0); PG8_BAR; PG8_SCHED;
            PG8_LDB(B1, 0, 1); PG8_STAGE(PG8_SB(0, 0), b2, voffB);
            PG8_BAR; PG8_WAIT_L(0); PG8_MMA(0, 1, At, B1); PG8_BAR;
            PG8_LDA(At, 0, 1); PG8_STAGE(PG8_SA(0, 0), a2, voffA);
            PG8_BAR; PG8_WAIT_L(0); PG8_MMA(1, 0, At, B0); PG8_BAR; PG8_SCHED;
            PG8_STAGE(PG8_SB(0, 1), b2 + hstep, voffB);
            PG8_WAIT_V(6); PG8_BAR; PG8_MMA(1, 1, At, B1); PG8_BAR;
            PG8_LDB(B0, 1, 0); PG8_SCHED; PG8_LDA(At, 1, 0); PG8_STAGE(PG8_SA(0, 1), a2 + hstep, voffA);
            PG8_WAIT_L(8); PG8_BAR; PG8_WAIT_L(0); PG8_MMA(0, 0, At, B0); PG8_BAR; PG8_SCHED;
            PG8_LDB(B1, 1, 1); PG8_STAGE(PG8_SB(1, 0), b3, voffB);
            PG8_BAR; PG8_WAIT_L(0); PG8_MMA(0, 1, At, B1); PG8_BAR;
            PG8_LDA(At, 1, 1); PG8_STAGE(PG8_SA(1, 0), a3, voffA);
            PG8_BAR; PG8_WAIT_L(0); PG8_MMA(1, 0, At, B0); PG8_BAR; PG8_SCHED;
            PG8_STAGE(PG8_SB(1, 1), b3 + hstep, voffB);
            PG8_WAIT_V(6); PG8_BAR; PG8_MMA(1, 1, At, B1); PG8_BAR;
            }
        }
        if constexpr (ALIGN_EPI) { if (wr == 0) PG8_BAR; }
        if constexpr (!Epi::AFTER_DRAIN) { E(acc, cur, wr, wc, fr, fq); S.done(cur); }
        if (!has_next) break;
#pragma unroll
        for (int a = 0; a < 2; ++a)
#pragma unroll
            for (int b = 0; b < 2; ++b)
#pragma unroll
                for (int m = 0; m < 4; ++m)
#pragma unroll
                    for (int n = 0; n < 2; ++n) acc[a][b][m][n] = (f32x4){0.f, 0.f, 0.f, 0.f};
        cur = nxt; cA = nA; cB = nB; ++ui;
        if constexpr (ALIGN_EPI) { if (wr == 1) PG8_BAR; }
    }
    PG8_WAIT_V(0);
    if constexpr (!ALIGN_EPI) { if (wr == 0) PG8_BAR; }
    PG8_BAR;
    if constexpr (Epi::AFTER_DRAIN) { E.fused(acc, cur, wr, wc, fr, fq, lds, wid, lane); S.done(cur); }
#undef PG8_SA
#undef PG8_SB
#undef PG8_STAGE
#undef PG8_LDA
#undef PG8_LDB
#undef PG8_MMA
#undef PG8_WAIT_V
#undef PG8_WAIT_L
#undef PG8_BAR
#undef PG8_SCHED
}
}
constexpr int M = 32768, D = 1024, S = 2048;
constexpr int NPROJ = 2560, NQ = 2048, NEXP = 16384;
typedef unsigned short bf16;
constexpr size_t MiB = 1u << 20;
constexpr size_t WS_CTL = 0, CTL_ZERO_BYTES = 1 * MiB;
constexpr size_t WS_WIN = 2 * MiB, WS_WOUT = 8 * MiB, WS_WQ = 10 * MiB;
constexpr size_t WS_SK = 14 * MiB, WS_WPT = 14 * MiB + 512 * 1024;
constexpr size_t WS_SA = 15 * MiB + 640 * 1024, WS_SWIN = 15 * MiB + 768 * 1024;
constexpr size_t WS_SU = 15 * MiB, WS_SV = 15 * MiB + 64 * 1024, WS_ROWSS = 15 * MiB + 512 * 1024;
constexpr size_t WS_U8 = 16 * MiB, WS_V8 = 32 * MiB;
constexpr size_t WS_XN = 48 * MiB;
constexpr size_t WS_P = 112 * MiB;
constexpr size_t WS_Q = 128 * MiB, WS_K = 176 * MiB, WS_V = 224 * MiB;
constexpr size_t WS_ORAW = 272 * MiB, WS_LSE = 320 * MiB, WS_MIXIN = 322 * MiB, WS_END = 386 * MiB;
constexpr size_t WS_QP = 128 * MiB, WS_IDX = 256 * MiB, WS_GATE = 264 * MiB, WS_X8 = 280 * MiB;
constexpr size_t WS_PROJ = 386 * MiB;
constexpr int CW_BAR = 4096;
constexpr int CW_CMAX = CW_BAR + 2 * 3456, CW_CCNT = CW_CMAX + NPROJ, CW_END = CW_CCNT + NPROJ / 32;

constexpr int RING_BYTES = 147456;
constexpr int LDSCTL_OFF = RING_BYTES, MISC_OFF = LDSCTL_OFF;
constexpr int LDS_BYTES = RING_BYTES + 128;
constexpr int NWAVES = 8;

#define GAS __attribute__((address_space(1)))
#define LAS __attribute__((address_space(3)))
typedef unsigned v4u __attribute__((ext_vector_type(4)));
typedef float f32x4 __attribute__((ext_vector_type(4)));
typedef GAS unsigned gu32;
#define LDS_WAIT() asm volatile("s_waitcnt lgkmcnt(0)" ::: "memory")
#define VM_WAIT() asm volatile("s_waitcnt vmcnt(0)" ::: "memory")
__device__ __forceinline__ unsigned f2bf(float f) { unsigned u = __builtin_bit_cast(unsigned, f); return (u + 0x7fffu + ((u >> 16) & 1u)) >> 16; }
__device__ __forceinline__ unsigned pk2(float lo, float hi) { return f2bf(lo) | (f2bf(hi) << 16); }
__device__ __forceinline__ float bf2f(unsigned short b) { return __builtin_bit_cast(float, (unsigned)b << 16); }
template <int CTRL> __device__ __forceinline__ float dpp_mov(float v) { return __builtin_bit_cast(float, __builtin_amdgcn_mov_dpp(__builtin_bit_cast(int, v), CTRL, 0xF, 0xF, true)); }
__device__ __forceinline__ float lane_val(float v, int l) { return __builtin_bit_cast(float, __builtin_amdgcn_readlane(__builtin_bit_cast(int, v), l)); }
__device__ __forceinline__ float wave_sum(float v) {
    v += dpp_mov<0xB1>(v); v += dpp_mov<0x4E>(v); v += dpp_mov<0x141>(v); v += dpp_mov<0x140>(v);
    return (lane_val(v, 0) + lane_val(v, 16)) + (lane_val(v, 32) + lane_val(v, 48));
}
__device__ __forceinline__ float wave_max(float v) {
    v = fmaxf(v, dpp_mov<0xB1>(v)); v = fmaxf(v, dpp_mov<0x4E>(v)); v = fmaxf(v, dpp_mov<0x141>(v)); v = fmaxf(v, dpp_mov<0x140>(v));
    return fmaxf(fmaxf(lane_val(v, 0), lane_val(v, 16)), fmaxf(lane_val(v, 32), lane_val(v, 48)));
}
#define XB_TMO      128
#define XB_XCNT(j)  (256  + 64 * (j))
#define XB_XSUB(j)  (1280 + 64 * (j))
#define XB_XGEN(j)  (2304 + 64 * (j))
#define XB_TOP      3328
#define XB_TOPGEN   3392
#define XCD_BAR_WORDS 3456
#define XB_SPIN_CAP (1u << 18)

__device__ __forceinline__ unsigned xb_ld(unsigned* p)              { return __hip_atomic_load(p, __ATOMIC_RELAXED, __HIP_MEMORY_SCOPE_AGENT); }
__device__ __forceinline__ unsigned xb_add(unsigned* p, unsigned v) { return __hip_atomic_fetch_add(p, v, __ATOMIC_RELAXED, __HIP_MEMORY_SCOPE_AGENT); }
__device__ __forceinline__ unsigned xb_xcc_id() { return (unsigned)__builtin_amdgcn_s_getreg((3 << 11) | 20) & 0xFu; }
#define XB_SPIN(cond, bar) do { unsigned _sp = 0; while (cond) { __builtin_amdgcn_s_sleep(1); \
    if ((++_sp & 255u) == 0u) { if (xb_ld(&(bar)[XB_TMO])) break; if (_sp > XB_SPIN_CAP) { atomicAdd(&(bar)[XB_TMO], 1u); break; } } } } while (0)

struct XcdBarrier {
    unsigned* bar; unsigned x;
    volatile LAS unsigned* st;
};

__device__ __forceinline__ XcdBarrier xcd_barrier_post(unsigned* bar, volatile LAS unsigned* st) {
    XcdBarrier b; b.bar = bar; b.x = xb_xcc_id(); b.st = st;
    if (threadIdx.x == 0) (void)xb_add(&bar[XB_XCNT(b.x)], 1u);
    return b;
}
__device__ __forceinline__ void xcd_barrier_complete(unsigned* bar, unsigned x, unsigned& nloc, unsigned& nx) {
    const unsigned G = gridDim.x * gridDim.y * gridDim.z;
    unsigned sum, cnt, mine, sp = 0u;
    for (;;) {
        sum = 0u; cnt = 0u; mine = 0u;
#pragma unroll
        for (unsigned j = 0; j < 16; ++j) { const unsigned c = xb_ld(&bar[XB_XCNT(j)]); sum += c; cnt += (c > 0u) ? 1u : 0u; mine = (j == x) ? c : mine; }
        if (sum == G) break;
        __builtin_amdgcn_s_sleep(1);
        if ((++sp & 255u) == 0u) { if (xb_ld(&bar[XB_TMO])) break; if (sp > XB_SPIN_CAP) { atomicAdd(&bar[XB_TMO], 1u); break; } }
    }
    nloc = mine > 0u ? mine : 1u; nx = cnt > 0u ? cnt : 1u;
}

__device__ __forceinline__ void xcd_barrier(const XcdBarrier& b, int wave_) {
    asm volatile("s_waitcnt vmcnt(0)" ::: "memory");
    __syncthreads();
    if (wave_ == 0 && lane_now() == 0) {
        unsigned* bar = b.bar;
        __builtin_amdgcn_s_waitcnt(0);
        unsigned nloc = b.st[0], nx = b.st[1];
        if (nloc == 0u) { xcd_barrier_complete(bar, b.x, nloc, nx); b.st[0] = nloc; b.st[1] = nx; }
        const unsigned old = xb_add(&bar[XB_XSUB(b.x)], 1u);
        const unsigned gen = old / nloc;
        if (old + 1u == (gen + 1u) * nloc) {
            __builtin_amdgcn_fence(__ATOMIC_RELEASE, "agent");
            asm volatile("s_waitcnt vmcnt(0)" ::: "memory");
            const unsigned og = xb_add(&bar[XB_TOP], 1u);
            const unsigned tg = og / nx;
            if (og + 1u == (tg + 1u) * nx) xb_add(&bar[XB_TOPGEN], 1u);
            else XB_SPIN(xb_ld(&bar[XB_TOPGEN]) == tg, bar);
            __builtin_amdgcn_fence(__ATOMIC_ACQUIRE, "agent");
            xb_add(&bar[XB_XGEN(b.x)], 1u);
            asm volatile("s_waitcnt vmcnt(0)" ::: "memory");
        } else {
            XB_SPIN(xb_ld(&bar[XB_XGEN(b.x)]) == gen, bar);
            __builtin_amdgcn_fence(__ATOMIC_ACQUIRE, "agent");
            asm volatile("s_waitcnt vmcnt(0)" ::: "memory");
        }
    }
    __syncthreads();
}
struct Args { const float* in[12]; float* out; unsigned char* ws; int ph_lo, ph_hi, li, pad; };

__device__ __forceinline__ void p0_transpose_item(const float* W, int K, int N, bf16* WT, const float* kscale, LAS float* scr, int item, int lane) {
    const int nblk = N / 32, kb = item / nblk, nb = item % nblk, k0 = 64 * kb, n0 = 32 * nb;
#pragma unroll 8
    for (int i = 0; i < 32; ++i) { const int kk = 2 * i + (lane >> 5); float w = W[(size_t)(k0 + kk) * N + n0 + (lane & 31)]; if (kscale) w *= kscale[k0 + kk]; scr[kk * 33 + (lane & 31)] = w; }
    LDS_WAIT(); asm volatile("" ::: "memory");
    const int c = lane & 7;
#pragma unroll
    for (int j = 0; j < 4; ++j) { const int n = (lane >> 3) + 8 * j; const LAS float* s = scr + (8 * c) * 33 + n;
        v4u o; o.x = pk2(s[0 * 33], s[1 * 33]); o.y = pk2(s[2 * 33], s[3 * 33]); o.z = pk2(s[4 * 33], s[5 * 33]); o.w = pk2(s[6 * 33], s[7 * 33]);
        *(GAS v4u*)(WT + (size_t)(n0 + n) * K + k0 + 8 * c) = o; }
    LDS_WAIT(); asm volatile("" ::: "memory");
}
__device__ __forceinline__ void p0_quant_publish(const float* W, int N, unsigned* cmax, unsigned* ccnt, LAS float* scr, int item, int lane) {
    const int nblk = N / 32, kb = item / nblk, nb = item % nblk, k0 = 64 * kb, n0 = 32 * nb;
    float mx = 0.f;
#pragma unroll 8
    for (int i = 0; i < 32; ++i) { const int kk = 2 * i + (lane >> 5); const float w = W[(size_t)(k0 + kk) * N + n0 + (lane & 31)]; scr[kk * 33 + (lane & 31)] = w; mx = fmaxf(mx, fabsf(w)); }
    { const auto rr = __builtin_amdgcn_permlane32_swap(__builtin_bit_cast(unsigned, mx), __builtin_bit_cast(unsigned, mx), false, false);
      mx = fmaxf(__builtin_bit_cast(float, (unsigned)rr[0]), __builtin_bit_cast(float, (unsigned)rr[1])); }
    if (lane < 32) __hip_atomic_fetch_max(cmax + n0 + lane, __builtin_bit_cast(unsigned, mx), __ATOMIC_RELAXED, __HIP_MEMORY_SCOPE_AGENT);
    asm volatile("s_waitcnt vmcnt(0)" ::: "memory");
    if (lane == 0) __hip_atomic_fetch_add(ccnt + nb, 1u, __ATOMIC_RELAXED, __HIP_MEMORY_SCOPE_AGENT);
}
__device__ __forceinline__ void p0_quant_finish(int N, signed char* W8, float* sw, unsigned* cmax, unsigned* ccnt, LAS float* scr, int item, int lane) {
    const int nblk = N / 32, kb = item / nblk, nb = item % nblk, k0 = 64 * kb, n0 = 32 * nb;
    if (lane == 0) { unsigned sp = 0; while (__hip_atomic_load(ccnt + nb, __ATOMIC_RELAXED, __HIP_MEMORY_SCOPE_AGENT) < 16u) { __builtin_amdgcn_s_sleep(1); if (++sp > (1u << 22)) break; } }
    asm volatile("s_waitcnt vmcnt(0) lgkmcnt(0)" ::: "memory");
    __builtin_amdgcn_wave_barrier();
#pragma unroll
    for (int j = 0; j < 2; ++j) { const int n = 16 * j + (lane >> 2), ck = lane & 3;
        const float cm = __builtin_bit_cast(float, __hip_atomic_load(cmax + n0 + n, __ATOMIC_RELAXED, __HIP_MEMORY_SCOPE_AGENT));
        const float inv = cm > 0.f ? 127.f / cm : 0.f;
        if (kb == 0 && ck == 0) sw[n0 + n] = cm > 0.f ? cm * (1.f / 127.f) : 1.f;
        v4u o;
#pragma unroll
        for (int q = 0; q < 4; ++q) { const LAS float* sp_ = scr + (16 * ck + 4 * q) * 33 + n;
            const int a = (int)rintf(sp_[0] * inv), b = (int)rintf(sp_[33] * inv), c = (int)rintf(sp_[66] * inv), d = (int)rintf(sp_[99] * inv);
            o[q] = (unsigned)(a & 0xff) | ((unsigned)(b & 0xff) << 8) | ((unsigned)(c & 0xff) << 16) | ((unsigned)(d & 0xff) << 24); }
        *(GAS v4u*)(W8 + (size_t)(n0 + n) * 1024 + k0 + 16 * ck) = o; }
    LDS_WAIT(); asm volatile("" ::: "memory");
}
__device__ __forceinline__ void p0_quant_item(const float* W, int N, signed char* W8, float* sw, unsigned* cmax, unsigned* ccnt, LAS float* scr, int item, int lane) {
    p0_quant_publish(W, N, cmax, ccnt, scr, item, lane); p0_quant_finish(N, W8, sw, cmax, ccnt, scr, item, lane);
}
__device__ __forceinline__ void rms_row_to_bf16(const float* xrow, const float* g, bf16* orow, int lane) {
    const GAS f32x4* xr = (const GAS f32x4*)xrow + lane;
    f32x4 v[4]; float s = 0.f;
#pragma unroll
    for (int j = 0; j < 4; ++j) { v[j] = xr[64 * j]; s += (v[j].x * v[j].x + v[j].y * v[j].y) + (v[j].z * v[j].z + v[j].w * v[j].w); }
    const float r = rsqrtf(wave_sum(s) * (1.f / D) + 1e-6f);
    GAS unsigned long long* o8 = (GAS unsigned long long*)orow + lane;
#pragma unroll
    for (int j = 0; j < 4; ++j) { const f32x4 gg = ((const GAS f32x4*)g)[lane + 64 * j];
        o8[64 * j] = (unsigned long long)pk2(v[j].x * r * gg.x, v[j].y * r * gg.y) | ((unsigned long long)pk2(v[j].z * r * gg.z, v[j].w * r * gg.w) << 32); }
}
__device__ __forceinline__ void quant_row_i8(const float* src, const float* gsc, signed char* dst, float* scale_out, int lane) {
    const GAS f32x4* p = (const GAS f32x4*)src + 4 * lane;
    f32x4 v[4]; float amax = 0.f;
#pragma unroll
    for (int j = 0; j < 4; ++j) { v[j] = p[j]; if (gsc) v[j] = v[j] * ((const GAS f32x4*)gsc)[4 * lane + j];
        amax = fmaxf(amax, fmaxf(fmaxf(fabsf(v[j].x), fabsf(v[j].y)), fmaxf(fabsf(v[j].z), fabsf(v[j].w)))); }
    amax = wave_max(amax);
    const float inv = amax > 0.f ? 127.f / amax : 0.f;
    v4u w;
#pragma unroll
    for (int j = 0; j < 4; ++j) { const int a = (int)rintf(v[j].x * inv), b = (int)rintf(v[j].y * inv), c = (int)rintf(v[j].z * inv), d = (int)rintf(v[j].w * inv);
        w[j] = (unsigned)(a & 0xff) | ((unsigned)(b & 0xff) << 8) | ((unsigned)(c & 0xff) << 16) | ((unsigned)(d & 0xff) << 24); }
    *(GAS v4u*)(dst + (size_t)(lane >> 3) * ((size_t)NEXP * 128) + 16 * (lane & 7)) = w;
    if (lane == 0) *scale_out = amax > 0.f ? amax * (1.f / 127.f) : 1.f;
}
__device__ __forceinline__ void quant_row_load(const float* src, f32x4 (&v)[4], int lane) {
    const GAS f32x4* p = (const GAS f32x4*)src + 4 * lane;
#pragma unroll
    for (int j = 0; j < 4; ++j) v[j] = p[j];
}
__device__ __forceinline__ void quant_row_finish(f32x4 (&v)[4], const float* gsc, signed char* dst, float* scale_out, int lane) {
    float amax = 0.f;
#pragma unroll
    for (int j = 0; j < 4; ++j) { if (gsc) v[j] = v[j] * ((const GAS f32x4*)gsc)[4 * lane + j];
        amax = fmaxf(amax, fmaxf(fmaxf(fabsf(v[j].x), fabsf(v[j].y)), fmaxf(fabsf(v[j].z), fabsf(v[j].w)))); }
    amax = wave_max(amax);
    const float inv = amax > 0.f ? 127.f / amax : 0.f;
    v4u w;
#pragma unroll
    for (int j = 0; j < 4; ++j) { const int a = (int)rintf(v[j].x * inv), b = (int)rintf(v[j].y * inv), c = (int)rintf(v[j].z * inv), d = (int)rintf(v[j].w * inv);
        w[j] = (unsigned)(a & 0xff) | ((unsigned)(b & 0xff) << 8) | ((unsigned)(c & 0xff) << 16) | ((unsigned)(d & 0xff) << 24); }
    *(GAS v4u*)(dst + (size_t)(lane >> 3) * ((size_t)NEXP * 128) + 16 * (lane & 7)) = w;
    if (lane == 0) *scale_out = amax > 0.f ? amax * (1.f / 127.f) : 1.f;
}
__device__ __forceinline__ void p0_prologue(const Args& a, LAS unsigned char* lds, int gw, int NGW, int wave, int lane) {
    unsigned char* ws = a.ws;
    LAS float* scr = (LAS float*)(lds + wave * 17408);
    LAS float* scr2 = scr + 64 * 33;
    const float* w_in = a.in[2]; const float* w_pool = a.in[3]; const float* w_out = a.in[5]; const float* g_ffn = a.in[6]; const float* w_q = a.in[7];
    constexpr int I_IN = (D / 64) * (NPROJ / 32), I_OUT = (D / 64) * (D / 32), I_Q = (D / 64) * (NQ / 32), I_P = 4 * 2;
    constexpr int NITEMS = I_IN + I_OUT + I_Q + I_P;
    unsigned* cmax_ = (unsigned*)(ws + WS_CTL) + CW_CMAX; unsigned* ccnt_ = (unsigned*)(ws + WS_CTL) + CW_CCNT;
    const bool defer = gw < I_IN;
    if (defer) p0_quant_publish(w_in, NPROJ, cmax_, ccnt_, scr, gw, lane);
    for (int it = defer ? gw + NGW : gw; it < NITEMS; it += NGW) {
        int r = it;
        if (r < I_IN) { p0_quant_item(w_in, NPROJ, (signed char*)(ws + WS_WIN), (float*)(ws + WS_SWIN), cmax_, ccnt_, scr2, r, lane); continue; } r -= I_IN;
        if (r < I_OUT) { p0_transpose_item(w_out, D, D, (bf16*)(ws + WS_WOUT), nullptr, scr2, r, lane); continue; } r -= I_OUT;
        if (r < I_Q) { p0_transpose_item(w_q, D, NQ, (bf16*)(ws + WS_WQ), g_ffn, scr2, r, lane); continue; } r -= I_Q;
        p0_transpose_item(w_pool + (r >> 1) * 4096, 64, 64, (bf16*)(ws + WS_WPT) + (r >> 1) * 4096, nullptr, scr2, r & 1, lane);
    }
    constexpr int R_X = M, R_SK = 256, R_Z = 32, NROWS = R_X + R_SK + R_Z;
    for (int c4 = gw; c4 < R_X / 4; c4 += NGW) {
        const GAS f32x4* xr = (const GAS f32x4*)(a.in[0] + (size_t)c4 * 4 * D) + lane;
        f32x4 v[4][4]; float ssq[4];
#pragma unroll
        for (int rr = 0; rr < 4; ++rr)
#pragma unroll
            for (int j = 0; j < 4; ++j) v[rr][j] = xr[rr * (D / 4) + 64 * j];
#pragma unroll
        for (int rr = 0; rr < 4; ++rr) { float s_ = 0.f;
#pragma unroll
            for (int j = 0; j < 4; ++j) s_ += (v[rr][j].x * v[rr][j].x + v[rr][j].y * v[rr][j].y) + (v[rr][j].z * v[rr][j].z + v[rr][j].w * v[rr][j].w);
            ssq[rr] = s_; }
#pragma unroll
        for (int rr = 0; rr < 4; ++rr) ssq[rr] = wave_sum(ssq[rr]);
#pragma unroll
        for (int rr = 0; rr < 4; ++rr) { const float rs = rsqrtf(ssq[rr] * (1.f / D) + 1e-6f);
            GAS unsigned* o4 = (GAS unsigned*)((signed char*)(ws + WS_XN) + ((size_t)c4 * 4 + rr) * D) + lane;
            f32x4 y[4]; float am = 0.f;
#pragma unroll
            for (int j = 0; j < 4; ++j) { const f32x4 gg = ((const GAS f32x4*)a.in[1])[lane + 64 * j]; y[j] = v[rr][j] * gg * rs;
                am = fmaxf(am, fmaxf(fmaxf(fabsf(y[j].x), fabsf(y[j].y)), fmaxf(fabsf(y[j].z), fabsf(y[j].w)))); }
            am = wave_max(am); const float qi = am > 0.f ? 127.f / am : 0.f;
#pragma unroll
            for (int j = 0; j < 4; ++j) { const int q0 = (int)rintf(y[j].x * qi), q1 = (int)rintf(y[j].y * qi), q2 = (int)rintf(y[j].z * qi), q3 = (int)rintf(y[j].w * qi);
                o4[64 * j] = (unsigned)(q0 & 0xff) | ((unsigned)(q1 & 0xff) << 8) | ((unsigned)(q2 & 0xff) << 16) | ((unsigned)q3 << 24); }
            if (lane == 0) ((float*)(ws + WS_SA))[(size_t)c4 * 4 + rr] = am > 0.f ? am * (1.f / 127.f) : 1.f; }
    }
    for (int it = R_X + gw; it < NROWS; it += NGW) {
        int r = it - R_X;
        if (r < R_SK) { const GAS f32x4* p = (const GAS f32x4*)(a.in[8] + (size_t)r * 1024) + lane; GAS unsigned long long* o8 = (GAS unsigned long long*)((bf16*)(ws + WS_SK) + (size_t)r * 1024) + lane;
#pragma unroll
            for (int j = 0; j < 4; ++j) { const f32x4 v = p[64 * j]; o8[64 * j] = (unsigned long long)pk2(v.x, v.y) | ((unsigned long long)pk2(v.z, v.w) << 32); }
            continue; } r -= R_SK;
        { GAS f32x4* z = (GAS f32x4*)((float*)(ws + WS_ROWSS) + (size_t)r * 1024) + lane;
#pragma unroll
          for (int j = 0; j < 4; ++j) z[64 * j] = (f32x4){0.f, 0.f, 0.f, 0.f}; }
    }
    if (defer) p0_quant_finish(NPROJ, (signed char*)(ws + WS_WIN), (float*)(ws + WS_SWIN), cmax_, ccnt_, scr, gw, lane);
}
namespace attn {
typedef short bf16x8 __attribute__((ext_vector_type(8)));
typedef short s16x4 __attribute__((ext_vector_type(4)));
typedef float f32x16 __attribute__((ext_vector_type(16)));
typedef float f32x2_t __attribute__((ext_vector_type(2)));
typedef __bf16 bf16x2_t __attribute__((ext_vector_type(2)));
typedef unsigned u32x4 __attribute__((ext_vector_type(4)));
typedef unsigned u32x2 __attribute__((ext_vector_type(2)));
constexpr int KROW = 144;
constexpr int SLOT = 2 * 256 * KROW;
__device__ __forceinline__ unsigned cvtpk(float lo, float hi) { f32x2_t v = {lo, hi}; bf16x2_t b = __builtin_convertvector(v, bf16x2_t); return __builtin_bit_cast(unsigned, b); }
__device__ __forceinline__ s16x4 vtr(LAS const unsigned char* p) { return __builtin_bit_cast(s16x4, __builtin_amdgcn_ds_read_tr16_b64_v4i16((LAS s16x4*)p)); }

__device__ __forceinline__ void attn_phase(unsigned char* ws, LAS unsigned char* lds, int vcu, int G, int tid) {
    const int lane = tid & 63, wv = __builtin_amdgcn_readfirstlane(tid >> 6), grp = wv >> 2, w = wv & 3, tl = tid & 255;
    const int ql = lane & 31, h = lane >> 5;
    LAS unsigned char* Ks = lds + grp * SLOT; LAS unsigned char* Vs = Ks + 256 * KROW;
    const bf16* Qd = (const bf16*)(ws + WS_Q); const bf16* Kd = (const bf16*)(ws + WS_K); const bf16* Vd = (const bf16*)(ws + WS_V);
    bf16* ORAW = (bf16*)(ws + WS_ORAW); float* LSE = (float*)(ws + WS_LSE);
#define ATT_UNIT(pi_) const int uid = 2 * (pi_) + grp, bh = uid >> 4, cu = uid & 15, hd = bh % 12, b = bh / 12, sh = 2 * (hd >> 2), L = 2048 >> sh; \
        const int r = cu >> (4 - sh), n = cu & ((16 >> sh) - 1), q0 = 128 * n; const size_t pbase = ((size_t)bh * 2048 + (size_t)r * L) * 64;
#define ATT_LOAD(pi_) do { ATT_UNIT(pi_) (void)b; (void)hd; const bf16* Kp = Kd + pbase; const bf16* Vp = Vd + pbase; const bf16* Qp = Qd + pbase; \
        _Pragma("unroll") for (int j = 0; j < 8; ++j) { const int id = tl + 256 * j, row = id >> 3, ch = id & 7; int kr = q0 - 64 + row; kr = kr < 0 ? 0 : (kr > L - 1 ? L - 1 : kr); \
            kreg[j] = *(const u32x4*)(Kp + (size_t)kr * 64 + ch * 8); vreg[j] = *(const u32x4*)(Vp + (size_t)kr * 64 + ch * 8); } \
        _Pragma("unroll") for (int ks = 0; ks < 4; ++ks) qn[ks] = *(const bf16x8*)(Qp + (size_t)(q0 + 32 * w + ql) * 64 + 16 * ks + 8 * h); } while (0)
    u32x4 kreg[8], vreg[8]; bf16x8 qn[4];
    if (vcu < 1536) ATT_LOAD(vcu);
    for (int pi = vcu; pi < 1536; pi += G) {
        ATT_UNIT(pi)
        __syncthreads();
        int hh = h, qll = ql; asm volatile("" : "+v"(hh), "+v"(qll));
#pragma unroll
        for (int j = 0; j < 8; ++j) { const int id = tl + 256 * j, row = id >> 3, ch = id & 7; *(LAS u32x4*)(Ks + row * KROW + ch * 16) = kreg[j]; *(LAS u32x4*)(Vs + row * KROW + ch * 16) = vreg[j]; }
        bf16x8 qf[4];
#pragma unroll
        for (int ks = 0; ks < 4; ++ks) qf[ks] = qn[ks];
        __syncthreads();
        if (pi + G < 1536) ATT_LOAD(pi + G);
        const float slope2 = exp2f(-8.f * (float)(hd + 1) / 12.f) * (float)(1 << sh) * 1.4426950408889634f;
        const int nb = qll - 4 * hh;
        const float sbp = -slope2 * (float)nb;
        bool tv[5];
#pragma unroll
        for (int kt = 0; kt < 5; ++kt) { const int klo = q0 + 32 * w + 32 * kt - 64; tv[kt] = (klo >= 0) && (klo + 32 <= L); }
        f32x16 sT[5]; float mx = -1e30f;
#pragma unroll
        for (int kt = 0; kt < 5; ++kt) {
            if (tv[kt]) {
                const float c0 = kt < 2 ? sbp : (kt == 2 ? 0.f : -sbp);
                f32x16 acc;
#pragma unroll
                for (int rr = 0; rr < 16; ++rr) acc[rr] = c0;
#pragma unroll
                for (int ks = 0; ks < 4; ++ks) { const bf16x8 af = *(LAS const bf16x8*)(Ks + (32 * w + 32 * kt + ql) * KROW + ks * 32 + h * 16);
                    acc = __builtin_amdgcn_mfma_f32_32x32x16_bf16(af, qf[ks], acc, 0, 0, 0); }
#pragma unroll
                for (int rr = 0; rr < 16; ++rr) { const int c = (rr & 3) + 8 * (rr >> 2); float sv = acc[rr];
                    if (kt < 2) sv = fmaf(slope2, (float)(32 * kt - 64 + c), sv);
                    else if (kt > 2) sv = fmaf(-slope2, (float)(32 * kt - 64 + c), sv);
                    else sv = fmaf(-slope2, fabsf((float)c - (float)nb), sv);
                    if (kt == 0) sv = (c >= nb) ? sv : -1e30f;
                    if (kt == 4) sv = (c <= nb) ? sv : -1e30f;
                    acc[rr] = sv; mx = fmaxf(mx, sv); }
                sT[kt] = acc; } }
        { const auto rr_ = __builtin_amdgcn_permlane32_swap(__builtin_bit_cast(unsigned, mx), __builtin_bit_cast(unsigned, mx), false, false); mx = fmaxf(__builtin_bit_cast(float, (unsigned)rr_[0]), __builtin_bit_cast(float, (unsigned)rr_[1])); }
        float den = 0.f;
#pragma unroll
        for (int kt = 0; kt < 5; ++kt)
            if (tv[kt]) {
#pragma unroll
                for (int rr = 0; rr < 16; ++rr) { const float p = __builtin_amdgcn_exp2f(sT[kt][rr] - mx); sT[kt][rr] = p; den += p; } }
        { const auto rr_ = __builtin_amdgcn_permlane32_swap(__builtin_bit_cast(unsigned, den), __builtin_bit_cast(unsigned, den), false, false); den = __builtin_bit_cast(float, (unsigned)rr_[0]) + __builtin_bit_cast(float, (unsigned)rr_[1]); }
        f32x16 o[2]; o[0] = f32x16{}; o[1] = f32x16{};
        const int g4 = lane >> 4, i16 = lane & 15, qq = i16 >> 2, pp = i16 & 3;
        LAS const unsigned char* vb = Vs + (32 * w + 4 * h + qq) * KROW + (16 * (g4 & 1) + 4 * pp) * 2;
#pragma unroll
        for (int s2 = 0; s2 < 10; ++s2) { const int kt = s2 >> 1, rb = 8 * (s2 & 1);
            if (tv[kt]) {
            u32x4 pw; pw.x = cvtpk(sT[kt][rb + 0], sT[kt][rb + 1]); pw.y = cvtpk(sT[kt][rb + 2], sT[kt][rb + 3]); pw.z = cvtpk(sT[kt][rb + 4], sT[kt][rb + 5]); pw.w = cvtpk(sT[kt][rb + 6], sT[kt][rb + 7]);
            const bf16x8 pf = __builtin_bit_cast(bf16x8, pw);
#pragma unroll
            for (int ct = 0; ct < 2; ++ct) { const s16x4 lo = vtr(vb + (16 * s2) * KROW + ct * 64), hi4 = vtr(vb + (16 * s2 + 8) * KROW + ct * 64);
                const bf16x8 af = (bf16x8){lo[0], lo[1], lo[2], lo[3], hi4[0], hi4[1], hi4[2], hi4[3]};
                o[ct] = __builtin_amdgcn_mfma_f32_32x32x16_bf16(af, pf, o[ct], 0, 0, 0); } } }
        const float inv = 1.f / den;
        __syncthreads();
        LAS unsigned char* ost = Ks + w * (32 * KROW);
#pragma unroll
        for (int ct = 0; ct < 2; ++ct)
#pragma unroll
            for (int a4 = 0; a4 < 4; ++a4) { u32x2 wv2; wv2.x = cvtpk(o[ct][4 * a4] * inv, o[ct][4 * a4 + 1] * inv); wv2.y = cvtpk(o[ct][4 * a4 + 2] * inv, o[ct][4 * a4 + 3] * inv);
                *(LAS u32x2*)(ost + ql * KROW + (32 * ct + 8 * a4 + 4 * h) * 2) = wv2; }
        {   const int pos = ((q0 + 32 * w + ql) << sh) + r; const size_t t = (size_t)b * 2048 + pos;
            if (h == 0) LSE[t * 12 + hd] = 0.6931471805599453f * (mx + __builtin_amdgcn_logf(den)); }
        asm volatile("s_waitcnt lgkmcnt(0)" ::: "memory");
#pragma unroll
        for (int i = 0; i < 4; ++i) { const int qr = 8 * i + (lane >> 3), ch = lane & 7;
            const u32x4 v = *(LAS const u32x4*)(ost + qr * KROW + ch * 16);
            const size_t t = (size_t)b * 2048 + (((q0 + 32 * w + qr) << sh) + r);
            *(u32x4*)(ORAW + t * 768 + hd * 64 + ch * 8) = v; }
    }
    __syncthreads();
#undef ATT_UNIT
#undef ATT_LOAD
}
}
namespace mixp {
typedef short bf16x8 __attribute__((ext_vector_type(8)));
typedef unsigned u32x4 __attribute__((ext_vector_type(4)));
__device__ __forceinline__ void unpack8(const u32x4 v, float (&f)[8]) {
#pragma unroll
    for (int i = 0; i < 4; ++i) { f[2 * i] = __builtin_bit_cast(float, v[i] << 16); f[2 * i + 1] = __builtin_bit_cast(float, v[i] & 0xffff0000u); }
}
__device__ __forceinline__ void mix_phase(const Args& a, LAS unsigned char* lds, int gw, int NGW, int wave, int lane) {
    unsigned char* ws = a.ws;
    LAS float* al = (LAS float*)(lds + wave * 1024);
    constexpr int PROW = 528;
    LAS unsigned char* pst = lds + 8192 + wave * (32 * PROW);
    const bf16* P = (const bf16*)(ws + WS_P); const bf16* ORAW = (const bf16*)(ws + WS_ORAW); const float* LSE = (const float*)(ws + WS_LSE);
    bf16* MIXIN = (bf16*)(ws + WS_MIXIN); const bf16* WpT = (const bf16*)(ws + WS_WPT); const float* pool_scale = a.in[4];
    for (int u = gw; u < M / 16; u += NGW) {
        const int t0 = 16 * u;
#pragma unroll
        for (int j = 0; j < 3; ++j) { const int id = lane + 64 * j, tk = id / 12, hd = id % 12, s = hd & 3, g = hd >> 2;
            const float* lp = LSE + (size_t)(t0 + tk) * 12 + s; const float l0 = lp[0], l1 = lp[4], l2 = lp[8];
            const float mx = fmaxf(l0, fmaxf(l1, l2)); const float e0 = __expf(l0 - mx), e1 = __expf(l1 - mx), e2 = __expf(l2 - mx);
            al[id] = (g == 0 ? e0 : (g == 1 ? e1 : e2)) / (e0 + e1 + e2); }
        asm volatile("s_waitcnt lgkmcnt(0)" ::: "memory");
#pragma unroll 12
        for (int it = 0; it < 24; ++it) { const int id = lane + 64 * it, tk = id / 96, ch = id % 96, hd = ch >> 3;
            const u32x4 v = *(const u32x4*)(ORAW + (size_t)(t0 + tk) * 768 + ch * 8); const float alpha = al[tk * 12 + hd];
            float f[8]; unpack8(v, f); u32x4 o;
#pragma unroll
            for (int i = 0; i < 4; ++i) o[i] = pk2(f[2 * i] * alpha, f[2 * i + 1] * alpha);
            *(u32x4*)(MIXIN + (size_t)(t0 + tk) * D + 256 + ch * 8) = o; }
        asm volatile("s_waitcnt lgkmcnt(0)" ::: "memory");
        const int ti = lane & 15, kq = lane >> 4, pos = (t0 + ti) & 2047, b0 = t0 - (t0 & 2047);
#pragma unroll
        for (int j = 0; j < 16; ++j) { const int rr = 2 * j + (lane >> 5), ch = lane & 31; int tr = t0 - 8 + rr; tr = tr < b0 ? b0 : (tr > b0 + 2047 ? b0 + 2047 : tr);
            const u32x4 v = *(const u32x4*)(P + (size_t)tr * 256 + ch * 8); *(LAS u32x4*)(pst + rr * PROW + ch * 16) = v; }
        asm volatile("s_waitcnt lgkmcnt(0)" ::: "memory");
        f32x4 acc[4][4];
#pragma unroll
        for (int gi = 0; gi < 4; ++gi) { const int hw = 1 << gi;
#pragma unroll
            for (int dt = 0; dt < 4; ++dt) acc[gi][dt] = (f32x4){0.f, 0.f, 0.f, 0.f};
#pragma unroll
            for (int kk = 0; kk < 2; ++kk) { const int cg = 64 * gi + 32 * kk + 8 * kq;
                float sum[8]; int cnt = 0;
#pragma unroll
                for (int i = 0; i < 8; ++i) sum[i] = 0.f;
#pragma unroll
                for (int dj = -hw; dj < hw; ++dj) { const int p2 = pos + dj; const bool ok = (p2 >= 0) && (p2 < 2048);
                    const u32x4 v = *(LAS const u32x4*)(pst + (ti + 8 + dj) * PROW + cg * 2); float f[8]; unpack8(v, f);
                    if (ok) {
#pragma unroll
                        for (int i = 0; i < 8; ++i) sum[i] += f[i];
                        ++cnt; } }
                const u32x4 ov = *(LAS const u32x4*)(pst + (ti + 8) * PROW + cg * 2); float own[8]; unpack8(ov, own);
                const float rc = 1.f / (float)cnt; u32x4 aw;
#pragma unroll
                for (int i = 0; i < 4; ++i) aw[i] = pk2(sum[2 * i] * rc - own[2 * i], sum[2 * i + 1] * rc - own[2 * i + 1]);
                const bf16x8 af = __builtin_bit_cast(bf16x8, aw);
#pragma unroll
                for (int dt = 0; dt < 4; ++dt) { const bf16x8 bfr = *(const bf16x8*)(WpT + gi * 4096 + (16 * dt + ti) * 64 + 32 * kk + 8 * kq);
                    acc[gi][dt] = __builtin_amdgcn_mfma_f32_16x16x32_bf16(af, bfr, acc[gi][dt], 0, 0, 0); } } }
        asm volatile("s_waitcnt lgkmcnt(0)" ::: "memory");
#pragma unroll
        for (int gi = 0; gi < 4; ++gi)
#pragma unroll
            for (int dt = 0; dt < 4; ++dt) { const int d = 64 * gi + 16 * dt + ti; const float sc = pool_scale[d];
#pragma unroll
                for (int rg = 0; rg < 4; ++rg) { const float fv = acc[gi][dt][rg]; *(LAS unsigned short*)(pst + (4 * kq + rg) * PROW + d * 2) = (unsigned short)f2bf(fv * sc); } }
        asm volatile("s_waitcnt lgkmcnt(0)" ::: "memory");
#pragma unroll
        for (int j = 0; j < 8; ++j) { const int rr = 2 * j + (lane >> 5), ch = lane & 31;
            const u32x4 v = *(LAS const u32x4*)(pst + rr * PROW + ch * 16); *(u32x4*)(MIXIN + (size_t)(t0 + rr) * D + ch * 8) = v; }
        asm volatile("s_waitcnt lgkmcnt(0)" ::: "memory");
    }
}
}
namespace peer {
typedef unsigned u32x4 __attribute__((ext_vector_type(4)));
typedef unsigned u32x2 __attribute__((ext_vector_type(2)));
typedef int i32x4 __attribute__((ext_vector_type(4)));
constexpr int TOK_PER_BLK = 128, TOK_PER_WAVE = 16;
constexpr int L_IDX = 0, L_ZW = 32768, L_TOK = 98304, L_SS = 100352;
constexpr size_t SLICE_BYTES = (size_t)NEXP * 128;
__device__ __forceinline__ float gelu_erf(float v) { return 0.5f * v * (1.f + erff(v * 0.70710678118654752f)); }
__device__ __forceinline__ int lane_xor1(int v) { return __builtin_amdgcn_mov_dpp(v, 0xB1, 0xF, 0xF, true); }
__device__ __forceinline__ int lane_xor2(int v) { return __builtin_amdgcn_mov_dpp(v, 0x4E, 0xF, 0xF, true); }
__device__ __forceinline__ int lane_hmirror(int v) { return __builtin_amdgcn_mov_dpp(v, 0x141, 0xF, 0xF, true); }
__device__ __forceinline__ float bf_lo(unsigned w) { return __builtin_bit_cast(float, w << 16); }
__device__ __forceinline__ float bf_hi(unsigned w) { return __builtin_bit_cast(float, w & 0xffff0000u); }

__device__ __forceinline__ void gather_phase(const Args& a, LAS unsigned char* lds, int vcu, int G, int wave, int lane) {
    unsigned char* ws = a.ws; float* out = a.out;
    const unsigned char* U8 = ws + WS_U8; const unsigned char* V8 = ws + WS_V8;
    const float* SU = (const float*)(ws + WS_SU); const float* SV = (const float*)(ws + WS_SV);
    const unsigned short* IDX = (const unsigned short*)(ws + WS_IDX); const float* GATE = (const float*)(ws + WS_GATE);
    unsigned char* X8 = ws + WS_X8; const float* g_final = a.in[11];
    bf16* X2B = (bf16*)(ws + WS_XN);
    for (int tb = vcu; tb < M / TOK_PER_BLK; tb += G) {
        const int T0 = tb * TOK_PER_BLK + wave * TOK_PER_WAVE, tl0 = wave * TOK_PER_WAVE;
        LAS unsigned short* idxl = (LAS unsigned short*)(lds + L_IDX) + tl0 * 128;
        LAS int* zw = (LAS int*)(lds + L_ZW) + tl0 * 128;
        LAS float* tokf = (LAS float*)(lds + L_TOK) + tl0 * 2;
        LAS float* ssl = (LAS float*)(lds + L_SS) + tl0 * 8;
        for (int tk4 = 0; tk4 < TOK_PER_WAVE; tk4 += 4) {
          u32x4 xbA[4], xbB[4]; unsigned short ix0[4], ix1[4];
#pragma unroll
          for (int u = 0; u < 4; ++u) { const int t = T0 + tk4 + u; xbA[u] = *(const u32x4*)(X2B + (size_t)t * D + 16 * lane); xbB[u] = *(const u32x4*)(X2B + (size_t)t * D + 16 * lane + 8);
              ix0[u] = IDX[(size_t)t * 128 + lane]; ix1[u] = IDX[(size_t)t * 128 + 64 + lane]; }
#pragma unroll
          for (int u = 0; u < 4; ++u) { const int tk = tk4 + u, t = T0 + tk;
            f32x4 x2[4]; float ss = 0.f, amax = 0.f;
            const u32x4 xb0 = xbA[u], xb1 = xbB[u];
#pragma unroll
            for (int j = 0; j < 4; ++j) { const unsigned w0 = (j < 2 ? xb0 : xb1)[2 * (j & 1)], w1 = (j < 2 ? xb0 : xb1)[2 * (j & 1) + 1];
                x2[j] = (f32x4){bf_lo(w0), bf_hi(w0), bf_lo(w1), bf_hi(w1)};
                ss += (x2[j].x * x2[j].x + x2[j].y * x2[j].y) + (x2[j].z * x2[j].z + x2[j].w * x2[j].w);
                amax = fmaxf(amax, fmaxf(fmaxf(fabsf(x2[j].x), fabsf(x2[j].y)), fmaxf(fabsf(x2[j].z), fabsf(x2[j].w)))); }
            ss = wave_sum(ss); amax = wave_max(amax);
            const float rstd = rsqrtf(ss * (1.f / D) + 1e-6f), inv = amax > 0.f ? 127.f / amax : 0.f, sx = amax * (1.f / 127.f);
            u32x4 xq;
#pragma unroll
            for (int j = 0; j < 4; ++j) { const int q0 = (int)rintf(x2[j].x * inv), q1 = (int)rintf(x2[j].y * inv), q2 = (int)rintf(x2[j].z * inv), q3 = (int)rintf(x2[j].w * inv);
                xq[j] = (unsigned)(q0 & 0xff) | ((unsigned)(q1 & 0xff) << 8) | ((unsigned)(q2 & 0xff) << 16) | ((unsigned)q3 << 24); }
            *(u32x4*)(X8 + (size_t)t * D + 16 * lane) = xq;
            idxl[tk * 128 + lane] = ix0[u]; idxl[tk * 128 + 64 + lane] = ix1[u];
            zw[tk * 128 + lane] = 0; zw[tk * 128 + 64 + lane] = 0;
            if (lane < 8) ssl[tk * 8 + lane] = 0.f;
            if (lane == 0) { tokf[tk * 2] = sx * rstd; tokf[tk * 2 + 1] = 0.f; } } }
        asm volatile("s_waitcnt vmcnt(0) lgkmcnt(0)" ::: "memory");
        { const int g = lane >> 3, i8 = lane & 7;
#define PEER_ULOAD(buf, v, h) do { const int s_ = (v) >> 4, tk_ = (v) & 15; const unsigned char* Us_ = U8 + (size_t)s_ * SLICE_BYTES; \
            _Pragma("unroll") for (int it = 0; it < 8; ++it) { const unsigned e = idxl[tk_ * 128 + 64 * (h) + 8 * it + g]; buf[it] = *(const u32x4*)(Us_ + ((e << 7) | lo16u)); } } while (0)
#define PEER_XLOAD(xv, v) do { const int s_ = (v) >> 4, tk_ = (v) & 15; xv = *(const u32x4*)(X8 + (size_t)(T0 + tk_) * D + 128 * s_ + 16 * i8); } while (0)
#define PEER_UCOMP(buf, xv, v, h) do { const int tk_ = (v) & 15; int d_[8], a_[4], b_[2]; \
            _Pragma("unroll") for (int it = 0; it < 8; ++it) { int d = __builtin_amdgcn_sdot4((int)buf[it].x, (int)xv.x, 0, false); d = __builtin_amdgcn_sdot4((int)buf[it].y, (int)xv.y, d, false); \
                d = __builtin_amdgcn_sdot4((int)buf[it].z, (int)xv.z, d, false); d_[it] = __builtin_amdgcn_sdot4((int)buf[it].w, (int)xv.w, d, false); } \
              \
              \
            _Pragma("unroll") for (int p = 0; p < 4; ++p) { const int keep = q2 ? d_[4 + p] : d_[p], send = q2 ? d_[p] : d_[4 + p]; a_[p] = keep + lane_hmirror(send); } \
            _Pragma("unroll") for (int p = 0; p < 2; ++p) { const int keep = q0 ? a_[2 * p + 1] : a_[2 * p], send = q0 ? a_[2 * p] : a_[2 * p + 1]; b_[p] = keep + lane_xor1(send); } \
            { const int keep = q1 ? b_[1] : b_[0], send = q1 ? b_[0] : b_[1]; const int c_ = keep + lane_xor2(send); \
              __hip_atomic_fetch_add(zw + tk_ * 128 + 64 * (h) + 8 * i8 + g, c_, __ATOMIC_RELAXED, __HIP_MEMORY_SCOPE_WORKGROUP); } } while (0)
        {   const bool q0 = lane & 1, q1 = lane & 2, q2 = lane & 4; const unsigned lo16u = (unsigned)i8 << 4;
            u32x4 u0[8], u1[8], u2[8], x0, x1, x2;
            PEER_XLOAD(x0, 0); PEER_ULOAD(u0, 0, 0); PEER_ULOAD(u1, 0, 1);
            for (int i = 0; i < 42; ++i) {
                PEER_XLOAD(x1, 3 * i + 1); PEER_ULOAD(u2, 3 * i + 1, 0); PEER_UCOMP(u0, x0, 3 * i + 0, 0);
                PEER_ULOAD(u0, 3 * i + 1, 1); PEER_UCOMP(u1, x0, 3 * i + 0, 1);
                PEER_XLOAD(x2, 3 * i + 2); PEER_ULOAD(u1, 3 * i + 2, 0); PEER_UCOMP(u2, x1, 3 * i + 1, 0);
                PEER_ULOAD(u2, 3 * i + 2, 1); PEER_UCOMP(u0, x1, 3 * i + 1, 1);
                PEER_XLOAD(x0, 3 * i + 3); PEER_ULOAD(u0, 3 * i + 3, 0); PEER_UCOMP(u1, x2, 3 * i + 2, 0);
                PEER_ULOAD(u1, 3 * i + 3, 1); PEER_UCOMP(u2, x2, 3 * i + 2, 1);
            }
            PEER_XLOAD(x1, 127); PEER_ULOAD(u2, 127, 0); PEER_UCOMP(u0, x0, 126, 0);
            PEER_ULOAD(u0, 127, 1); PEER_UCOMP(u1, x0, 126, 1);
            PEER_UCOMP(u2, x1, 127, 0);
            PEER_UCOMP(u0, x1, 127, 1);
        }
#undef PEER_ULOAD
#undef PEER_XLOAD
#undef PEER_UCOMP
        }
        asm volatile("s_waitcnt lgkmcnt(0)" ::: "memory");
        for (int tk = 0; tk < TOK_PER_WAVE; ++tk) { const int t = T0 + tk; const float cs = tokf[tk * 2];
            float w[2];
#pragma unroll
            for (int hf = 0; hf < 2; ++hf) { const int k = lane + 64 * hf; const unsigned e = idxl[tk * 128 + k];
                const float z = (float)zw[tk * 128 + k] * (SU[e] * cs);
                w[hf] = GATE[(size_t)t * 128 + k] * gelu_erf(z) * SV[e]; }
            const float wm = wave_max(fmaxf(fabsf(w[0]), fabsf(w[1]))), winv = wm > 0.f ? 127.f / wm : 0.f;
            asm volatile("s_waitcnt lgkmcnt(0)" ::: "memory");
            LAS signed char* wpb = (LAS signed char*)(zw + tk * 128);
            wpb[lane] = (signed char)(int)rintf(w[0] * winv); wpb[64 + lane] = (signed char)(int)rintf(w[1] * winv);
            if (lane == 0) tokf[tk * 2 + 1] = wm * (1.f / 127.f); }
        asm volatile("s_waitcnt lgkmcnt(0)" ::: "memory");
        {   const int g = lane >> 3, i8 = lane & 7; const unsigned lo16 = (unsigned)i8 << 4;
#define PEER_DLOAD(QB, WP, qi) do { const int s_ = (qi) >> 6, tok_ = 8 * (((qi) >> 5) & 1) + g, q_ = (qi) & 31; \
            const u32x2 id_ = *(LAS const u32x2*)(idxl + tok_ * 128 + 4 * q_); WP = zw[tok_ * 128 + q_]; const unsigned char* Vs_ = V8 + (size_t)s_ * SLICE_BYTES; \
            QB[0] = *(const u32x4*)(Vs_ + (((id_.x << 7) & 0x7fff80u) | lo16)); QB[1] = *(const u32x4*)(Vs_ + (((id_.x >> 9) & 0x7fff80u) | lo16)); \
            QB[2] = *(const u32x4*)(Vs_ + (((id_.y << 7) & 0x7fff80u) | lo16)); QB[3] = *(const u32x4*)(Vs_ + (((id_.y >> 9) & 0x7fff80u) | lo16)); } while (0)
#define PEER_DACC(QB, WP) do { \
            _Pragma("unroll") for (int j = 0; j < 4; ++j) { const unsigned A_ = QB[0][j], B_ = QB[1][j], C_ = QB[2][j], D_ = QB[3][j]; \
                const unsigned t0 = __builtin_amdgcn_perm(B_, A_, 0x05010400u), t1 = __builtin_amdgcn_perm(B_, A_, 0x07030602u); \
                const unsigned u0 = __builtin_amdgcn_perm(D_, C_, 0x05010400u), u1 = __builtin_amdgcn_perm(D_, C_, 0x07030602u); \
                acc[4 * j + 0] = __builtin_amdgcn_sdot4((int)__builtin_amdgcn_perm(u0, t0, 0x05040100u), WP, acc[4 * j + 0], false); \
                acc[4 * j + 1] = __builtin_amdgcn_sdot4((int)__builtin_amdgcn_perm(u0, t0, 0x07060302u), WP, acc[4 * j + 1], false); \
                acc[4 * j + 2] = __builtin_amdgcn_sdot4((int)__builtin_amdgcn_perm(u1, t1, 0x05040100u), WP, acc[4 * j + 2], false); \
                acc[4 * j + 3] = __builtin_amdgcn_sdot4((int)__builtin_amdgcn_perm(u1, t1, 0x07060302u), WP, acc[4 * j + 3], false); } } while (0)
#define PEER_DX2(qi) do { const int s_ = (qi) >> 6, tok_ = 8 * (((qi) >> 5) & 1) + g; const bf16* xp_ = X2B + (size_t)(T0 + tok_) * D + 128 * s_ + 16 * i8; \
            x2a = *(const u32x4*)xp_; x2b = *(const u32x4*)(xp_ + 8); } while (0)
#define PEER_DFIN(qi) do { const int s_ = (qi) >> 6, tok_ = 8 * (((qi) >> 5) & 1) + g; const float wsc = tokf[tok_ * 2 + 1]; float ssq = 0.f; u32x4 oa, ob; \
            _Pragma("unroll") for (int j = 0; j < 4; ++j) { const unsigned w_ = x2a[j]; const float f0 = bf_lo(w_) + (float)acc[2 * j] * wsc, f1 = bf_hi(w_) + (float)acc[2 * j + 1] * wsc; ssq += f0 * f0 + f1 * f1; oa[j] = pk2(f0, f1); } \
            _Pragma("unroll") for (int j = 0; j < 4; ++j) { const unsigned w_ = x2b[j]; const float f0 = bf_lo(w_) + (float)acc[8 + 2 * j] * wsc, f1 = bf_hi(w_) + (float)acc[8 + 2 * j + 1] * wsc; ssq += f0 * f0 + f1 * f1; ob[j] = pk2(f0, f1); } \
            bf16* xp_ = X2B + (size_t)(T0 + tok_) * D + 128 * s_ + 16 * i8; *(u32x4*)xp_ = oa; *(u32x4*)(xp_ + 8) = ob; \
            __hip_atomic_fetch_add(ssl + tok_ * 8 + i8, ssq, __ATOMIC_RELAXED, __HIP_MEMORY_SCOPE_WORKGROUP); } while (0)
            u32x4 q0[4], q1[4], q2[4], q3[4], q4[4], q5[4], q6[4], q7[4], x2a, x2b; int w0, w1, w2, w3, w4, w5, w6, w7, acc[16];
            PEER_DLOAD(q0, w0, 0); PEER_DLOAD(q1, w1, 1); PEER_DLOAD(q2, w2, 2); PEER_DLOAD(q3, w3, 3); PEER_DLOAD(q4, w4, 4); PEER_DLOAD(q5, w5, 5); PEER_DLOAD(q6, w6, 6);
            for (int i = 0; i < 512 / 8 - 1; ++i) {
                const int qi = 8 * i;
                if ((i & 3) == 0) {
#pragma unroll
                    for (int c = 0; c < 16; ++c) acc[c] = 0; }
                if ((i & 3) == 3) PEER_DX2(qi);
                PEER_DLOAD(q7, w7, qi + 7); PEER_DACC(q0, w0); PEER_DLOAD(q0, w0, qi + 8); PEER_DACC(q1, w1); PEER_DLOAD(q1, w1, qi + 9); PEER_DACC(q2, w2); PEER_DLOAD(q2, w2, qi + 10); PEER_DACC(q3, w3); PEER_DLOAD(q3, w3, qi + 11); PEER_DACC(q4, w4); PEER_DLOAD(q4, w4, qi + 12); PEER_DACC(q5, w5); PEER_DLOAD(q5, w5, qi + 13); PEER_DACC(q6, w6); PEER_DLOAD(q6, w6, qi + 14); PEER_DACC(q7, w7);
                if ((i & 3) == 3) PEER_DFIN(qi);
            }
            PEER_DX2(504); PEER_DLOAD(q7, w7, 511); PEER_DACC(q0, w0); PEER_DACC(q1, w1); PEER_DACC(q2, w2); PEER_DACC(q3, w3); PEER_DACC(q4, w4); PEER_DACC(q5, w5); PEER_DACC(q6, w6); PEER_DACC(q7, w7); PEER_DFIN(504);
#undef PEER_DLOAD
#undef PEER_DACC
#undef PEER_DX2
#undef PEER_DFIN
#undef PEER_DSTEP
        }
        asm volatile("s_waitcnt vmcnt(0) lgkmcnt(0)" ::: "memory");
        {   f32x4 gg[4];
#pragma unroll
            for (int j = 0; j < 4; ++j) gg[j] = ((const f32x4*)g_final)[lane + 64 * j];
            for (int tk4 = 0; tk4 < TOK_PER_WAVE; tk4 += 4) { u32x2 xb[4][4];
#pragma unroll
                for (int u = 0; u < 4; ++u)
#pragma unroll
                    for (int j = 0; j < 4; ++j) xb[u][j] = *(const u32x2*)(X2B + (size_t)(T0 + tk4 + u) * D + 4 * (lane + 64 * j));
#pragma unroll
                for (int u = 0; u < 4; ++u) { const int tk = tk4 + u, t = T0 + tk;
                    float sq = ssl[tk * 8 + (lane & 7)]; sq += dpp_mov<0xB1>(sq); sq += dpp_mov<0x4E>(sq); sq += dpp_mov<0x141>(sq);
                    const float r3 = rsqrtf(sq * (1.f / D) + 1e-6f);
#pragma unroll
                    for (int j = 0; j < 4; ++j) { const u32x2 w_ = xb[u][j]; const f32x4 x3 = (f32x4){bf_lo(w_.x), bf_hi(w_.x), bf_lo(w_.y), bf_hi(w_.y)};
                        *((f32x4*)(out + (size_t)t * D) + lane + 64 * j) = x3 * gg[j] * r3; } } } }
    }
}
}
namespace topk {
typedef short bf16x8 __attribute__((ext_vector_type(8)));
typedef float f32x16 __attribute__((ext_vector_type(16)));
typedef unsigned u32x4 __attribute__((ext_vector_type(4)));
constexpr int SKROW = 272;
__device__ __forceinline__ float fmax_(float a, float b) { float t; asm("v_max_f32 %0, %1, %2" : "=v"(t) : "v"(a), "v"(b)); return t; }
__device__ __forceinline__ void cswap(float& a, float& b) { float t, u; asm("v_max_f32 %0, %1, %2" : "=v"(t) : "v"(a), "v"(b)); asm("v_min_f32 %0, %1, %2" : "=v"(u) : "v"(a), "v"(b)); a = t; b = u; }
__device__ __forceinline__ void merge16(float (&c)[16]) {
#pragma unroll
    for (int j = 8; j > 0; j >>= 1)
#pragma unroll
        for (int i = 0; i < 16; ++i) { const int l = i ^ j; if (l > i) cswap(c[i], c[l]); }
}
__device__ __forceinline__ void sort16(float (&v)[16]) {
    constexpr int SA[60] = {0,1,2,3,4,5,7,9, 0,1,2,3,6,8,10,11, 0,2,4,6,7,10,12,14, 0,1,4,5,6,8,12,13, 1,3,4,5,8,9,13, 1,2,5,7,9,11, 2,3,9,11, 3,6,7,10, 3,5,7,9,11, 6,8};
    constexpr int SB[60] = {13,12,15,14,8,6,11,10, 5,7,9,4,13,14,15,12, 1,3,5,8,9,11,13,15, 2,3,10,11,7,9,14,15, 2,12,6,7,10,11,14, 4,6,8,10,13,14, 4,6,12,13, 5,8,9,12, 4,6,8,10,12, 7,9};
#pragma unroll
    for (int i = 0; i < 60; ++i) cswap(v[SA[i]], v[SB[i]]);
}
__device__ __forceinline__ void topmerge(float (&a)[16], const float (&b)[16]) {
#pragma unroll
    for (int i = 0; i < 16; ++i) a[i] = fmax_(a[i], b[15 - i]);
    merge16(a);
}
__device__ __forceinline__ void insert16(float (&a)[16], float x) {
#pragma unroll
    for (int i = 0; i < 16; ++i) cswap(a[i], x);
}
__device__ __forceinline__ float cand(float a, float b, unsigned ca, unsigned cb) { return __builtin_bit_cast(float, (__builtin_bit_cast(unsigned, a + b) & ~0x3fffu) | ca | cb); }

__device__ __forceinline__ void qhalf_load(u32x4 (&q)[8], const bf16* QPw, int lane) {
#pragma unroll
    for (int j = 0; j < 8; ++j) q[j] = *(const u32x4*)(QPw + (size_t)(4 * j + (lane >> 4)) * NQ + (lane & 15) * 8);
}
__device__ __forceinline__ void qhalf_stage(const u32x4 (&q)[8], LAS unsigned char* qst, int lane) {
#pragma unroll
    for (int j = 0; j < 8; ++j) *(LAS u32x4*)(qst + (4 * j + (lane >> 4)) * SKROW + (lane & 15) * 16) = q[j];
}
__device__ __forceinline__ void half_top16(float (&e)[16], LAS const unsigned char* qst, LAS const unsigned char* sk, int ql, int hh) {
    unsigned qoff = (unsigned)(ql * SKROW + hh * 16);
    float m0[16], m1[16];
#pragma unroll
    for (int kt = 0; kt < 4; ++kt) { f32x16 acc = {}; float v[16];
        asm volatile("" : "+v"(qoff));
#pragma unroll
        for (int ks = 0; ks < 8; ++ks) { const bf16x8 af = *(LAS const bf16x8*)(sk + (32 * kt + ql) * SKROW + ks * 32 + hh * 16);
            const bf16x8 bfr = *(LAS const bf16x8*)(qst + qoff + ks * 32);
            acc = __builtin_amdgcn_mfma_f32_32x32x16_bf16(af, bfr, acc, 0, 0, 0); }
#pragma unroll
        for (int rr = 0; rr < 16; ++rr) { const unsigned key = (unsigned)(32 * kt + (rr & 3) + 8 * (rr >> 2)) + 4u * (unsigned)hh;
            const float fv = acc[rr];
            v[rr] = __builtin_bit_cast(float, (__builtin_bit_cast(unsigned, fv) & ~0x7fu) | key); }
        sort16(v);
        if (kt == 0) {
#pragma unroll
            for (int i = 0; i < 16; ++i) m0[i] = v[i]; }
        else if (kt == 1) topmerge(m0, v);
        else if (kt == 2) {
#pragma unroll
            for (int i = 0; i < 16; ++i) m1[i] = v[i]; }
        else topmerge(m1, v); }
    topmerge(m0, m1);
#pragma unroll
    for (int i = 0; i < 16; ++i) { const unsigned x = __builtin_bit_cast(unsigned, m0[15 - i]);
        const auto rr = __builtin_amdgcn_permlane32_swap(x, x, false, false);
        const unsigned lo_ = rr[0], hi_ = rr[1];
        e[i] = fmax_(m0[i], __builtin_bit_cast(float, hh ? lo_ : hi_)); }
    merge16(e);
}

__device__ __forceinline__ void topk_phase(const Args& a, LAS unsigned char* lds, int bx, int G, int tid) {
    unsigned char* ws = a.ws;
    const int lane = tid & 63, wave = __builtin_amdgcn_readfirstlane(tid >> 6);
    const bf16* QP = (const bf16*)(ws + WS_QP); const bf16* SK = (const bf16*)(ws + WS_SK);
    unsigned short* IDX = (unsigned short*)(ws + WS_IDX); float* GATE = (float*)(ws + WS_GATE);
    const float* pu = a.in[9]; const float* pv = a.in[10]; const float* g_ffn = a.in[6];
    signed char* U8 = (signed char*)(ws + WS_U8); signed char* V8 = (signed char*)(ws + WS_V8); float* SU = (float*)(ws + WS_SU); float* SV = (float*)(ws + WS_SV);
    pg8::StaticOrder So; So.init(M, NQ, G, bx); pg8::Unit un;
    int h_staged = -1;
    int nun = 0; while (So.next(nun, un)) ++nun;
    const int ne = (nun + 1) >> 1;
    LAS unsigned char* qst = lds + 256 * SKROW + wave * (32 * SKROW);
    u32x4 qa[8], qb[8];
    if (nun > 0) { So.next(0, un); qhalf_load(qa, QP + (size_t)(256 * un.pm + 32 * wave) * NQ + un.pn * 256, lane); }
    for (int uo = 0; uo < nun; ++uo) {
        const int ui = uo < ne ? 2 * uo : 2 * (uo - ne) + 1; So.next(ui, un);
        const int h = un.pn, tt = un.pm;
        int lane_ = lane; asm volatile("" : "+v"(lane_));
        const int ql = lane_ & 31, hh = lane_ >> 5, tid_ = wave * 64 + lane_;
        const int er0 = ((ui * G + bx) * 8 + wave) * 2;
        if (h != h_staged) {
            __syncthreads();
#pragma unroll
            for (int j = 0; j < 8; ++j) { const int id = tid_ + 512 * j, row = id >> 4, ch = id & 15;
                const u32x4 v = *(const u32x4*)(SK + ((size_t)h * 256 + row) * 128 + ch * 8); *(LAS u32x4*)(lds + row * SKROW + ch * 16) = v; }
            __syncthreads(); h_staged = h;
        }
        const int t = 256 * tt + 32 * wave + ql;
        const bf16* QPw = QP + (size_t)(256 * tt + 32 * wave) * NQ + h * 256;
        float A[16], B[16];
        f32x4 rw[4];
        qhalf_stage(qa, qst, lane_);
        qhalf_load(qb, QPw + 128, lane_);
        quant_row_load(pu + (size_t)er0 * D, rw, lane_);
        half_top16(A, qst, lds, ql, hh);
        quant_row_finish(rw, g_ffn, U8 + (size_t)er0 * 128, SU + er0, lane_);
        qhalf_stage(qb, qst, lane_);
        if (uo + 1 < nun) { const int un_ = uo + 1, ui2 = un_ < ne ? 2 * un_ : 2 * (un_ - ne) + 1; pg8::Unit u2; So.next(ui2, u2);
            qhalf_load(qa, QP + (size_t)(256 * u2.pm + 32 * wave) * NQ + u2.pn * 256, lane_); }
        quant_row_load(pv + (size_t)er0 * D, rw, lane_);
        half_top16(B, qst, lds + 128 * SKROW, ql, hh);
        quant_row_finish(rw, nullptr, V8 + (size_t)er0 * 128, SV + er0, lane_);
        f32x4 rw2[4];
        quant_row_load(pu + (size_t)(er0 + 1) * D, rw, lane_); quant_row_load(pv + (size_t)(er0 + 1) * D, rw2, lane_);
        unsigned ca[16], cb[16];
#pragma unroll
        for (int i = 0; i < 16; ++i) { ca[i] = (__builtin_bit_cast(unsigned, A[i]) & 0x7fu) << 7; cb[i] = __builtin_bit_cast(unsigned, B[i]) & 0x7fu; }
        float X0[16], X1[16], X2[16];
#pragma unroll
        for (int j = 0; j < 16; ++j) X0[j] = cand(A[0], B[j], ca[0], cb[j]);
#pragma unroll
        for (int j = 0; j < 8; ++j) X1[j] = cand(A[1], B[j], ca[1], cb[j]);
#pragma unroll
        for (int j = 0; j < 5; ++j) X1[8 + j] = cand(A[2], B[j], ca[2], cb[j]);
#pragma unroll
        for (int j = 0; j < 3; ++j) X1[13 + j] = cand(A[4], B[j], ca[4], cb[j]);
#pragma unroll
        for (int j = 0; j < 4; ++j) X2[j] = cand(A[3], B[j], ca[3], cb[j]);
#pragma unroll
        for (int i = 5; i < 8; ++i)
#pragma unroll
            for (int j = 0; j < 2; ++j) X2[4 + 2 * (i - 5) + j] = cand(A[i], B[j], ca[i], cb[j]);
#pragma unroll
        for (int i = 8; i < 14; ++i) X2[10 + (i - 8)] = cand(A[i], B[0], ca[i], cb[0]);
        const float x14 = cand(A[14], B[0], ca[14], cb[0]), x15 = cand(A[15], B[0], ca[15], cb[0]);
        sort16(X1); sort16(X2);
        topmerge(X1, X2); topmerge(X0, X1); insert16(X0, x14); insert16(X0, x15);
        float sc[16]; float den = 0.f;
#pragma unroll
        for (int i = 0; i < 16; ++i) { sc[i] = __builtin_bit_cast(float, __builtin_bit_cast(unsigned, X0[i]) & ~0x3fffu); }
        const float m0 = sc[0];
#pragma unroll
        for (int i = 0; i < 16; ++i) { sc[i] = __expf(sc[i] - m0); den += sc[i]; }
        const float rd = 1.f / den;
        if (hh == 0) { u32x4 w0, w1;
#pragma unroll
            for (int i = 0; i < 4; ++i) { w0[i] = (__builtin_bit_cast(unsigned, X0[2 * i]) & 0x3fffu) | ((__builtin_bit_cast(unsigned, X0[2 * i + 1]) & 0x3fffu) << 16);
                w1[i] = (__builtin_bit_cast(unsigned, X0[8 + 2 * i]) & 0x3fffu) | ((__builtin_bit_cast(unsigned, X0[8 + 2 * i + 1]) & 0x3fffu) << 16); }
            u32x4* ip = (u32x4*)(IDX + (size_t)t * 128 + h * 16); ip[0] = w0; ip[1] = w1;
        } else { f32x4* gp = (f32x4*)(GATE + (size_t)t * 128 + h * 16);
#pragma unroll
            for (int i = 0; i < 4; ++i) gp[i] = (f32x4){sc[4 * i] * rd, sc[4 * i + 1] * rd, sc[4 * i + 2] * rd, sc[4 * i + 3] * rd}; }
        quant_row_finish(rw, g_ffn, U8 + (size_t)(er0 + 1) * 128, SU + er0 + 1, lane_); quant_row_finish(rw2, nullptr, V8 + (size_t)(er0 + 1) * 128, SV + er0 + 1, lane_);
    }
    __syncthreads();
}
}
__global__ void __launch_bounds__(NWAVES * 64, 2) mega_fwd(Args a) {
    extern __shared__ __attribute__((aligned(16))) unsigned char lds_raw[];
    LAS unsigned char* lds = (LAS unsigned char*)lds_raw;
    volatile LAS unsigned* MISC = (volatile LAS unsigned*)(lds + MISC_OFF);
    const int wave = __builtin_amdgcn_readfirstlane((int)threadIdx.x >> 6);
#define TID_NOW (wave * 64 + lane_now())
    const int G = gridDim.x, bx = blockIdx.x, vcu = (G % 8 == 0) ? (bx % 8) * (G / 8) + bx / 8 : bx;
    unsigned char* ws = a.ws;
    if (threadIdx.x < 32) ((LAS unsigned*)(lds + LDSCTL_OFF))[threadIdx.x] = 0u;
    __syncthreads();
    XcdBarrier bar = xcd_barrier_post((unsigned*)(ws + WS_CTL) + CW_BAR + a.li * XCD_BAR_WORDS, MISC + 8);
    const int lo = a.ph_lo, hi = a.ph_hi;
#define IN(k) (lo <= (k) && (k) < hi)
#define BOTH(k) (IN(k) && IN((k) + 1))
    if (IN(0)) { p0_prologue(a, lds, vcu * NWAVES + wave, G * NWAVES, wave, lane_now()); if (BOTH(0)) xcd_barrier(bar, wave); }
    if (IN(1)) {
        pg8::Gemm g{(const bf16*)(ws + WS_XN), (const bf16*)(ws + WS_WIN), M, NPROJ, D / 2}; pg8::StaticOrder So; So.init(M, NPROJ, G, bx);
        pg8::EpiInProj E{(bf16*)(ws + WS_P), (bf16*)(ws + WS_Q), (size_t)(WS_K - WS_Q) / 2, (const float*)(ws + WS_SA), (const float*)(ws + WS_SWIN)};
        pg8::gemm_phase<pg8::EpiInProj, pg8::StaticOrder, true, true, true>(lds, g, So, E, wave);
        if (BOTH(1)) xcd_barrier(bar, wave);
    }
    if (IN(2)) { attn::attn_phase(ws, lds, vcu, G, TID_NOW); if (BOTH(2)) xcd_barrier(bar, wave); }
    if (IN(3)) { mixp::mix_phase(a, lds, vcu * NWAVES + wave, G * NWAVES, wave, lane_now()); if (BOTH(3)) xcd_barrier(bar, wave); }
    if (IN(4)) {
        pg8::Gemm g{(const bf16*)(ws + WS_MIXIN), (const bf16*)(ws + WS_WOUT), M, D, D}; pg8::StaticOrder So; So.init(M, D, G, bx);
        pg8::EpiOutProj E{a.in[0], (bf16*)(ws + WS_XN), (float*)(ws + WS_ROWSS)};
        pg8::gemm_phase<pg8::EpiOutProj, pg8::StaticOrder, true, true>(lds, g, So, E, wave);
        if (BOTH(4)) xcd_barrier(bar, wave);
    }
    if (IN(5)) {
        pg8::Gemm g{(const bf16*)(ws + WS_XN), (const bf16*)(ws + WS_WQ), M, NQ, D}; pg8::StaticOrder So; So.init(M, NQ, G, bx);
        pg8::EpiPeerQ E{(bf16*)(ws + WS_QP), (const float*)(ws + WS_ROWSS)};
        pg8::gemm_phase<pg8::EpiPeerQ, pg8::StaticOrder, true, true>(lds, g, So, E, wave);
    }
    if (IN(6)) { topk::topk_phase(a, lds, bx, G, TID_NOW); if (BOTH(6)) xcd_barrier(bar, wave); }
    if (IN(7)) { peer::gather_phase(a, lds, vcu, G, wave, lane_now()); }
#undef IN
#undef BOTH
#undef TID_NOW
}
extern "C" void kernel_launch(void* const* d_in, const int* in_sizes, int n_in, void* d_out, int out_size, void* d_ws, size_t ws_size, hipStream_t stream) {
    static int grid = 0;
    if (grid == 0) {
        if (n_in != 12 || in_sizes[0] != M * D || out_size != M * D || ws_size < WS_END) { fprintf(stderr, "kernel_launch: unexpected shapes (n_in %d, in0 %d, out %d, ws %zu)\n", n_in, n_in > 0 ? in_sizes[0] : -1, out_size, ws_size); grid = -1; return; }
        int dev = 0, cus = 0, per_cu = 0;
        if (hipGetDevice(&dev) != hipSuccess || hipDeviceGetAttribute(&cus, hipDeviceAttributeMultiprocessorCount, dev) != hipSuccess) { fprintf(stderr, "kernel_launch: device query failed\n"); grid = -1; return; }
        if (hipFuncSetAttribute((const void*)mega_fwd, hipFuncAttributeMaxDynamicSharedMemorySize, LDS_BYTES) != hipSuccess) { fprintf(stderr, "kernel_launch: hipFuncSetAttribute failed\n"); grid = -1; return; }
        if (hipOccupancyMaxActiveBlocksPerMultiprocessor(&per_cu, (const void*)mega_fwd, NWAVES * 64, LDS_BYTES) != hipSuccess || per_cu < 1) { fprintf(stderr, "kernel_launch: occupancy query says %d blocks per CU\n", per_cu); grid = -1; (void)hipGetLastError(); return; }
        grid = cus;
    }
    if (grid < 0) return;
    (void)hipMemsetAsync((char*)d_ws + WS_CTL + CW_BAR * 4, 0, (CW_END - CW_BAR) * 4, stream);
    Args a{};
    for (int i = 0; i < 12; ++i) a.in[i] = (const float*)d_in[i];
    a.out = (float*)d_out; a.ws = (unsigned char*)d_ws; a.ph_lo = 0; a.ph_hi = 8; a.li = 0;
    hipLaunchKernelGGL(mega_fwd, dim3(grid), dim3(NWAVES * 64), LDS_BYTES, stream, a);
#ifdef PROBE_LO
    a.ph_lo = PROBE_LO; a.ph_hi = PROBE_HI; a.li = 1;
    hipLaunchKernelGGL(mega_fwd, dim3(grid), dim3(NWAVES * 64), LDS_BYTES, stream, a);
#endif
}
```

```cpp
#include <hip/hip_runtime.h>
#include <cstdio>
#include <cstdint>
__device__ __forceinline__ int lane_now() { int l; asm volatile("v_mbcnt_lo_u32_b32 %0, -1, 0\n\tv_mbcnt_hi_u32_b32 %0, -1, %0" : "=v"(l)); return l; }
namespace pg8 {
#define PG8_LAS __attribute__((address_space(3)))
typedef unsigned short bf16_t;
typedef short bf16x8 __attribute__((ext_vector_type(8)));
typedef float f32x4 __attribute__((ext_vector_type(4)));
typedef unsigned u32x4 __attribute__((ext_vector_type(4)));
typedef int i32x4 __attribute__((ext_vector_type(4)));
constexpr int BM = 256, BK = 64, HALF = 128, HTB = HALF * BK * 2  , STAGE_BYTES = 8 * HTB, NXCD = 8, WGM = 8;

__host__ __device__ __forceinline__ int lds_byte(int r, int c) { const int st = (r >> 4) * 2 + (c >> 5), rr = r & 15, cc = c & 31, ob = rr * 64 + cc * 2; return st * 1024 + (ob ^ (((ob >> 9) & 1) << 5)); }
__host__ __device__ __forceinline__ void stage_rc(int b, int& R, int& C) { const int st = b / 1024, sb = b % 1024, swz = sb ^ (((sb >> 9) & 1) << 5); R = (st >> 1) * 16 + swz / 64; C = (st & 1) * 32 + (swz % 64) / 2; }
__host__ __device__ __forceinline__ int perm32(int rho) { const int n = rho >> 4, i = rho & 15; return 8 * (i >> 2) + 4 * n + (i & 3); }

struct Unit { int pm, pn; };
struct Gemm { const bf16_t* A; const bf16_t* Bt; int M, N, K; };

struct StaticOrder {
    int nM, nN, nwg, G, c;
    __host__ __device__ void init(int M, int N, int G_, int c_) { nM = M / BM; nN = N / BM; nwg = nM * nN; G = G_; c = c_; }
    __host__ __device__ bool next(int i, Unit& u) const {
        const long L = (long)i * G + c; if (L >= nwg) return false;
        int wgid = (int)L; { const int q = nwg / NXCD, r = nwg % NXCD, xcd = wgid % NXCD, off = wgid / NXCD; wgid = (xcd < r ? xcd * (q + 1) : r * (q + 1) + (xcd - r) * q) + off; }
        const int nig = WGM * nN, gid = wgid / nig, fm = gid * WGM, gsz = (nM - fm) < WGM ? (nM - fm) : WGM;
        u.pm = fm + ((wgid % nig) % gsz); u.pn = (wgid % nig) / gsz; return true;
    }
    __device__ __forceinline__ void a_ready(const Unit&) const {}
    __device__ __forceinline__ void done(const Unit&) const {}
};

__device__ __forceinline__ unsigned cvt_pk_bf16(float lo, float hi) { unsigned r; asm volatile("v_cvt_pk_bf16_f32 %0, %1, %2" : "=v"(r) : "v"(lo), "v"(hi)); return r; }
typedef unsigned u32x2 __attribute__((ext_vector_type(2)));
constexpr float C2Q = 0.125f * 1.4426950408889634f;
struct EpiInProj {
    static constexpr bool PERM = true, AFTER_DRAIN = false;
    bf16_t* P; bf16_t* QKV; size_t ty_stride; const float* sa; const float* sw;
    __device__ __forceinline__ void operator()(const f32x4 (&acc)[2][2][4][2], const Unit& u, int wr, int wc, int fr, int fq) const {
        const int row0 = u.pm * BM + wr * 64 + fr;
        f32x4 swv[2][2];
#pragma unroll
        for (int bj = 0; bj < 2; ++bj)
#pragma unroll
            for (int n = 0; n < 2; ++n) swv[bj][n] = *(const f32x4*)(sw + u.pn * BM + bj * HALF + wc * 32 + 8 * fq + 4 * n);
#define PG8_I2F(x) __builtin_convertvector(__builtin_bit_cast(i32x4, (x)), f32x4)
        if (u.pn == 0) {
#pragma unroll
            for (int ai = 0; ai < 2; ++ai)
#pragma unroll
                for (int m = 0; m < 4; ++m) { bf16_t* rowp = P + (size_t)(row0 + ai * HALF + m * 16) * 256 + wc * 32 + 8 * fq; const float sar = sa[row0 + ai * HALF + m * 16];
#pragma unroll
                    for (int bj = 0; bj < 2; ++bj) { const f32x4 v0 = PG8_I2F(acc[ai][bj][m][0]) * swv[bj][0] * sar, v1 = PG8_I2F(acc[ai][bj][m][1]) * swv[bj][1] * sar;
                        u32x4 w; w.x = cvt_pk_bf16(v0[0], v0[1]); w.y = cvt_pk_bf16(v0[2], v0[3]); w.z = cvt_pk_bf16(v1[0], v1[1]); w.w = cvt_pk_bf16(v1[2], v1[3]);
                        *(u32x4*)(rowp + bj * HALF) = w; } }
        } else {
            const int ty = (u.pn - 1) / 3, g = (u.pn - 1) % 3, sh = 2 * g;
            const float sc = (ty == 0) ? C2Q : 1.f;
            bf16_t* base = QKV + (size_t)ty * ty_stride;
#pragma unroll
            for (int ai = 0; ai < 2; ++ai)
#pragma unroll
                for (int m = 0; m < 4; ++m) { const int row = row0 + ai * HALF + m * 16, b = row >> 11, pos = row & 2047;
                    const int seqp = ((pos & ((1 << sh) - 1)) << (11 - sh)) | (pos >> sh); const float sar = sa[row] * sc;
#pragma unroll
                    for (int bj = 0; bj < 2; ++bj) { const int cl = bj * HALF + wc * 32 + 8 * fq, hd = 4 * g + (cl >> 6), c = cl & 63;
                        const f32x4 v0 = PG8_I2F(acc[ai][bj][m][0]) * swv[bj][0] * sar, v1 = PG8_I2F(acc[ai][bj][m][1]) * swv[bj][1] * sar;
                        u32x4 w; w.x = cvt_pk_bf16(v0[0], v0[1]); w.y = cvt_pk_bf16(v0[2], v0[3]); w.z = cvt_pk_bf16(v1[0], v1[1]); w.w = cvt_pk_bf16(v1[2], v1[3]);
                        *(u32x4*)(base + ((size_t)((b * 12 + hd) * 2048 + seqp)) * 64 + c) = w; } }
        }
#undef PG8_I2F
    }
};
struct EpiOutProj {
    static constexpr bool PERM = true, AFTER_DRAIN = false;
    const float* x; bf16_t* x2b; float* rowss;
    __device__ __forceinline__ void operator()(const f32x4 (&acc)[2][2][4][2], const Unit& u, int wr, int wc, int fr, int fq) const {
        const int col0 = u.pn * BM + wc * 32 + 8 * fq;
#pragma unroll
        for (int ai = 0; ai < 2; ++ai)
#pragma unroll
            for (int m = 0; m < 4; ++m) { const int row = u.pm * BM + ai * HALF + wr * 64 + m * 16 + fr; const size_t off = (size_t)row * 1024 + col0; float ss = 0.f;
#pragma unroll
                for (int bj = 0; bj < 2; ++bj) { const size_t o2 = off + bj * HALF;
                    const f32x4 o0 = *(const f32x4*)(x + o2) + acc[ai][bj][m][0], o1 = *(const f32x4*)(x + o2 + 4) + acc[ai][bj][m][1];
                    ss += ((o0[0] * o0[0] + o0[1] * o0[1]) + (o0[2] * o0[2] + o0[3] * o0[3])) + ((o1[0] * o1[0] + o1[1] * o1[1]) + (o1[2] * o1[2] + o1[3] * o1[3]));
                    u32x4 w; w.x = cvt_pk_bf16(o0[0], o0[1]); w.y = cvt_pk_bf16(o0[2], o0[3]); w.z = cvt_pk_bf16(o1[0], o1[1]); w.w = cvt_pk_bf16(o1[2], o1[3]);
                    *(u32x4*)(x2b + o2) = w; }
                ss += __shfl_xor(ss, 16); ss += __shfl_xor(ss, 32);
                if (fq == 0) atomicAdd(rowss + row, ss); }
    }
};
struct EpiPeerQ {
    static constexpr bool PERM = true, AFTER_DRAIN = false;
    bf16_t* O; const float* rowss;
    __device__ __forceinline__ void operator()(const f32x4 (&acc)[2][2][4][2], const Unit& u, int wr, int wc, int fr, int fq) const {
        const int row0 = u.pm * BM + wr * 64 + fr, col0 = u.pn * BM + wc * 32 + 8 * fq;
#pragma unroll
        for (int ai = 0; ai < 2; ++ai)
#pragma unroll
            for (int m = 0; m < 4; ++m) { const int row = row0 + ai * HALF + m * 16; const float rs = rsqrtf(rowss[row] * (1.f / 1024.f) + 1e-6f);
                bf16_t* rowp = O + (size_t)row * 2048 + col0;
#pragma unroll
                for (int bj = 0; bj < 2; ++bj) { const f32x4 v0 = acc[ai][bj][m][0] * rs, v1 = acc[ai][bj][m][1] * rs;
                    u32x4 w; w.x = cvt_pk_bf16(v0[0], v0[1]); w.y = cvt_pk_bf16(v0[2], v0[3]); w.z = cvt_pk_bf16(v1[0], v1[1]); w.w = cvt_pk_bf16(v1[2], v1[3]);
                    *(u32x4*)(rowp + bj * HALF) = w; } }
    }
};
template <class Epi, class Sched, bool ALIGN_EPI = false, bool SP2 = false, bool I8 = false>
__device__ __forceinline__ void gemm_phase(PG8_LAS unsigned char* lds, const Gemm g, const Sched& S, const Epi& E, int wid) {
    const int lane = lane_now(), tid = wid * 64 + lane, wr = wid >> 2, wc = wid & 3, fr = lane & 15, fq = lane >> 4;
    const int K = g.K, nt = K / BK;
    unsigned voffA[2], voffB[2];
#pragma unroll
    for (int i = 0; i < 2; ++i) { int R, C; stage_rc(tid * 16 + i * 8192, R, C); const int Rb = Epi::PERM ? ((R & ~31) + perm32(R & 31)) : R;
        voffA[i] = (unsigned)(R * K + C) * 2u; voffB[i] = (unsigned)(Rb * K + C) * 2u; }
    const size_t kstep = (size_t)(BK * 2);
    const size_t hstep = (size_t)HALF * K * 2;
    const size_t tstep = 2 * hstep;
    const unsigned ldsw = (unsigned)wid * 1024u;
    const int aoff = lds_byte(wr * 64 + fr, fq * 8), boff = lds_byte(wc * 32 + fr, fq * 8);
#define PG8_SA(b, h) (((b) * 2 + (h)) * HTB)
#define PG8_SB(b, h) ((4 + (b) * 2 + (h)) * HTB)
#define PG8_STAGE(bufoff, gbase, voff) do { _Pragma("unroll") for (int _i = 0; _i < 2; ++_i) \
        __builtin_amdgcn_global_load_lds((const unsigned*)((const char*)(gbase) + (voff)[_i]), (PG8_LAS unsigned*)(lds + (bufoff) + ldsw + _i * 8192), 16, 0, 0); } while (0)
#define PG8_LDA(dst, b, h) do { _Pragma("unroll") for (int m = 0; m < 4; ++m) _Pragma("unroll") for (int k = 0; k < 2; ++k) dst[m][k] = *(const PG8_LAS bf16x8*)(lds + PG8_SA(b, h) + aoff + m * 2048 + k * 1024); } while (0)
#define PG8_LDB(dst, b, h) do { _Pragma("unroll") for (int n = 0; n < 2; ++n) _Pragma("unroll") for (int k = 0; k < 2; ++k) dst[n][k] = *(const PG8_LAS bf16x8*)(lds + PG8_SB(b, h) + boff + n * 2048 + k * 1024); } while (0)
#define PG8_MMA(ai, bj, At, Bt) do { __builtin_amdgcn_s_setprio(1); _Pragma("unroll") for (int m = 0; m < 4; ++m) _Pragma("unroll") for (int n = 0; n < 2; ++n) _Pragma("unroll") for (int k = 0; k < 2; ++k) \
        { if constexpr (I8) acc[ai][bj][m][n] = __builtin_bit_cast(f32x4, __builtin_amdgcn_mfma_i32_16x16x64_i8(__builtin_bit_cast(i32x4, Bt[n][k]), __builtin_bit_cast(i32x4, At[m][k]), __builtin_bit_cast(i32x4, acc[ai][bj][m][n]), 0, 0, 0)); \
          else acc[ai][bj][m][n] = __builtin_amdgcn_mfma_f32_16x16x32_bf16(Bt[n][k], At[m][k], acc[ai][bj][m][n], 0, 0, 0); } __builtin_amdgcn_s_setprio(0); } while (0)
#define PG8_WAIT_V(n) asm volatile("s_waitcnt vmcnt(" #n ")" ::: "memory")
#define PG8_WAIT_L(n) asm volatile("s_waitcnt lgkmcnt(" #n ")" ::: "memory")
#define PG8_BAR __builtin_amdgcn_s_barrier()
#define PG8_SCHED __builtin_amdgcn_sched_barrier(0)
    Unit cur, nxt; int ui = 0;
    if (!S.next(0, cur)) return;
    f32x4 acc[2][2][4][2];
#pragma unroll
    for (int a = 0; a < 2; ++a)
#pragma unroll
        for (int b = 0; b < 2; ++b)
#pragma unroll
            for (int m = 0; m < 4; ++m)
#pragma unroll
                for (int n = 0; n < 2; ++n) acc[a][b][m][n] = (f32x4){0.f, 0.f, 0.f, 0.f};
    bf16x8 At[4][2], B0[2][2], B1[2][2];
    const char* cA = (const char*)g.A + (size_t)cur.pm * tstep; const char* cB = (const char*)g.Bt + (size_t)cur.pn * tstep;
    S.a_ready(cur);
    if constexpr (SP2) {
        PG8_STAGE(PG8_SB(0, 0), cB, voffB); PG8_STAGE(PG8_SB(0, 1), cB + hstep, voffB); PG8_STAGE(PG8_SA(0, 0), cA, voffA); PG8_STAGE(PG8_SA(0, 1), cA + hstep, voffA);
        if (wr == 1) PG8_BAR;
        PG8_WAIT_V(2); PG8_BAR;
        PG8_STAGE(PG8_SB(1, 0), cB + kstep, voffB); PG8_STAGE(PG8_SA(1, 0), cA + kstep, voffA); PG8_STAGE(PG8_SB(1, 1), cB + hstep + kstep, voffB);
        PG8_WAIT_V(6); PG8_BAR;
    } else {
        PG8_STAGE(PG8_SB(0, 0), cB, voffB); PG8_STAGE(PG8_SA(0, 0), cA, voffA); PG8_STAGE(PG8_SB(0, 1), cB + hstep, voffB); PG8_STAGE(PG8_SA(0, 1), cA + hstep, voffA);
        if (wr == 1) PG8_BAR;
        PG8_WAIT_V(4); PG8_BAR;
        PG8_STAGE(PG8_SB(1, 0), cB + kstep, voffB); PG8_STAGE(PG8_SA(1, 0), cA + kstep, voffA); PG8_STAGE(PG8_SB(1, 1), cB + hstep + kstep, voffB);
        PG8_WAIT_V(6); PG8_BAR;
    }
    for (;;) {
        const bool has_next = S.next(ui + 1, nxt);
        const char* nA = has_next ? (const char*)g.A + (size_t)nxt.pm * tstep : cA; const char* nB = has_next ? (const char*)g.Bt + (size_t)nxt.pn * tstep : cB;
        for (int t = 0; t < nt; t += 2) {
            const bool last = (t == nt - 2);
            const char* a1 = cA + (size_t)(t + 1) * kstep;
            const char* a2 = last ? nA : cA + (size_t)(t + 2) * kstep; const char* b2 = last ? nB : cB + (size_t)(t + 2) * kstep;
            const char* a3 = a2 + kstep; const char* b3 = b2 + kstep;
            if (last && has_next) S.a_ready(nxt);
            if constexpr (SP2) {
            PG8_LDB(B0, 0, 0); PG8_LDB(B1, 0, 1); PG8_SCHED; PG8_LDA(At, 0, 0); PG8_STAGE(PG8_SA(1, 1), a1 + hstep, voffA);
            PG8_WAIT_V(8); PG8_WAIT_L(0); PG8_BAR; PG8_MMA(0, 0, At, B0); PG8_MMA(0, 1, At, B1); PG8_BAR; PG8_SCHED;
            PG8_LDA(At, 0, 1); PG8_STAGE(PG8_SB(0, 0), b2, voffB); PG8_STAGE(PG8_SB(0, 1), b2 + hstep, voffB); PG8_STAGE(PG8_SA(0, 0), a2, voffA);
            PG8_WAIT_V(8); PG8_WAIT_L(0); PG8_BAR; PG8_MMA(1, 0, At, B0); PG8_MMA(1, 1, At, B1); PG8_BAR; PG8_SCHED;
            PG8_LDB(B0, 1, 0); PG8_LDB(B1, 1, 1); PG8_SCHED; PG8_LDA(At, 1, 0); PG8_STAGE(PG8_SA(0, 1), a2 + hstep, voffA);
            PG8_WAIT_V(8); PG8_WAIT_L(0); PG8_BAR; PG8_MMA(0, 0, At, B0); PG8_MMA(0, 1, At, B1); PG8_BAR; PG8_SCHED;
            PG8_LDA(At, 1, 1); PG8_STAGE(PG8_SB(1, 0), b3, voffB); PG8_STAGE(PG8_SB(1, 1), b3 + hstep, voffB); PG8_STAGE(PG8_SA(1, 0), a3, voffA);
            PG8_WAIT_V(8); PG8_WAIT_L(0); PG8_BAR; PG8_MMA(1, 0, At, B0); PG8_MMA(1, 1, At, B1); PG8_BAR; PG8_SCHED;
            } else {
            PG8_LDB(B0, 0, 0); PG8_SCHED; PG8_LDA(At, 0, 0); PG8_STAGE(PG8_SA(1, 1), a1 + hstep, voffA);
            PG8_WAIT_L(8); PG8_BAR; PG8_WAIT_L(0); PG8_MMA(0, 0, At, B0); PG8_BAR; PG8_SCHED;
            PG8_LDB(B1, 0, 1); PG8_STAGE(PG8_SB(0, 0), b2, voffB);
            PG8_BAR; PG8_WAIT_L(0); PG8_MMA(0, 1, At, B1); PG8_BAR;
            PG8_LDA(At, 0, 1); PG8_STAGE(PG8_SA(0, 0), a2, voffA);
            PG8_BAR; PG8_WAIT_L(0); PG8_MMA(1, 0, At, B0); PG8_BAR; PG8_SCHED;
            PG8_STAGE(PG8_SB(0, 1), b2 + hstep, voffB);
            PG8_WAIT_V(6); PG8_BAR; PG8_MMA(1, 1, At, B1); PG8_BAR;
            PG8_LDB(B0, 1, 0); PG8_SCHED; PG8_LDA(At, 1, 0); PG8_STAGE(PG8_SA(0, 1), a2 + hstep, voffA);
            PG8_WAIT_L(8); PG8_BAR; PG8_WAIT_L(0); PG8_MMA(0, 0, At, B0); PG8_BAR; PG8_SCHED;
            PG8_LDB(B1, 1, 1); PG8_STAGE(PG8_SB(1, 0), b3, voffB);
            PG8_BAR; PG8_WAIT_L(0); PG8_MMA(0, 1, At, B1); PG8_BAR;
            PG8_LDA(At, 1, 1); PG8_STAGE(PG8_SA(1, 0), a3, voffA);
            PG8_BAR; PG8_WAIT_L(0); PG8_MMA(1, 0, At, B0); PG8_BAR; PG8_SCHED;
            PG8_STAGE(PG8_SB(1, 1), b3 + hstep, voffB);
            PG8_WAIT_V(6); PG8_BAR; PG8_MMA(1, 1, At, B1); PG8_BAR;
            }
        }
        if constexpr (ALIGN_EPI) { if (wr == 0) PG8_BAR; }
        if constexpr (!Epi::AFTER_DRAIN) { E(acc, cur, wr, wc, fr, fq); S.done(cur); }
        if (!has_next) break;
#pragma unroll
        for (int a = 0; a < 2; ++a)
#pragma unroll
            for (int b = 0; b < 2; ++b)
#pragma unroll
                for (int m = 0; m < 4; ++m)
#pragma unroll
                    for (int n = 0; n < 2; ++n) acc[a][b][m][n] = (f32x4){0.f, 0.f, 0.f, 0.f};
        cur = nxt; cA = nA; cB = nB; ++ui;
        if constexpr (ALIGN_EPI) { if (wr == 1) PG8_BAR; }
    }
    PG8_WAIT_V(0);
    if constexpr (!ALIGN_EPI) { if (wr == 0) PG8_BAR; }
    PG8_BAR;
    if constexpr (Epi::AFTER_DRAIN) { E.fused(acc, cur, wr, wc, fr, fq, lds, wid, lane); S.done(cur); }
#undef PG8_SA
#undef PG8_SB
#undef PG8_STAGE
#undef PG8_LDA
#undef PG8_LDB
#undef PG8_MMA
#undef PG8_WAIT_V
#undef PG8_WAIT_L
#undef PG8_BAR
#undef PG8_SCHED
}
}
constexpr int M = 32768, D = 1024, S = 2048;
constexpr int NPROJ = 2560, NQ = 2048, NEXP = 16384;
typedef unsigned short bf16;
constexpr size_t MiB = 1u << 20;
constexpr size_t WS_CTL = 0, CTL_ZERO_BYTES = 1 * MiB;
constexpr size_t WS_WIN = 2 * MiB, WS_WOUT = 8 * MiB, WS_WQ = 10 * MiB;
constexpr size_t WS_SK = 14 * MiB, WS_WPT = 14 * MiB + 512 * 1024;
constexpr size_t WS_SA = 15 * MiB + 640 * 1024, WS_SWIN = 15 * MiB + 768 * 1024;
constexpr size_t WS_SU = 15 * MiB, WS_SV = 15 * MiB + 64 * 1024, WS_ROWSS = 15 * MiB + 512 * 1024;
constexpr size_t WS_U8 = 16 * MiB, WS_V8 = 32 * MiB;
constexpr size_t WS_XN = 48 * MiB;
constexpr size_t WS_P = 112 * MiB;
constexpr size_t WS_Q = 128 * MiB, WS_K = 176 * MiB, WS_V = 224 * MiB;
constexpr size_t WS_ORAW = 272 * MiB, WS_LSE = 320 * MiB, WS_MIXIN = 322 * MiB, WS_END = 386 * MiB;
constexpr size_t WS_QP = 128 * MiB, WS_IDX = 256 * MiB, WS_GATE = 264 * MiB, WS_X8 = 280 * MiB;
constexpr size_t WS_PROJ = 386 * MiB;
constexpr int CW_BAR = 4096;
constexpr int CW_CMAX = CW_BAR + 2 * 3456, CW_CCNT = CW_CMAX + NPROJ, CW_END = CW_CCNT + NPROJ / 32;

constexpr int RING_BYTES = 147456;
constexpr int LDSCTL_OFF = RING_BYTES, MISC_OFF = LDSCTL_OFF;
constexpr int LDS_BYTES = RING_BYTES + 128;
constexpr int NWAVES = 8;

#define GAS __attribute__((address_space(1)))
#define LAS __attribute__((address_space(3)))
typedef unsigned v4u __attribute__((ext_vector_type(4)));
typedef float f32x4 __attribute__((ext_vector_type(4)));
typedef GAS unsigned gu32;
#define LDS_WAIT() asm volatile("s_waitcnt lgkmcnt(0)" ::: "memory")
#define VM_WAIT() asm volatile("s_waitcnt vmcnt(0)" ::: "memory")
__device__ __forceinline__ unsigned f2bf(float f) { unsigned u = __builtin_bit_cast(unsigned, f); return (u + 0x7fffu + ((u >> 16) & 1u)) >> 16; }
__device__ __forceinline__ unsigned pk2(float lo, float hi) { return f2bf(lo) | (f2bf(hi) << 16); }
__device__ __forceinline__ float bf2f(unsigned short b) { return __builtin_bit_cast(float, (unsigned)b << 16); }
template <int CTRL> __device__ __forceinline__ float dpp_mov(float v) { return __builtin_bit_cast(float, __builtin_amdgcn_mov_dpp(__builtin_bit_cast(int, v), CTRL, 0xF, 0xF, true)); }
__device__ __forceinline__ float lane_val(float v, int l) { return __builtin_bit_cast(float, __builtin_amdgcn_readlane(__builtin_bit_cast(int, v), l)); }
__device__ __forceinline__ float wave_sum(float v) {
    v += dpp_mov<0xB1>(v); v += dpp_mov<0x4E>(v); v += dpp_mov<0x141>(v); v += dpp_mov<0x140>(v);
    return (lane_val(v, 0) + lane_val(v, 16)) + (lane_val(v, 32) + lane_val(v, 48));
}
__device__ __forceinline__ float wave_max(float v) {
    v = fmaxf(v, dpp_mov<0xB1>(v)); v = fmaxf(v, dpp_mov<0x4E>(v)); v = fmaxf(v, dpp_mov<0x141>(v)); v = fmaxf(v, dpp_mov<0x140>(v));
    return fmaxf(fmaxf(lane_val(v, 0), lane_val(v, 16)), fmaxf(lane_val(v, 32), lane_val(v, 48)));
}
#define XB_TMO      128
#define XB_XCNT(j)  (256  + 64 * (j))
#define XB_XSUB(j)  (1280 + 64 * (j))
#define XB_XGEN(j)  (2304 + 64 * (j))
#define XB_TOP      3328
#define XB_TOPGEN   3392
#define XCD_BAR_WORDS 3456
#define XB_SPIN_CAP (1u << 18)

__device__ __forceinline__ unsigned xb_ld(unsigned* p)              { return __hip_atomic_load(p, __ATOMIC_RELAXED, __HIP_MEMORY_SCOPE_AGENT); }
__device__ __forceinline__ unsigned xb_add(unsigned* p, unsigned v) { return __hip_atomic_fetch_add(p, v, __ATOMIC_RELAXED, __HIP_MEMORY_SCOPE_AGENT); }
__device__ __forceinline__ unsigned xb_xcc_id() { return (unsigned)__builtin_amdgcn_s_getreg((3 << 11) | 20) & 0xFu; }
#define XB_SPIN(cond, bar) do { unsigned _sp = 0; while (cond) { __builtin_amdgcn_s_sleep(1); \
    if ((++_sp & 255u) == 0u) { if (xb_ld(&(bar)[XB_TMO])) break; if (_sp > XB_SPIN_CAP) { atomicAdd(&(bar)[XB_TMO], 1u); break; } } } } while (0)

struct XcdBarrier {
    unsigned* bar; unsigned x;
    volatile LAS unsigned* st;
};

__device__ __forceinline__ XcdBarrier xcd_barrier_post(unsigned* bar, volatile LAS unsigned* st) {
    XcdBarrier b; b.bar = bar; b.x = xb_xcc_id(); b.st = st;
    if (threadIdx.x == 0) (void)xb_add(&bar[XB_XCNT(b.x)], 1u);
    return b;
}
__device__ __forceinline__ void xcd_barrier_complete(unsigned* bar, unsigned x, unsigned& nloc, unsigned& nx) {
    const unsigned G = gridDim.x * gridDim.y * gridDim.z;
    unsigned sum, cnt, mine, sp = 0u;
    for (;;) {
        sum = 0u; cnt = 0u; mine = 0u;
#pragma unroll
        for (unsigned j = 0; j < 16; ++j) { const unsigned c = xb_ld(&bar[XB_XCNT(j)]); sum += c; cnt += (c > 0u) ? 1u : 0u; mine = (j == x) ? c : mine; }
        if (sum == G) break;
        __builtin_amdgcn_s_sleep(1);
        if ((++sp & 255u) == 0u) { if (xb_ld(&bar[XB_TMO])) break; if (sp > XB_SPIN_CAP) { atomicAdd(&bar[XB_TMO], 1u); break; } }
    }
    nloc = mine > 0u ? mine : 1u; nx = cnt > 0u ? cnt : 1u;
}

__device__ __forceinline__ void xcd_barrier(const XcdBarrier& b, int wave_) {
    asm volatile("s_waitcnt vmcnt(0)" ::: "memory");
    __syncthreads();
    if (wave_ == 0 && lane_now() == 0) {
        unsigned* bar = b.bar;
        __builtin_amdgcn_s_waitcnt(0);
        unsigned nloc = b.st[0], nx = b.st[1];
        if (nloc == 0u) { xcd_barrier_complete(bar, b.x, nloc, nx); b.st[0] = nloc; b.st[1] = nx; }
        const unsigned old = xb_add(&bar[XB_XSUB(b.x)], 1u);
        const unsigned gen = old / nloc;
        if (old + 1u == (gen + 1u) * nloc) {
            __builtin_amdgcn_fence(__ATOMIC_RELEASE, "agent");
            asm volatile("s_waitcnt vmcnt(0)" ::: "memory");
            const unsigned og = xb_add(&bar[XB_TOP], 1u);
            const unsigned tg = og / nx;
            if (og + 1u == (tg + 1u) * nx) xb_add(&bar[XB_TOPGEN], 1u);
            else XB_SPIN(xb_ld(&bar[XB_TOPGEN]) == tg, bar);
            __builtin_amdgcn_fence(__ATOMIC_ACQUIRE, "agent");
            xb_add(&bar[XB_XGEN(b.x)], 1u);
            asm volatile("s_waitcnt vmcnt(0)" ::: "memory");
        } else {
            XB_SPIN(xb_ld(&bar[XB_XGEN(b.x)]) == gen, bar);
            __builtin_amdgcn_fence(__ATOMIC_ACQUIRE, "agent");
            asm volatile("s_waitcnt vmcnt(0)" ::: "memory");
        }
    }
    __syncthreads();
}
struct Args { const float* in[12]; float* out; unsigned char* ws; int ph_lo, ph_hi, li, pad; };

__device__ __forceinline__ void p0_transpose_item(const float* W, int K, int N, bf16* WT, const float* kscale, LAS float* scr, int item, int lane) {
    const int nblk = N / 32, kb = item / nblk, nb = item % nblk, k0 = 64 * kb, n0 = 32 * nb;
#pragma unroll 8
    for (int i = 0; i < 32; ++i) { const int kk = 2 * i + (lane >> 5); float w = W[(size_t)(k0 + kk) * N + n0 + (lane & 31)]; if (kscale) w *= kscale[k0 + kk]; scr[kk * 33 + (lane & 31)] = w; }
    LDS_WAIT(); asm volatile("" ::: "memory");
    const int c = lane & 7;
#pragma unroll
    for (int j = 0; j < 4; ++j) { const int n = (lane >> 3) + 8 * j; const LAS float* s = scr + (8 * c) * 33 + n;
        v4u o; o.x = pk2(s[0 * 33], s[1 * 33]); o.y = pk2(s[2 * 33], s[3 * 33]); o.z = pk2(s[4 * 33], s[5 * 33]); o.w = pk2(s[6 * 33], s[7 * 33]);
        *(GAS v4u*)(WT + (size_t)(n0 + n) * K + k0 + 8 * c) = o; }
    LDS_WAIT(); asm volatile("" ::: "memory");
}
__device__ __forceinline__ void p0_quant_publish(const float* W, int N, unsigned* cmax, unsigned* ccnt, LAS float* scr, int item, int lane) {
    const int nblk = N / 32, kb = item / nblk, nb = item % nblk, k0 = 64 * kb, n0 = 32 * nb;
    float mx = 0.f;
#pragma unroll 8
    for (int i = 0; i < 32; ++i) { const int kk = 2 * i + (lane >> 5); const float w = W[(size_t)(k0 + kk) * N + n0 + (lane & 31)]; scr[kk * 33 + (lane & 31)] = w; mx = fmaxf(mx, fabsf(w)); }
    { const auto rr = __builtin_amdgcn_permlane32_swap(__builtin_bit_cast(unsigned, mx), __builtin_bit_cast(unsigned, mx), false, false);
      mx = fmaxf(__builtin_bit_cast(float, (unsigned)rr[0]), __builtin_bit_cast(float, (unsigned)rr[1])); }
    if (lane < 32) __hip_atomic_fetch_max(cmax + n0 + lane, __builtin_bit_cast(unsigned, mx), __ATOMIC_RELAXED, __HIP_MEMORY_SCOPE_AGENT);
    asm volatile("s_waitcnt vmcnt(0)" ::: "memory");
    if (lane == 0) __hip_atomic_fetch_add(ccnt + nb, 1u, __ATOMIC_RELAXED, __HIP_MEMORY_SCOPE_AGENT);
}
__device__ __forceinline__ void p0_quant_finish(int N, signed char* W8, float* sw, unsigned* cmax, unsigned* ccnt, LAS float* scr, int item, int lane) {
    const int nblk = N / 32, kb = item / nblk, nb = item % nblk, k0 = 64 * kb, n0 = 32 * nb;
    if (lane == 0) { unsigned sp = 0; while (__hip_atomic_load(ccnt + nb, __ATOMIC_RELAXED, __HIP_MEMORY_SCOPE_AGENT) < 16u) { __builtin_amdgcn_s_sleep(1); if (++sp > (1u << 22)) break; } }
    asm volatile("s_waitcnt vmcnt(0) lgkmcnt(0)" ::: "memory");
    __builtin_amdgcn_wave_barrier();
#pragma unroll
    for (int j = 0; j < 2; ++j) { const int n = 16 * j + (lane >> 2), ck = lane & 3;
        const float cm = __builtin_bit_cast(float, __hip_atomic_load(cmax + n0 + n, __ATOMIC_RELAXED, __HIP_MEMORY_SCOPE_AGENT));
        const float inv = cm > 0.f ? 127.f / cm : 0.f;
        if (kb == 0 && ck == 0) sw[n0 + n] = cm > 0.f ? cm * (1.f / 127.f) : 1.f;
        v4u o;
#pragma unroll
        for (int q = 0; q < 4; ++q) { const LAS float* sp_ = scr + (16 * ck + 4 * q) * 33 + n;
            const int a = (int)rintf(sp_[0] * inv), b = (int)rintf(sp_[33] * inv), c = (int)rintf(sp_[66] * inv), d = (int)rintf(sp_[99] * inv);
            o[q] = (unsigned)(a & 0xff) | ((unsigned)(b & 0xff) << 8) | ((unsigned)(c & 0xff) << 16) | ((unsigned)(d & 0xff) << 24); }
        *(GAS v4u*)(W8 + (size_t)(n0 + n) * 1024 + k0 + 16 * ck) = o; }
    LDS_WAIT(); asm volatile("" ::: "memory");
}
__device__ __forceinline__ void p0_quant_item(const float* W, int N, signed char* W8, float* sw, unsigned* cmax, unsigned* ccnt, LAS float* scr, int item, int lane) {
    p0_quant_publish(W, N, cmax, ccnt, scr, item, lane); p0_quant_finish(N, W8, sw, cmax, ccnt, scr, item, lane);
}
__device__ __forceinline__ void rms_row_to_bf16(const float* xrow, const float* g, bf16* orow, int lane) {
    const GAS f32x4* xr = (const GAS f32x4*)xrow + lane;
    f32x4 v[4]; float s = 0.f;
#pragma unroll
    for (int j = 0; j < 4; ++j) { v[j] = xr[64 * j]; s += (v[j].x * v[j].x + v[j].y * v[j].y) + (v[j].z * v[j].z + v[j].w * v[j].w); }
    const float r = rsqrtf(wave_sum(s) * (1.f / D) + 1e-6f);
    GAS unsigned long long* o8 = (GAS unsigned long long*)orow + lane;
#pragma unroll
    for (int j = 0; j < 4; ++j) { const f32x4 gg = ((const GAS f32x4*)g)[lane + 64 * j];
        o8[64 * j] = (unsigned long long)pk2(v[j].x * r * gg.x, v[j].y * r * gg.y) | ((unsigned long long)pk2(v[j].z * r * gg.z, v[j].w * r * gg.w) << 32); }
}
__device__ __forceinline__ void quant_row_i8(const float* src, const float* gsc, signed char* dst, float* scale_out, int lane) {
    const GAS f32x4* p = (const GAS f32x4*)src + 4 * lane;
    f32x4 v[4]; float amax = 0.f;
#pragma unroll
    for (int j = 0; j < 4; ++j) { v[j] = p[j]; if (gsc) v[j] = v[j] * ((const GAS f32x4*)gsc)[4 * lane + j];
        amax = fmaxf(amax, fmaxf(fmaxf(fabsf(v[j].x), fabsf(v[j].y)), fmaxf(fabsf(v[j].z), fabsf(v[j].w)))); }
    amax = wave_max(amax);
    const float inv = amax > 0.f ? 127.f / amax : 0.f;
    v4u w;
#pragma unroll
    for (int j = 0; j < 4; ++j) { const int a = (int)rintf(v[j].x * inv), b = (int)rintf(v[j].y * inv), c = (int)rintf(v[j].z * inv), d = (int)rintf(v[j].w * inv);
        w[j] = (unsigned)(a & 0xff) | ((unsigned)(b & 0xff) << 8) | ((unsigned)(c & 0xff) << 16) | ((unsigned)(d & 0xff) << 24); }
    *(GAS v4u*)(dst + (size_t)(lane >> 3) * ((size_t)NEXP * 128) + 16 * (lane & 7)) = w;
    if (lane == 0) *scale_out = amax > 0.f ? amax * (1.f / 127.f) : 1.f;
}
__device__ __forceinline__ void quant_row_load(const float* src, f32x4 (&v)[4], int lane) {
    const GAS f32x4* p = (const GAS f32x4*)src + 4 * lane;
#pragma unroll
    for (int j = 0; j < 4; ++j) v[j] = p[j];
}
__device__ __forceinline__ void quant_row_finish(f32x4 (&v)[4], const float* gsc, signed char* dst, float* scale_out, int lane) {
    float amax = 0.f;
#pragma unroll
    for (int j = 0; j < 4; ++j) { if (gsc) v[j] = v[j] * ((const GAS f32x4*)gsc)[4 * lane + j];
        amax = fmaxf(amax, fmaxf(fmaxf(fabsf(v[j].x), fabsf(v[j].y)), fmaxf(fabsf(v[j].z), fabsf(v[j].w)))); }
    amax = wave_max(amax);
    const float inv = amax > 0.f ? 127.f / amax : 0.f;
    v4u w;
#pragma unroll
    for (int j = 0; j < 4; ++j) { const int a = (int)rintf(v[j].x * inv), b = (int)rintf(v[j].y * inv), c = (int)rintf(v[j].z * inv), d = (int)rintf(v[j].w * inv);
        w[j] = (unsigned)(a & 0xff) | ((unsigned)(b & 0xff) << 8) | ((unsigned)(c & 0xff) << 16) | ((unsigned)(d & 0xff) << 24); }
    *(GAS v4u*)(dst + (size_t)(lane >> 3) * ((size_t)NEXP * 128) + 16 * (lane & 7)) = w;
    if (lane == 0) *scale_out = amax > 0.f ? amax * (1.f / 127.f) : 1.f;
}
__device__ __forceinline__ void p0_prologue(const Args& a, LAS unsigned char* lds, int gw, int NGW, int wave, int lane) {
    unsigned char* ws = a.ws;
    LAS float* scr = (LAS float*)(lds + wave * 17408);
    LAS float* scr2 = scr + 64 * 33;
    const float* w_in = a.in[2]; const float* w_pool = a.in[3]; const float* w_out = a.in[5]; const float* g_ffn = a.in[6]; const float* w_q = a.in[7];
    constexpr int I_IN = (D / 64) * (NPROJ / 32), I_OUT = (D / 64) * (D / 32), I_Q = (D / 64) * (NQ / 32), I_P = 4 * 2;
    constexpr int NITEMS = I_IN + I_OUT + I_Q + I_P;
    unsigned* cmax_ = (unsigned*)(ws + WS_CTL) + CW_CMAX; unsigned* ccnt_ = (unsigned*)(ws + WS_CTL) + CW_CCNT;
    const bool defer = gw < I_IN;
    if (defer) p0_quant_publish(w_in, NPROJ, cmax_, ccnt_, scr, gw, lane);
    for (int it = defer ? gw + NGW : gw; it < NITEMS; it += NGW) {
        int r = it;
        if (r < I_IN) { p0_quant_item(w_in, NPROJ, (signed char*)(ws + WS_WIN), (float*)(ws + WS_SWIN), cmax_, ccnt_, scr2, r, lane); continue; } r -= I_IN;
        if (r < I_OUT) { p0_transpose_item(w_out, D, D, (bf16*)(ws + WS_WOUT), nullptr, scr2, r, lane); continue; } r -= I_OUT;
        if (r < I_Q) { p0_transpose_item(w_q, D, NQ, (bf16*)(ws + WS_WQ), g_ffn, scr2, r, lane); continue; } r -= I_Q;
        p0_transpose_item(w_pool + (r >> 1) * 4096, 64, 64, (bf16*)(ws + WS_WPT) + (r >> 1) * 4096, nullptr, scr2, r & 1, lane);
    }
    constexpr int R_X = M, R_SK = 256, R_Z = 32, NROWS = R_X + R_SK + R_Z;
    for (int c4 = gw; c4 < R_X / 4; c4 += NGW) {
        const GAS f32x4* xr = (const GAS f32x4*)(a.in[0] + (size_t)c4 * 4 * D) + lane;
        f32x4 v[4][4]; float ssq[4];
#pragma unroll
        for (int rr = 0; rr < 4; ++rr)
#pragma unroll
            for (int j = 0; j < 4; ++j) v[rr][j] = xr[rr * (D / 4) + 64 * j];
#pragma unroll
        for (int rr = 0; rr < 4; ++rr) { float s_ = 0.f;
#pragma unroll
            for (int j = 0; j < 4; ++j) s_ += (v[rr][j].x * v[rr][j].x + v[rr][j].y * v[rr][j].y) + (v[rr][j].z * v[rr][j].z + v[rr][j].w * v[rr][j].w);
            ssq[rr] = s_; }
#pragma unroll
        for (int rr = 0; rr < 4; ++rr) ssq[rr] = wave_sum(ssq[rr]);
#pragma unroll
        for (int rr = 0; rr < 4; ++rr) { const float rs = rsqrtf(ssq[rr] * (1.f / D) + 1e-6f);
            GAS unsigned* o4 = (GAS unsigned*)((signed char*)(ws + WS_XN) + ((size_t)c4 * 4 + rr) * D) + lane;
            f32x4 y[4]; float am = 0.f;
#pragma unroll
            for (int j = 0; j < 4; ++j) { const f32x4 gg = ((const GAS f32x4*)a.in[1])[lane + 64 * j]; y[j] = v[rr][j] * gg * rs;
                am = fmaxf(am, fmaxf(fmaxf(fabsf(y[j].x), fabsf(y[j].y)), fmaxf(fabsf(y[j].z), fabsf(y[j].w)))); }
            am = wave_max(am); const float qi = am > 0.f ? 127.f / am : 0.f;
#pragma unroll
            for (int j = 0; j < 4; ++j) { const int q0 = (int)rintf(y[j].x * qi), q1 = (int)rintf(y[j].y * qi), q2 = (int)rintf(y[j].z * qi), q3 = (int)rintf(y[j].w * qi);
                o4[64 * j] = (unsigned)(q0 & 0xff) | ((unsigned)(q1 & 0xff) << 8) | ((unsigned)(q2 & 0xff) << 16) | ((unsigned)q3 << 24); }
            if (lane == 0) ((float*)(ws + WS_SA))[(size_t)c4 * 4 + rr] = am > 0.f ? am * (1.f / 127.f) : 1.f; }
    }
    for (int it = R_X + gw; it < NROWS; it += NGW) {
        int r = it - R_X;
        if (r < R_SK) { const GAS f32x4* p = (const GAS f32x4*)(a.in[8] + (size_t)r * 1024) + lane; GAS unsigned long long* o8 = (GAS unsigned long long*)((bf16*)(ws + WS_SK) + (size_t)r * 1024) + lane;
#pragma unroll
            for (int j = 0; j < 4; ++j) { const f32x4 v = p[64 * j]; o8[64 * j] = (unsigned long long)pk2(v.x, v.y) | ((unsigned long long)pk2(v.z, v.w) << 32); }
            continue; } r -= R_SK;
        { GAS f32x4* z = (GAS f32x4*)((float*)(ws + WS_ROWSS) + (size_t)r * 1024) + lane;
#pragma unroll
          for (int j = 0; j < 4; ++j) z[64 * j] = (f32x4){0.f, 0.f, 0.f, 0.f}; }
    }
    if (defer) p0_quant_finish(NPROJ, (signed char*)(ws + WS_WIN), (float*)(ws + WS_SWIN), cmax_, ccnt_, scr, gw, lane);
}
namespace attn {
typedef short bf16x8 __attribute__((ext_vector_type(8)));
typedef short s16x4 __attribute__((ext_vector_type(4)));
typedef float f32x16 __attribute__((ext_vector_type(16)));
typedef float f32x2_t __attribute__((ext_vector_type(2)));
typedef __bf16 bf16x2_t __attribute__((ext_vector_type(2)));
typedef unsigned u32x4 __attribute__((ext_vector_type(4)));
typedef unsigned u32x2 __attribute__((ext_vector_type(2)));
constexpr int KROW = 144;
constexpr int SLOT = 2 * 256 * KROW;
__device__ __forceinline__ unsigned cvtpk(float lo, float hi) { f32x2_t v = {lo, hi}; bf16x2_t b = __builtin_convertvector(v, bf16x2_t); return __builtin_bit_cast(unsigned, b); }
__device__ __forceinline__ s16x4 vtr(LAS const unsigned char* p) { return __builtin_bit_cast(s16x4, __builtin_amdgcn_ds_read_tr16_b64_v4i16((LAS s16x4*)p)); }

__device__ __forceinline__ void attn_phase(unsigned char* ws, LAS unsigned char* lds, int vcu, int G, int tid) {
    const int lane = tid & 63, wv = __builtin_amdgcn_readfirstlane(tid >> 6), grp = wv >> 2, w = wv & 3, tl = tid & 255;
    const int ql = lane & 31, h = lane >> 5;
    LAS unsigned char* Ks = lds + grp * SLOT; LAS unsigned char* Vs = Ks + 256 * KROW;
    const bf16* Qd = (const bf16*)(ws + WS_Q); const bf16* Kd = (const bf16*)(ws + WS_K); const bf16* Vd = (const bf16*)(ws + WS_V);
    bf16* ORAW = (bf16*)(ws + WS_ORAW); float* LSE = (float*)(ws + WS_LSE);
#define ATT_UNIT(pi_) const int uid = 2 * (pi_) + grp, bh = uid >> 4, cu = uid & 15, hd = bh % 12, b = bh / 12, sh = 2 * (hd >> 2), L = 2048 >> sh; \
        const int r = cu >> (4 - sh), n = cu & ((16 >> sh) - 1), q0 = 128 * n; const size_t pbase = ((size_t)bh * 2048 + (size_t)r * L) * 64;
#define ATT_LOAD(pi_) do { ATT_UNIT(pi_) (void)b; (void)hd; const bf16* Kp = Kd + pbase; const bf16* Vp = Vd + pbase; const bf16* Qp = Qd + pbase; \
        _Pragma("unroll") for (int j = 0; j < 8; ++j) { const int id = tl + 256 * j, row = id >> 3, ch = id & 7; int kr = q0 - 64 + row; kr = kr < 0 ? 0 : (kr > L - 1 ? L - 1 : kr); \
            kreg[j] = *(const u32x4*)(Kp + (size_t)kr * 64 + ch * 8); vreg[j] = *(const u32x4*)(Vp + (size_t)kr * 64 + ch * 8); } \
        _Pragma("unroll") for (int ks = 0; ks < 4; ++ks) qn[ks] = *(const bf16x8*)(Qp + (size_t)(q0 + 32 * w + ql) * 64 + 16 * ks + 8 * h); } while (0)
    u32x4 kreg[8], vreg[8]; bf16x8 qn[4];
    if (vcu < 1536) ATT_LOAD(vcu);
    for (int pi = vcu; pi < 1536; pi += G) {
        ATT_UNIT(pi)
        __syncthreads();
        int hh = h, qll = ql; asm volatile("" : "+v"(hh), "+v"(qll));
#pragma unroll
        for (int j = 0; j < 8; ++j) { const int id = tl + 256 * j, row = id >> 3, ch = id & 7; *(LAS u32x4*)(Ks + row * KROW + ch * 16) = kreg[j]; *(LAS u32x4*)(Vs + row * KROW + ch * 16) = vreg[j]; }
        bf16x8 qf[4];
#pragma unroll
        for (int ks = 0; ks < 4; ++ks) qf[ks] = qn[ks];
        __syncthreads();
        if (pi + G < 1536) ATT_LOAD(pi + G);
        const float slope2 = exp2f(-8.f * (float)(hd + 1) / 12.f) * (float)(1 << sh) * 1.4426950408889634f;
        const int nb = qll - 4 * hh;
        const float sbp = -slope2 * (float)nb;
        bool tv[5];
#pragma unroll
        for (int kt = 0; kt < 5; ++kt) { const int klo = q0 + 32 * w + 32 * kt - 64; tv[kt] = (klo >= 0) && (klo + 32 <= L); }
        f32x16 sT[5]; float mx = -1e30f;
#pragma unroll
        for (int kt = 0; kt < 5; ++kt) {
            if (tv[kt]) {
                const float c0 = kt < 2 ? sbp : (kt == 2 ? 0.f : -sbp);
                f32x16 acc;
#pragma unroll
                for (int rr = 0; rr < 16; ++rr) acc[rr] = c0;
#pragma unroll
                for (int ks = 0; ks < 4; ++ks) { const bf16x8 af = *(LAS const bf16x8*)(Ks + (32 * w + 32 * kt + ql) * KROW + ks * 32 + h * 16);
                    acc = __builtin_amdgcn_mfma_f32_32x32x16_bf16(af, qf[ks], acc, 0, 0, 0); }
#pragma unroll
                for (int rr = 0; rr < 16; ++rr) { const int c = (rr & 3) + 8 * (rr >> 2); float sv = acc[rr];
                    if (kt < 2) sv = fmaf(slope2, (float)(32 * kt - 64 + c), sv);
                    else if (kt > 2) sv = fmaf(-slope2, (float)(32 * kt - 64 + c), sv);
                    else sv = fmaf(-slope2, fabsf((float)c - (float)nb), sv);
                    if (kt == 0) sv = (c >= nb) ? sv : -1e30f;
                    if (kt == 4) sv = (c <= nb) ? sv : -1e30f;
                    acc[rr] = sv; mx = fmaxf(mx, sv); }
                sT[kt] = acc; } }
        { const auto rr_ = __builtin_amdgcn_permlane32_swap(__builtin_bit_cast(unsigned, mx), __builtin_bit_cast(unsigned, mx), false, false); mx = fmaxf(__builtin_bit_cast(float, (unsigned)rr_[0]), __builtin_bit_cast(float, (unsigned)rr_[1])); }
        float den = 0.f;
#pragma unroll
        for (int kt = 0; kt < 5; ++kt)
            if (tv[kt]) {
#pragma unroll
                for (int rr = 0; rr < 16; ++rr) { const float p = __builtin_amdgcn_exp2f(sT[kt][rr] - mx); sT[kt][rr] = p; den += p; } }
        { const auto rr_ = __builtin_amdgcn_permlane32_swap(__builtin_bit_cast(unsigned, den), __builtin_bit_cast(unsigned, den), false, false); den = __builtin_bit_cast(float, (unsigned)rr_[0]) + __builtin_bit_cast(float, (unsigned)rr_[1]); }
        f32x16 o[2]; o[0] = f32x16{}; o[1] = f32x16{};
        const int g4 = lane >> 4, i16 = lane & 15, qq = i16 >> 2, pp = i16 & 3;
        LAS const unsigned char* vb = Vs + (32 * w + 4 * h + qq) * KROW + (16 * (g4 & 1) + 4 * pp) * 2;
#pragma unroll
        for (int s2 = 0; s2 < 10; ++s2) { const int kt = s2 >> 1, rb = 8 * (s2 & 1);
            if (tv[kt]) {
            u32x4 pw; pw.x = cvtpk(sT[kt][rb + 0], sT[kt][rb + 1]); pw.y = cvtpk(sT[kt][rb + 2], sT[kt][rb + 3]); pw.z = cvtpk(sT[kt][rb + 4], sT[kt][rb + 5]); pw.w = cvtpk(sT[kt][rb + 6], sT[kt][rb + 7]);
            const bf16x8 pf = __builtin_bit_cast(bf16x8, pw);
#pragma unroll
            for (int ct = 0; ct < 2; ++ct) { const s16x4 lo = vtr(vb + (16 * s2) * KROW + ct * 64), hi4 = vtr(vb + (16 * s2 + 8) * KROW + ct * 64);
                const bf16x8 af = (bf16x8){lo[0], lo[1], lo[2], lo[3], hi4[0], hi4[1], hi4[2], hi4[3]};
                o[ct] = __builtin_amdgcn_mfma_f32_32x32x16_bf16(af, pf, o[ct], 0, 0, 0); } } }
        const float inv = 1.f / den;
        __syncthreads();
        LAS unsigned char* ost = Ks + w * (32 * KROW);
#pragma unroll
        for (int ct = 0; ct < 2; ++ct)
#pragma unroll
            for (int a4 = 0; a4 < 4; ++a4) { u32x2 wv2; wv2.x = cvtpk(o[ct][4 * a4] * inv, o[ct][4 * a4 + 1] * inv); wv2.y = cvtpk(o[ct][4 * a4 + 2] * inv, o[ct][4 * a4 + 3] * inv);
                *(LAS u32x2*)(ost + ql * KROW + (32 * ct + 8 * a4 + 4 * h) * 2) = wv2; }
        {   const int pos = ((q0 + 32 * w + ql) << sh) + r; const size_t t = (size_t)b * 2048 + pos;
            if (h == 0) LSE[t * 12 + hd] = 0.6931471805599453f * (mx + __builtin_amdgcn_logf(den)); }
        asm volatile("s_waitcnt lgkmcnt(0)" ::: "memory");
#pragma unroll
        for (int i = 0; i < 4; ++i) { const int qr = 8 * i + (lane >> 3), ch = lane & 7;
            const u32x4 v = *(LAS const u32x4*)(ost + qr * KROW + ch * 16);
            const size_t t = (size_t)b * 2048 + (((q0 + 32 * w + qr) << sh) + r);
            *(u32x4*)(ORAW + t * 768 + hd * 64 + ch * 8) = v; }
    }
    __syncthreads();
#undef ATT_UNIT
#undef ATT_LOAD
}
}
namespace mixp {
typedef short bf16x8 __attribute__((ext_vector_type(8)));
typedef unsigned u32x4 __attribute__((ext_vector_type(4)));
__device__ __forceinline__ void unpack8(const u32x4 v, float (&f)[8]) {
#pragma unroll
    for (int i = 0; i < 4; ++i) { f[2 * i] = __builtin_bit_cast(float, v[i] << 16); f[2 * i + 1] = __builtin_bit_cast(float, v[i] & 0xffff0000u); }
}
__device__ __forceinline__ void mix_phase(const Args& a, LAS unsigned char* lds, int gw, int NGW, int wave, int lane) {
    unsigned char* ws = a.ws;
    LAS float* al = (LAS float*)(lds + wave * 1024);
    constexpr int PROW = 528;
    LAS unsigned char* pst = lds + 8192 + wave * (32 * PROW);
    const bf16* P = (const bf16*)(ws + WS_P); const bf16* ORAW = (const bf16*)(ws + WS_ORAW); const float* LSE = (const float*)(ws + WS_LSE);
    bf16* MIXIN = (bf16*)(ws + WS_MIXIN); const bf16* WpT = (const bf16*)(ws + WS_WPT); const float* pool_scale = a.in[4];
    for (int u = gw; u < M / 16; u += NGW) {
        const int t0 = 16 * u;
#pragma unroll
        for (int j = 0; j < 3; ++j) { const int id = lane + 64 * j, tk = id / 12, hd = id % 12, s = hd & 3, g = hd >> 2;
            const float* lp = LSE + (size_t)(t0 + tk) * 12 + s; const float l0 = lp[0], l1 = lp[4], l2 = lp[8];
            const float mx = fmaxf(l0, fmaxf(l1, l2)); const float e0 = __expf(l0 - mx), e1 = __expf(l1 - mx), e2 = __expf(l2 - mx);
            al[id] = (g == 0 ? e0 : (g == 1 ? e1 : e2)) / (e0 + e1 + e2); }
        asm volatile("s_waitcnt lgkmcnt(0)" ::: "memory");
#pragma unroll 12
        for (int it = 0; it < 24; ++it) { const int id = lane + 64 * it, tk = id / 96, ch = id % 96, hd = ch >> 3;
            const u32x4 v = *(const u32x4*)(ORAW + (size_t)(t0 + tk) * 768 + ch * 8); const float alpha = al[tk * 12 + hd];
            float f[8]; unpack8(v, f); u32x4 o;
#pragma unroll
            for (int i = 0; i < 4; ++i) o[i] = pk2(f[2 * i] * alpha, f[2 * i + 1] * alpha);
            *(u32x4*)(MIXIN + (size_t)(t0 + tk) * D + 256 + ch * 8) = o; }
        asm volatile("s_waitcnt lgkmcnt(0)" ::: "memory");
        const int ti = lane & 15, kq = lane >> 4, pos = (t0 + ti) & 2047, b0 = t0 - (t0 & 2047);
#pragma unroll
        for (int j = 0; j < 16; ++j) { const int rr = 2 * j + (lane >> 5), ch = lane & 31; int tr = t0 - 8 + rr; tr = tr < b0 ? b0 : (tr > b0 + 2047 ? b0 + 2047 : tr);
            const u32x4 v = *(const u32x4*)(P + (size_t)tr * 256 + ch * 8); *(LAS u32x4*)(pst + rr * PROW + ch * 16) = v; }
        asm volatile("s_waitcnt lgkmcnt(0)" ::: "memory");
        f32x4 acc[4][4];
#pragma unroll
        for (int gi = 0; gi < 4; ++gi) { const int hw = 1 << gi;
#pragma unroll
            for (int dt = 0; dt < 4; ++dt) acc[gi][dt] = (f32x4){0.f, 0.f, 0.f, 0.f};
#pragma unroll
            for (int kk = 0; kk < 2; ++kk) { const int cg = 64 * gi + 32 * kk + 8 * kq;
                float sum[8]; int cnt = 0;
#pragma unroll
                for (int i = 0; i < 8; ++i) sum[i] = 0.f;
#pragma unroll
                for (int dj = -hw; dj < hw; ++dj) { const int p2 = pos + dj; const bool ok = (p2 >= 0) && (p2 < 2048);
                    const u32x4 v = *(LAS const u32x4*)(pst + (ti + 8 + dj) * PROW + cg * 2); float f[8]; unpack8(v, f);
                    if (ok) {
#pragma unroll
                        for (int i = 0; i < 8; ++i) sum[i] += f[i];
                        ++cnt; } }
                const u32x4 ov = *(LAS const u32x4*)(pst + (ti + 8) * PROW + cg * 2); float own[8]; unpack8(ov, own);
                const float rc = 1.f / (float)cnt; u32x4 aw;
#pragma unroll
                for (int i = 0; i < 4; ++i) aw[i] = pk2(sum[2 * i] * rc - own[2 * i], sum[2 * i + 1] * rc - own[2 * i + 1]);
                const bf16x8 af = __builtin_bit_cast(bf16x8, aw);
#pragma unroll
                for (int dt = 0; dt < 4; ++dt) { const bf16x8 bfr = *(const bf16x8*)(WpT + gi * 4096 + (16 * dt + ti) * 64 + 32 * kk + 8 * kq);
                    acc[gi][dt] = __builtin_amdgcn_mfma_f32_16x16x32_bf16(af, bfr, acc[gi][dt], 0, 0, 0); } } }
        asm volatile("s_waitcnt lgkmcnt(0)" ::: "memory");
#pragma unroll
        for (int gi = 0; gi < 4; ++gi)
#pragma unroll
            for (int dt = 0; dt < 4; ++dt) { const int d = 64 * gi + 16 * dt + ti; const float sc = pool_scale[d];
#pragma unroll
                for (int rg = 0; rg < 4; ++rg) { const float fv = acc[gi][dt][rg]; *(LAS unsigned short*)(pst + (4 * kq + rg) * PROW + d * 2) = (unsigned short)f2bf(fv * sc); } }
        asm volatile("s_waitcnt lgkmcnt(0)" ::: "memory");
#pragma unroll
        for (int j = 0; j < 8; ++j) { const int rr = 2 * j + (lane >> 5), ch = lane & 31;
            const u32x4 v = *(LAS const u32x4*)(pst + rr * PROW + ch * 16); *(u32x4*)(MIXIN + (size_t)(t0 + rr) * D + ch * 8) = v; }
        asm volatile("s_waitcnt lgkmcnt(0)" ::: "memory");
    }
}
}
namespace peer {
typedef unsigned u32x4 __attribute__((ext_vector_type(4)));
typedef unsigned u32x2 __attribute__((ext_vector_type(2)));
typedef int i32x4 __attribute__((ext_vector_type(4)));
constexpr int TOK_PER_BLK = 128, TOK_PER_WAVE = 16;
constexpr int L_SRT = 0, L_IDX = 0, L_ZW = 65536, L_XS = 65536, L_TOK = 131072, L_SS = 132096, L_TMP = 136192;
constexpr size_t SLICE_BYTES = (size_t)NEXP * 128;
__device__ __forceinline__ float gelu_erf(float v) { return 0.5f * v * (1.f + erff(v * 0.70710678118654752f)); }
__device__ __forceinline__ int lane_xor1(int v) { return __builtin_amdgcn_mov_dpp(v, 0xB1, 0xF, 0xF, true); }
__device__ __forceinline__ int lane_xor2(int v) { return __builtin_amdgcn_mov_dpp(v, 0x4E, 0xF, 0xF, true); }
__device__ __forceinline__ int lane_hmirror(int v) { return __builtin_amdgcn_mov_dpp(v, 0x141, 0xF, 0xF, true); }
__device__ __forceinline__ float bf_lo(unsigned w) { return __builtin_bit_cast(float, w << 16); }
__device__ __forceinline__ float bf_hi(unsigned w) { return __builtin_bit_cast(float, w & 0xffff0000u); }

__device__ __forceinline__ void gather_phase(const Args& a, LAS unsigned char* lds, int vcu, int G, int wave, int lane) {
    unsigned char* ws = a.ws; float* out = a.out;
    const unsigned char* U8 = ws + WS_U8; const unsigned char* V8 = ws + WS_V8;
    const float* SU = (const float*)(ws + WS_SU); const float* SV = (const float*)(ws + WS_SV);
    const unsigned short* IDX = (const unsigned short*)(ws + WS_IDX); const float* GATE = (const float*)(ws + WS_GATE);
    unsigned char* X8 = ws + WS_X8; const float* g_final = a.in[11];
    bf16* X2B = (bf16*)(ws + WS_XN);
    for (int tb = vcu; tb < M / TOK_PER_BLK; tb += G) {
        __syncthreads();
        const int T0 = tb * TOK_PER_BLK + wave * TOK_PER_WAVE, tl0 = wave * TOK_PER_WAVE;
        LAS unsigned short* idxl = (LAS unsigned short*)(lds + L_IDX) + tl0 * 128;
        LAS int* zw = (LAS int*)(lds + L_ZW) + tl0 * 128;
        LAS float* tokf = (LAS float*)(lds + L_TOK) + tl0 * 2;
        LAS float* ssl = (LAS float*)(lds + L_SS) + tl0 * 8;
        for (int tk4 = 0; tk4 < TOK_PER_WAVE; tk4 += 4) {
          u32x4 xbA[4], xbB[4];
#pragma unroll
          for (int u = 0; u < 4; ++u) { const int t = T0 + tk4 + u; xbA[u] = *(const u32x4*)(X2B + (size_t)t * D + 16 * lane); xbB[u] = *(const u32x4*)(X2B + (size_t)t * D + 16 * lane + 8); }
#pragma unroll
          for (int u = 0; u < 4; ++u) { const int tk = tk4 + u, t = T0 + tk;
            f32x4 x2[4]; float ss = 0.f, amax = 0.f;
            const u32x4 xb0 = xbA[u], xb1 = xbB[u];
#pragma unroll
            for (int j = 0; j < 4; ++j) { const unsigned w0 = (j < 2 ? xb0 : xb1)[2 * (j & 1)], w1 = (j < 2 ? xb0 : xb1)[2 * (j & 1) + 1];
                x2[j] = (f32x4){bf_lo(w0), bf_hi(w0), bf_lo(w1), bf_hi(w1)};
                ss += (x2[j].x * x2[j].x + x2[j].y * x2[j].y) + (x2[j].z * x2[j].z + x2[j].w * x2[j].w);
                amax = fmaxf(amax, fmaxf(fmaxf(fabsf(x2[j].x), fabsf(x2[j].y)), fmaxf(fabsf(x2[j].z), fabsf(x2[j].w)))); }
            ss = wave_sum(ss); amax = wave_max(amax);
            const float rstd = rsqrtf(ss * (1.f / D) + 1e-6f), inv = amax > 0.f ? 127.f / amax : 0.f, sx = amax * (1.f / 127.f);
            u32x4 xq;
#pragma unroll
            for (int j = 0; j < 4; ++j) { const int q0 = (int)rintf(x2[j].x * inv), q1 = (int)rintf(x2[j].y * inv), q2 = (int)rintf(x2[j].z * inv), q3 = (int)rintf(x2[j].w * inv);
                xq[j] = (unsigned)(q0 & 0xff) | ((unsigned)(q1 & 0xff) << 8) | ((unsigned)(q2 & 0xff) << 16) | ((unsigned)q3 << 24); }
            *(u32x4*)(X8 + (size_t)t * D + 16 * lane) = xq;
            if (lane < 8) ssl[tk * 8 + lane] = 0.f;
            if (lane == 0) { tokf[tk * 2] = sx * rstd; tokf[tk * 2 + 1] = 0.f; } } }
        asm volatile("s_waitcnt vmcnt(0) lgkmcnt(0)" ::: "memory");
        const int tid = wave * 64 + lane;
        LAS unsigned* cnt = (LAS unsigned*)(lds + L_ZW);
        LAS unsigned* srt = (LAS unsigned*)(lds + L_SRT);
        const unsigned short* IDXb = IDX + (size_t)tb * TOK_PER_BLK * 128;
        const unsigned char* X8b = X8 + (size_t)tb * TOK_PER_BLK * D;
        {   u32x4 iv[4];
#pragma unroll
            for (int j = 0; j < 4; ++j) iv[j] = *(const u32x4*)(IDXb + 32 * tid + 8 * j);
#pragma unroll
            for (int j = 0; j < 4; ++j) *(LAS u32x4*)(lds + L_ZW + 8192 * j + 16 * tid) = (u32x4){0u, 0u, 0u, 0u};
            __syncthreads();
            unsigned er[32];
#pragma unroll
            for (int j = 0; j < 32; ++j) { const unsigned w_ = iv[j >> 3][(j >> 1) & 3]; const unsigned e = (j & 1) ? (w_ >> 16) : (w_ & 0xffffu); const unsigned sh = (e & 1u) << 4;
                const unsigned old = __hip_atomic_fetch_add(cnt + (e >> 1), 1u << sh, __ATOMIC_RELAXED, __HIP_MEMORY_SCOPE_WORKGROUP);
                er[j] = e | (((old >> sh) & 0xffffu) << 14); }
            __syncthreads();
            u32x4 cw[4]; unsigned tot = 0;
#pragma unroll
            for (int j = 0; j < 4; ++j) { cw[j] = *(LAS const u32x4*)(lds + L_ZW + 64 * tid + 16 * j);
#pragma unroll
                for (int i = 0; i < 4; ++i) tot += (cw[j][i] & 0xffffu) + (cw[j][i] >> 16); }
            unsigned inc = tot;
#pragma unroll
            for (int d = 1; d < 64; d <<= 1) { const unsigned t_ = (unsigned)__shfl_up((int)inc, d, 64); if (lane >= d) inc += t_; }
            LAS unsigned* tmp = (LAS unsigned*)(lds + L_TMP);
            if (lane == 63) tmp[wave] = inc;
            __syncthreads();
            unsigned run = inc - tot;
#pragma unroll
            for (int w_ = 0; w_ < 8; ++w_) { const unsigned t_ = tmp[w_]; if (w_ < wave) run += t_; }
#pragma unroll
            for (int j = 0; j < 4; ++j) {
#pragma unroll
                for (int i = 0; i < 4; ++i) { const unsigned w_ = cw[j][i]; const unsigned lo_ = run; run += w_ & 0xffffu; const unsigned hi_ = run; run += w_ >> 16; cw[j][i] = lo_ | (hi_ << 16); }
                *(LAS u32x4*)(lds + L_ZW + 64 * tid + 16 * j) = cw[j]; }
            __syncthreads();
#pragma unroll
            for (int j = 0; j < 32; ++j) { const unsigned e = er[j] & 0x3fffu, rank = er[j] >> 14; const unsigned w_ = cnt[e >> 1]; const unsigned off = (w_ >> ((e & 1u) << 4)) & 0xffffu;
                srt[off + rank] = (e << 14) | (unsigned)(32 * tid + j); }
            __syncthreads();
        }
        { const int g = lane >> 3, i8 = lane & 7;
#define PEER_ULOAD(buf, s, vp) do { const unsigned char* Us_ = U8 + (size_t)(s) * SLICE_BYTES; const u32x4 ea_ = *(LAS const u32x4*)(srt_g + (vp) * 256), eb_ = *(LAS const u32x4*)(srt_g + (vp) * 256 + 16); \
            _Pragma("unroll") for (int it = 0; it < 8; ++it) { const unsigned en_ = it < 4 ? ea_[it] : eb_[it - 4]; buf[it] = *(const u32x4*)(Us_ + (((en_ >> 7) & 0x1fff80u) | lo16u)); } } while (0)
#define PEER_UCOMP(buf, s, vp) do { const u32x4 ea_ = *(LAS const u32x4*)(srt_g + (vp) * 256), eb_ = *(LAS const u32x4*)(srt_g + (vp) * 256 + 16); \
            LAS const unsigned char* xs_ = lds + L_XS + ((s) & 1) * 16384 + lo16u; int d_[8], a_[4], b_[2]; \
            _Pragma("unroll") for (int it = 0; it < 8; ++it) { const unsigned en_ = it < 4 ? ea_[it] : eb_[it - 4]; const u32x4 xv = *(LAS const u32x4*)(xs_ + (en_ & 0x3f80u)); \
                int d = __builtin_amdgcn_sdot4((int)buf[it].x, (int)xv.x, 0, false); d = __builtin_amdgcn_sdot4((int)buf[it].y, (int)xv.y, d, false); \
                d = __builtin_amdgcn_sdot4((int)buf[it].z, (int)xv.z, d, false); d_[it] = __builtin_amdgcn_sdot4((int)buf[it].w, (int)xv.w, d, false); } \
              \
              \
            _Pragma("unroll") for (int p = 0; p < 4; ++p) { const int keep = q2 ? d_[4 + p] : d_[p], send = q2 ? d_[p] : d_[4 + p]; a_[p] = keep + lane_hmirror(send); } \
            _Pragma("unroll") for (int p = 0; p < 2; ++p) { const int keep = q0 ? a_[2 * p + 1] : a_[2 * p], send = q0 ? a_[2 * p] : a_[2 * p + 1]; b_[p] = keep + lane_xor1(send); } \
            { const int keep = q1 ? b_[1] : b_[0], send = q1 ? b_[0] : b_[1]; zreg[vp] += keep + lane_xor2(send); } } while (0)
        {   const bool q0 = lane & 1, q1 = lane & 2, q2 = lane & 4; const unsigned lo16u = (unsigned)i8 << 4;
            LAS const unsigned char* srt_g = lds + L_SRT + (wave * 2048 + 8 * g) * 4;
            const unsigned char* xsrc = X8b + (size_t)(tid >> 2) * D + 32 * (tid & 3);
            LAS unsigned char* xdst = lds + L_XS + (tid >> 2) * 128 + 32 * (tid & 3);
            u32x4 xsa = *(const u32x4*)xsrc, xsb = *(const u32x4*)(xsrc + 16);
            *(LAS u32x4*)xdst = xsa; *(LAS u32x4*)(xdst + 16) = xsb;
            int zreg[32];
#pragma unroll
            for (int vp = 0; vp < 32; ++vp) zreg[vp] = 0;
            u32x4 u0[8], u1[8];
            PEER_ULOAD(u0, 0, 0);
            asm volatile("s_waitcnt lgkmcnt(0)\n\ts_barrier" ::: "memory");
            for (int s = 0; s < 8; ++s) {
                const int sn = s + 1 < 8 ? s + 1 : 7;
                xsa = *(const u32x4*)(xsrc + 128 * sn); xsb = *(const u32x4*)(xsrc + 128 * sn + 16);
#pragma unroll
                for (int vp = 0; vp < 32; vp += 2) {
                    PEER_ULOAD(u1, s, vp + 1); PEER_UCOMP(u0, s, vp);
                    if (vp + 2 < 32) PEER_ULOAD(u0, s, vp + 2); else PEER_ULOAD(u0, sn, 0);
                    PEER_UCOMP(u1, s, vp + 1);
                }
                *(LAS u32x4*)(xdst + ((s + 1) & 1) * 16384) = xsa; *(LAS u32x4*)(xdst + ((s + 1) & 1) * 16384 + 16) = xsb;
                asm volatile("s_waitcnt lgkmcnt(0)\n\ts_barrier" ::: "memory");
            }
#pragma unroll
            for (int vp = 0; vp < 32; ++vp) { const unsigned en = *(LAS const unsigned*)(lds + L_SRT + (wave * 2048 + 64 * vp + lane) * 4); ((LAS int*)(lds + L_ZW))[en & 0x3fffu] = zreg[vp]; }
            asm volatile("s_waitcnt lgkmcnt(0)\n\ts_barrier" ::: "memory");
            {   u32x4 iv[4];
#pragma unroll
                for (int j = 0; j < 4; ++j) iv[j] = *(const u32x4*)(IDXb + (size_t)tl0 * 128 + 32 * lane + 8 * j);
#pragma unroll
                for (int j = 0; j < 4; ++j) *(LAS u32x4*)((LAS unsigned char*)idxl + 64 * lane + 16 * j) = iv[j]; }
        }
#undef PEER_ULOAD
#undef PEER_UCOMP
        }
        asm volatile("s_waitcnt lgkmcnt(0)" ::: "memory");
        for (int tk = 0; tk < TOK_PER_WAVE; ++tk) { const int t = T0 + tk; const float cs = tokf[tk * 2];
            float w[2];
#pragma unroll
            for (int hf = 0; hf < 2; ++hf) { const int k = lane + 64 * hf; const unsigned e = idxl[tk * 128 + k];
                const float z = (float)zw[tk * 128 + k] * (SU[e] * cs);
                w[hf] = GATE[(size_t)t * 128 + k] * gelu_erf(z) * SV[e]; }
            const float wm = wave_max(fmaxf(fabsf(w[0]), fabsf(w[1]))), winv = wm > 0.f ? 127.f / wm : 0.f;
            asm volatile("s_waitcnt lgkmcnt(0)" ::: "memory");
            LAS signed char* wpb = (LAS signed char*)(zw + tk * 128);
            wpb[lane] = (signed char)(int)rintf(w[0] * winv); wpb[64 + lane] = (signed char)(int)rintf(w[1] * winv);
            if (lane == 0) tokf[tk * 2 + 1] = wm * (1.f / 127.f); }
        asm volatile("s_waitcnt lgkmcnt(0)" ::: "memory");
        {   const int g = lane >> 3, i8 = lane & 7; const unsigned lo16 = (unsigned)i8 << 4;
#define PEER_DLOAD(QB, WP, qi) do { const int s_ = (qi) >> 6, tok_ = 8 * (((qi) >> 5) & 1) + g, q_ = (qi) & 31; \
            const u32x2 id_ = *(LAS const u32x2*)(idxl + tok_ * 128 + 4 * q_); WP = zw[tok_ * 128 + q_]; const unsigned char* Vs_ = V8 + (size_t)s_ * SLICE_BYTES; \
            QB[0] = *(const u32x4*)(Vs_ + (((id_.x << 7) & 0x7fff80u) | lo16)); QB[1] = *(const u32x4*)(Vs_ + (((id_.x >> 9) & 0x7fff80u) | lo16)); \
            QB[2] = *(const u32x4*)(Vs_ + (((id_.y << 7) & 0x7fff80u) | lo16)); QB[3] = *(const u32x4*)(Vs_ + (((id_.y >> 9) & 0x7fff80u) | lo16)); } while (0)
#define PEER_DACC(QB, WP) do { \
            _Pragma("unroll") for (int j = 0; j < 4; ++j) { const unsigned A_ = QB[0][j], B_ = QB[1][j], C_ = QB[2][j], D_ = QB[3][j]; \
                const unsigned t0 = __builtin_amdgcn_perm(B_, A_, 0x05010400u), t1 = __builtin_amdgcn_perm(B_, A_, 0x07030602u); \
                const unsigned u0 = __builtin_amdgcn_perm(D_, C_, 0x05010400u), u1 = __builtin_amdgcn_perm(D_, C_, 0x07030602u); \
                acc[4 * j + 0] = __builtin_amdgcn_sdot4((int)__builtin_amdgcn_perm(u0, t0, 0x05040100u), WP, acc[4 * j + 0], false); \
                acc[4 * j + 1] = __builtin_amdgcn_sdot4((int)__builtin_amdgcn_perm(u0, t0, 0x07060302u), WP, acc[4 * j + 1], false); \
                acc[4 * j + 2] = __builtin_amdgcn_sdot4((int)__builtin_amdgcn_perm(u1, t1, 0x05040100u), WP, acc[4 * j + 2], false); \
                acc[4 * j + 3] = __builtin_amdgcn_sdot4((int)__builtin_amdgcn_perm(u1, t1, 0x07060302u), WP, acc[4 * j + 3], false); } } while (0)
#define PEER_DX2(qi) do { const int s_ = (qi) >> 6, tok_ = 8 * (((qi) >> 5) & 1) + g; const bf16* xp_ = X2B + (size_t)(T0 + tok_) * D + 128 * s_ + 16 * i8; \
            x2a = *(const u32x4*)xp_; x2b = *(const u32x4*)(xp_ + 8); } while (0)
#define PEER_DFIN(qi) do { const int s_ = (qi) >> 6, tok_ = 8 * (((qi) >> 5) & 1) + g; const float wsc = tokf[tok_ * 2 + 1]; float ssq = 0.f; u32x4 oa, ob; \
            _Pragma("unroll") for (int j = 0; j < 4; ++j) { const unsigned w_ = x2a[j]; const float f0 = bf_lo(w_) + (float)acc[2 * j] * wsc, f1 = bf_hi(w_) + (float)acc[2 * j + 1] * wsc; ssq += f0 * f0 + f1 * f1; oa[j] = pk2(f0, f1); } \
            _Pragma("unroll") for (int j = 0; j < 4; ++j) { const unsigned w_ = x2b[j]; const float f0 = bf_lo(w_) + (float)acc[8 + 2 * j] * wsc, f1 = bf_hi(w_) + (float)acc[8 + 2 * j + 1] * wsc; ssq += f0 * f0 + f1 * f1; ob[j] = pk2(f0, f1); } \
            bf16* xp_ = X2B + (size_t)(T0 + tok_) * D + 128 * s_ + 16 * i8; *(u32x4*)xp_ = oa; *(u32x4*)(xp_ + 8) = ob; \
            __hip_atomic_fetch_add(ssl + tok_ * 8 + i8, ssq, __ATOMIC_RELAXED, __HIP_MEMORY_SCOPE_WORKGROUP); } while (0)
            u32x4 q0[4], q1[4], q2[4], q3[4], q4[4], q5[4], q6[4], q7[4], x2a, x2b; int w0, w1, w2, w3, w4, w5, w6, w7, acc[16];
            PEER_DLOAD(q0, w0, 0); PEER_DLOAD(q1, w1, 1); PEER_DLOAD(q2, w2, 2); PEER_DLOAD(q3, w3, 3); PEER_DLOAD(q4, w4, 4); PEER_DLOAD(q5, w5, 5); PEER_DLOAD(q6, w6, 6);
            for (int i = 0; i < 512 / 8 - 1; ++i) {
                const int qi = 8 * i;
                if ((i & 3) == 0) {
#pragma unroll
                    for (int c = 0; c < 16; ++c) acc[c] = 0; }
                if ((i & 3) == 3) PEER_DX2(qi);
                PEER_DLOAD(q7, w7, qi + 7); PEER_DACC(q0, w0); PEER_DLOAD(q0, w0, qi + 8); PEER_DACC(q1, w1); PEER_DLOAD(q1, w1, qi + 9); PEER_DACC(q2, w2); PEER_DLOAD(q2, w2, qi + 10); PEER_DACC(q3, w3); PEER_DLOAD(q3, w3, qi + 11); PEER_DACC(q4, w4); PEER_DLOAD(q4, w4, qi + 12); PEER_DACC(q5, w5); PEER_DLOAD(q5, w5, qi + 13); PEER_DACC(q6, w6); PEER_DLOAD(q6, w6, qi + 14); PEER_DACC(q7, w7);
                if ((i & 3) == 3) PEER_DFIN(qi);
            }
            PEER_DX2(504); PEER_DLOAD(q7, w7, 511); PEER_DACC(q0, w0); PEER_DACC(q1, w1); PEER_DACC(q2, w2); PEER_DACC(q3, w3); PEER_DACC(q4, w4); PEER_DACC(q5, w5); PEER_DACC(q6, w6); PEER_DACC(q7, w7); PEER_DFIN(504);
#undef PEER_DLOAD
#undef PEER_DACC
#undef PEER_DX2
#undef PEER_DFIN
#undef PEER_DSTEP
        }
        asm volatile("s_waitcnt vmcnt(0) lgkmcnt(0)" ::: "memory");
        {   f32x4 gg[4];
#pragma unroll
            for (int j = 0; j < 4; ++j) gg[j] = ((const f32x4*)g_final)[lane + 64 * j];
            for (int tk4 = 0; tk4 < TOK_PER_WAVE; tk4 += 4) { u32x2 xb[4][4];
#pragma unroll
                for (int u = 0; u < 4; ++u)
#pragma unroll
                    for (int j = 0; j < 4; ++j) xb[u][j] = *(const u32x2*)(X2B + (size_t)(T0 + tk4 + u) * D + 4 * (lane + 64 * j));
#pragma unroll
                for (int u = 0; u < 4; ++u) { const int tk = tk4 + u, t = T0 + tk;
                    float sq = ssl[tk * 8 + (lane & 7)]; sq += dpp_mov<0xB1>(sq); sq += dpp_mov<0x4E>(sq); sq += dpp_mov<0x141>(sq);
                    const float r3 = rsqrtf(sq * (1.f / D) + 1e-6f);
#pragma unroll
                    for (int j = 0; j < 4; ++j) { const u32x2 w_ = xb[u][j]; const f32x4 x3 = (f32x4){bf_lo(w_.x), bf_hi(w_.x), bf_lo(w_.y), bf_hi(w_.y)};
                        *((f32x4*)(out + (size_t)t * D) + lane + 64 * j) = x3 * gg[j] * r3; } } } }
    }
}
}
namespace topk {
typedef short bf16x8 __attribute__((ext_vector_type(8)));
typedef float f32x16 __attribute__((ext_vector_type(16)));
typedef unsigned u32x4 __attribute__((ext_vector_type(4)));
constexpr int SKROW = 272;
__device__ __forceinline__ float fmax_(float a, float b) { float t; asm("v_max_f32 %0, %1, %2" : "=v"(t) : "v"(a), "v"(b)); return t; }
__device__ __forceinline__ void cswap(float& a, float& b) { float t, u; asm("v_max_f32 %0, %1, %2" : "=v"(t) : "v"(a), "v"(b)); asm("v_min_f32 %0, %1, %2" : "=v"(u) : "v"(a), "v"(b)); a = t; b = u; }
__device__ __forceinline__ void merge16(float (&c)[16]) {
#pragma unroll
    for (int j = 8; j > 0; j >>= 1)
#pragma unroll
        for (int i = 0; i < 16; ++i) { const int l = i ^ j; if (l > i) cswap(c[i], c[l]); }
}
__device__ __forceinline__ void sort16(float (&v)[16]) {
    constexpr int SA[60] = {0,1,2,3,4,5,7,9, 0,1,2,3,6,8,10,11, 0,2,4,6,7,10,12,14, 0,1,4,5,6,8,12,13, 1,3,4,5,8,9,13, 1,2,5,7,9,11, 2,3,9,11, 3,6,7,10, 3,5,7,9,11, 6,8};
    constexpr int SB[60] = {13,12,15,14,8,6,11,10, 5,7,9,4,13,14,15,12, 1,3,5,8,9,11,13,15, 2,3,10,11,7,9,14,15, 2,12,6,7,10,11,14, 4,6,8,10,13,14, 4,6,12,13, 5,8,9,12, 4,6,8,10,12, 7,9};
#pragma unroll
    for (int i = 0; i < 60; ++i) cswap(v[SA[i]], v[SB[i]]);
}
__device__ __forceinline__ void topmerge(float (&a)[16], const float (&b)[16]) {
#pragma unroll
    for (int i = 0; i < 16; ++i) a[i] = fmax_(a[i], b[15 - i]);
    merge16(a);
}
__device__ __forceinline__ void insert16(float (&a)[16], float x) {
#pragma unroll
    for (int i = 0; i < 16; ++i) cswap(a[i], x);
}
__device__ __forceinline__ float cand(float a, float b, unsigned ca, unsigned cb) { return __builtin_bit_cast(float, (__builtin_bit_cast(unsigned, a + b) & ~0x3fffu) | ca | cb); }

__device__ __forceinline__ void qhalf_load(u32x4 (&q)[8], const bf16* QPw, int lane) {
#pragma unroll
    for (int j = 0; j < 8; ++j) q[j] = *(const u32x4*)(QPw + (size_t)(4 * j + (lane >> 4)) * NQ + (lane & 15) * 8);
}
__device__ __forceinline__ void qhalf_stage(const u32x4 (&q)[8], LAS unsigned char* qst, int lane) {
#pragma unroll
    for (int j = 0; j < 8; ++j) *(LAS u32x4*)(qst + (4 * j + (lane >> 4)) * SKROW + (lane & 15) * 16) = q[j];
}
__device__ __forceinline__ void half_top16(float (&e)[16], LAS const unsigned char* qst, LAS const unsigned char* sk, int ql, int hh) {
    unsigned qoff = (unsigned)(ql * SKROW + hh * 16);
    float m0[16], m1[16];
#pragma unroll
    for (int kt = 0; kt < 4; ++kt) { f32x16 acc = {}; float v[16];
        asm volatile("" : "+v"(qoff));
#pragma unroll
        for (int ks = 0; ks < 8; ++ks) { const bf16x8 af = *(LAS const bf16x8*)(sk + (32 * kt + ql) * SKROW + ks * 32 + hh * 16);
            const bf16x8 bfr = *(LAS const bf16x8*)(qst + qoff + ks * 32);
            acc = __builtin_amdgcn_mfma_f32_32x32x16_bf16(af, bfr, acc, 0, 0, 0); }
#pragma unroll
        for (int rr = 0; rr < 16; ++rr) { const unsigned key = (unsigned)(32 * kt + (rr & 3) + 8 * (rr >> 2)) + 4u * (unsigned)hh;
            const float fv = acc[rr];
            v[rr] = __builtin_bit_cast(float, (__builtin_bit_cast(unsigned, fv) & ~0x7fu) | key); }
        sort16(v);
        if (kt == 0) {
#pragma unroll
            for (int i = 0; i < 16; ++i) m0[i] = v[i]; }
        else if (kt == 1) topmerge(m0, v);
        else if (kt == 2) {
#pragma unroll
            for (int i = 0; i < 16; ++i) m1[i] = v[i]; }
        else topmerge(m1, v); }
    topmerge(m0, m1);
#pragma unroll
    for (int i = 0; i < 16; ++i) { const unsigned x = __builtin_bit_cast(unsigned, m0[15 - i]);
        const auto rr = __builtin_amdgcn_permlane32_swap(x, x, false, false);
        const unsigned lo_ = rr[0], hi_ = rr[1];
        e[i] = fmax_(m0[i], __builtin_bit_cast(float, hh ? lo_ : hi_)); }
    merge16(e);
}

__device__ __forceinline__ void topk_phase(const Args& a, LAS unsigned char* lds, int bx, int G, int tid) {
    unsigned char* ws = a.ws;
    const int lane = tid & 63, wave = __builtin_amdgcn_readfirstlane(tid >> 6);
    const bf16* QP = (const bf16*)(ws + WS_QP); const bf16* SK = (const bf16*)(ws + WS_SK);
    unsigned short* IDX = (unsigned short*)(ws + WS_IDX); float* GATE = (float*)(ws + WS_GATE);
    const float* pu = a.in[9]; const float* pv = a.in[10]; const float* g_ffn = a.in[6];
    signed char* U8 = (signed char*)(ws + WS_U8); signed char* V8 = (signed char*)(ws + WS_V8); float* SU = (float*)(ws + WS_SU); float* SV = (float*)(ws + WS_SV);
    pg8::StaticOrder So; So.init(M, NQ, G, bx); pg8::Unit un;
    int h_staged = -1;
    int nun = 0; while (So.next(nun, un)) ++nun;
    const int ne = (nun + 1) >> 1;
    LAS unsigned char* qst = lds + 256 * SKROW + wave * (32 * SKROW);
    u32x4 qa[8], qb[8];
    if (nun > 0) { So.next(0, un); qhalf_load(qa, QP + (size_t)(256 * un.pm + 32 * wave) * NQ + un.pn * 256, lane); }
    for (int uo = 0; uo < nun; ++uo) {
        const int ui = uo < ne ? 2 * uo : 2 * (uo - ne) + 1; So.next(ui, un);
        const int h = un.pn, tt = un.pm;
        int lane_ = lane; asm volatile("" : "+v"(lane_));
        const int ql = lane_ & 31, hh = lane_ >> 5, tid_ = wave * 64 + lane_;
        const int er0 = ((ui * G + bx) * 8 + wave) * 2;
        if (h != h_staged) {
            __syncthreads();
#pragma unroll
            for (int j = 0; j < 8; ++j) { const int id = tid_ + 512 * j, row = id >> 4, ch = id & 15;
                const u32x4 v = *(const u32x4*)(SK + ((size_t)h * 256 + row) * 128 + ch * 8); *(LAS u32x4*)(lds + row * SKROW + ch * 16) = v; }
            __syncthreads(); h_staged = h;
        }
        const int t = 256 * tt + 32 * wave + ql;
        const bf16* QPw = QP + (size_t)(256 * tt + 32 * wave) * NQ + h * 256;
        float A[16], B[16];
        f32x4 rw[4];
        qhalf_stage(qa, qst, lane_);
        qhalf_load(qb, QPw + 128, lane_);
        quant_row_load(pu + (size_t)er0 * D, rw, lane_);
        half_top16(A, qst, lds, ql, hh);
        quant_row_finish(rw, g_ffn, U8 + (size_t)er0 * 128, SU + er0, lane_);
        qhalf_stage(qb, qst, lane_);
        if (uo + 1 < nun) { const int un_ = uo + 1, ui2 = un_ < ne ? 2 * un_ : 2 * (un_ - ne) + 1; pg8::Unit u2; So.next(ui2, u2);
            qhalf_load(qa, QP + (size_t)(256 * u2.pm + 32 * wave) * NQ + u2.pn * 256, lane_); }
        quant_row_load(pv + (size_t)er0 * D, rw, lane_);
        half_top16(B, qst, lds + 128 * SKROW, ql, hh);
        quant_row_finish(rw, nullptr, V8 + (size_t)er0 * 128, SV + er0, lane_);
        f32x4 rw2[4];
        quant_row_load(pu + (size_t)(er0 + 1) * D, rw, lane_); quant_row_load(pv + (size_t)(er0 + 1) * D, rw2, lane_);
        unsigned ca[16], cb[16];
#pragma unroll
        for (int i = 0; i < 16; ++i) { ca[i] = (__builtin_bit_cast(unsigned, A[i]) & 0x7fu) << 7; cb[i] = __builtin_bit_cast(unsigned, B[i]) & 0x7fu; }
        float X0[16], X1[16], X2[16];
#pragma unroll
        for (int j = 0; j < 16; ++j) X0[j] = cand(A[0], B[j], ca[0], cb[j]);
#pragma unroll
        for (int j = 0; j < 8; ++j) X1[j] = cand(A[1], B[j], ca[1], cb[j]);
#pragma unroll
        for (int j = 0; j < 5; ++j) X1[8 + j] = cand(A[2], B[j], ca[2], cb[j]);
#pragma unroll
        for (int j = 0; j < 3; ++j) X1[13 + j] = cand(A[4], B[j], ca[4], cb[j]);
#pragma unroll
        for (int j = 0; j < 4; ++j) X2[j] = cand(A[3], B[j], ca[3], cb[j]);
#pragma unroll
        for (int i = 5; i < 8; ++i)
#pragma unroll
            for (int j = 0; j < 2; ++j) X2[4 + 2 * (i - 5) + j] = cand(A[i], B[j], ca[i], cb[j]);
#pragma unroll
        for (int i = 8; i < 14; ++i) X2[10 + (i - 8)] = cand(A[i], B[0], ca[i], cb[0]);
        const float x14 = cand(A[14], B[0], ca[14], cb[0]), x15 = cand(A[15], B[0], ca[15], cb[0]);
        sort16(X1); sort16(X2);
        topmerge(X1, X2); topmerge(X0, X1); insert16(X0, x14); insert16(X0, x15);
        float sc[16]; float den = 0.f;
#pragma unroll
        for (int i = 0; i < 16; ++i) { sc[i] = __builtin_bit_cast(float, __builtin_bit_cast(unsigned, X0[i]) & ~0x3fffu); }
        const float m0 = sc[0];
#pragma unroll
        for (int i = 0; i < 16; ++i) { sc[i] = __expf(sc[i] - m0); den += sc[i]; }
        const float rd = 1.f / den;
        if (hh == 0) { u32x4 w0, w1;
#pragma unroll
            for (int i = 0; i < 4; ++i) { w0[i] = (__builtin_bit_cast(unsigned, X0[2 * i]) & 0x3fffu) | ((__builtin_bit_cast(unsigned, X0[2 * i + 1]) & 0x3fffu) << 16);
                w1[i] = (__builtin_bit_cast(unsigned, X0[8 + 2 * i]) & 0x3fffu) | ((__builtin_bit_cast(unsigned, X0[8 + 2 * i + 1]) & 0x3fffu) << 16); }
            u32x4* ip = (u32x4*)(IDX + (size_t)t * 128 + h * 16); ip[0] = w0; ip[1] = w1;
        } else { f32x4* gp = (f32x4*)(GATE + (size_t)t * 128 + h * 16);
#pragma unroll
            for (int i = 0; i < 4; ++i) gp[i] = (f32x4){sc[4 * i] * rd, sc[4 * i + 1] * rd, sc[4 * i + 2] * rd, sc[4 * i + 3] * rd}; }
        quant_row_finish(rw, g_ffn, U8 + (size_t)(er0 + 1) * 128, SU + er0 + 1, lane_); quant_row_finish(rw2, nullptr, V8 + (size_t)(er0 + 1) * 128, SV + er0 + 1, lane_);
    }
    __syncthreads();
}
}
__global__ void __launch_bounds__(NWAVES * 64, 2) mega_fwd(Args a) {
    extern __shared__ __attribute__((aligned(16))) unsigned char lds_raw[];
    LAS unsigned char* lds = (LAS unsigned char*)lds_raw;
    volatile LAS unsigned* MISC = (volatile LAS unsigned*)(lds + MISC_OFF);
    const int wave = __builtin_amdgcn_readfirstlane((int)threadIdx.x >> 6);
#define TID_NOW (wave * 64 + lane_now())
    const int G = gridDim.x, bx = blockIdx.x, vcu = (G % 8 == 0) ? (bx % 8) * (G / 8) + bx / 8 : bx;
    unsigned char* ws = a.ws;
    if (threadIdx.x < 32) ((LAS unsigned*)(lds + LDSCTL_OFF))[threadIdx.x] = 0u;
    __syncthreads();
    XcdBarrier bar = xcd_barrier_post((unsigned*)(ws + WS_CTL) + CW_BAR + a.li * XCD_BAR_WORDS, MISC + 8);
    const int lo = a.ph_lo, hi = a.ph_hi;
#define IN(k) (lo <= (k) && (k) < hi)
#define BOTH(k) (IN(k) && IN((k) + 1))
    if (IN(0)) { p0_prologue(a, lds, vcu * NWAVES + wave, G * NWAVES, wave, lane_now()); if (BOTH(0)) xcd_barrier(bar, wave); }
    if (IN(1)) {
        pg8::Gemm g{(const bf16*)(ws + WS_XN), (const bf16*)(ws + WS_WIN), M, NPROJ, D / 2}; pg8::StaticOrder So; So.init(M, NPROJ, G, bx);
        pg8::EpiInProj E{(bf16*)(ws + WS_P), (bf16*)(ws + WS_Q), (size_t)(WS_K - WS_Q) / 2, (const float*)(ws + WS_SA), (const float*)(ws + WS_SWIN)};
        pg8::gemm_phase<pg8::EpiInProj, pg8::StaticOrder, true, true, true>(lds, g, So, E, wave);
        if (BOTH(1)) xcd_barrier(bar, wave);
    }
    if (IN(2)) { attn::attn_phase(ws, lds, vcu, G, TID_NOW); if (BOTH(2)) xcd_barrier(bar, wave); }
    if (IN(3)) { mixp::mix_phase(a, lds, vcu * NWAVES + wave, G * NWAVES, wave, lane_now()); if (BOTH(3)) xcd_barrier(bar, wave); }
    if (IN(4)) {
        pg8::Gemm g{(const bf16*)(ws + WS_MIXIN), (const bf16*)(ws + WS_WOUT), M, D, D}; pg8::StaticOrder So; So.init(M, D, G, bx);
        pg8::EpiOutProj E{a.in[0], (bf16*)(ws + WS_XN), (float*)(ws + WS_ROWSS)};
        pg8::gemm_phase<pg8::EpiOutProj, pg8::StaticOrder, true, true>(lds, g, So, E, wave);
        if (BOTH(4)) xcd_barrier(bar, wave);
    }
    if (IN(5)) {
        pg8::Gemm g{(const bf16*)(ws + WS_XN), (const bf16*)(ws + WS_WQ), M, NQ, D}; pg8::StaticOrder So; So.init(M, NQ, G, bx);
        pg8::EpiPeerQ E{(bf16*)(ws + WS_QP), (const float*)(ws + WS_ROWSS)};
        pg8::gemm_phase<pg8::EpiPeerQ, pg8::StaticOrder, true, true>(lds, g, So, E, wave);
    }
    if (IN(6)) { topk::topk_phase(a, lds, bx, G, TID_NOW); if (BOTH(6)) xcd_barrier(bar, wave); }
    if (IN(7)) { peer::gather_phase(a, lds, vcu, G, wave, lane_now()); }
#undef IN
#undef BOTH
#undef TID_NOW
}
extern "C" void kernel_launch(void* const* d_in, const int* in_sizes, int n_in, void* d_out, int out_size, void* d_ws, size_t ws_size, hipStream_t stream) {
    static int grid = 0;
    if (grid == 0) {
        if (n_in != 12 || in_sizes[0] != M * D || out_size != M * D || ws_size < WS_END) { fprintf(stderr, "kernel_launch: unexpected shapes (n_in %d, in0 %d, out %d, ws %zu)\n", n_in, n_in > 0 ? in_sizes[0] : -1, out_size, ws_size); grid = -1; return; }
        int dev = 0, cus = 0, per_cu = 0;
        if (hipGetDevice(&dev) != hipSuccess || hipDeviceGetAttribute(&cus, hipDeviceAttributeMultiprocessorCount, dev) != hipSuccess) { fprintf(stderr, "kernel_launch: device query failed\n"); grid = -1; return; }
        if (hipFuncSetAttribute((const void*)mega_fwd, hipFuncAttributeMaxDynamicSharedMemorySize, LDS_BYTES) != hipSuccess) { fprintf(stderr, "kernel_launch: hipFuncSetAttribute failed\n"); grid = -1; return; }
        if (hipOccupancyMaxActiveBlocksPerMultiprocessor(&per_cu, (const void*)mega_fwd, NWAVES * 64, LDS_BYTES) != hipSuccess || per_cu < 1) { fprintf(stderr, "kernel_launch: occupancy query says %d blocks per CU\n", per_cu); grid = -1; (void)hipGetLastError(); return; }
        grid = cus;
    }
    if (grid < 0) return;
    (void)hipMemsetAsync((char*)d_ws + WS_CTL + CW_BAR * 4, 0, (CW_END - CW_BAR) * 4, stream);
    Args a{};
    for (int i = 0; i < 12; ++i) a.in[i] = (const float*)d_in[i];
    a.out = (float*)d_out; a.ws = (unsigned char*)d_ws; a.ph_lo = 0; a.ph_hi = 8; a.li = 0;
    hipLaunchKernelGGL(mega_fwd, dim3(grid), dim3(NWAVES * 64), LDS_BYTES, stream, a);
#ifdef PROBE_LO
    a.ph_lo = PROBE_LO; a.ph_hi = PROBE_HI; a.li = 1;
    hipLaunchKernelGGL(mega_fwd, dim3(grid), dim3(NWAVES * 64), LDS_BYTES, stream, a);
#endif
}
```

```cpp
#include <hip/hip_runtime.h>
#include <cstdio>
#include <cstdint>
__device__ __forceinline__ int lane_now() { int l; asm volatile("v_mbcnt_lo_u32_b32 %0, -1, 0\n\tv_mbcnt_hi_u32_b32 %0, -1, %0" : "=v"(l)); return l; }
namespace pg8 {
#define PG8_LAS __attribute__((address_space(3)))
typedef unsigned short bf16_t;
typedef short bf16x8 __attribute__((ext_vector_type(8)));
typedef float f32x4 __attribute__((ext_vector_type(4)));
typedef unsigned u32x4 __attribute__((ext_vector_type(4)));
typedef int i32x4 __attribute__((ext_vector_type(4)));
constexpr int BM = 256, BK = 64, HALF = 128, HTB = HALF * BK * 2  , STAGE_BYTES = 8 * HTB, NXCD = 8, WGM = 8;

__host__ __device__ __forceinline__ int lds_byte(int r, int c) { const int st = (r >> 4) * 2 + (c >> 5), rr = r & 15, cc = c & 31, ob = rr * 64 + cc * 2; return st * 1024 + (ob ^ (((ob >> 9) & 1) << 5)); }
__host__ __device__ __forceinline__ void stage_rc(int b, int& R, int& C) { const int st = b / 1024, sb = b % 1024, swz = sb ^ (((sb >> 9) & 1) << 5); R = (st >> 1) * 16 + swz / 64; C = (st & 1) * 32 + (swz % 64) / 2; }
__host__ __device__ __forceinline__ int perm32(int rho) { const int n = rho >> 4, i = rho & 15; return 8 * (i >> 2) + 4 * n + (i & 3); }

struct Unit { int pm, pn; };
struct Gemm { const bf16_t* A; const bf16_t* Bt; int M, N, K; };

struct StaticOrder {
    int nM, nN, nwg, G, c;
    __host__ __device__ void init(int M, int N, int G_, int c_) { nM = M / BM; nN = N / BM; nwg = nM * nN; G = G_; c = c_; }
    __host__ __device__ bool next(int i, Unit& u) const {
        const long L = (long)i * G + c; if (L >= nwg) return false;
        int wgid = (int)L; { const int q = nwg / NXCD, r = nwg % NXCD, xcd = wgid % NXCD, off = wgid / NXCD; wgid = (xcd < r ? xcd * (q + 1) : r * (q + 1) + (xcd - r) * q) + off; }
        const int nig = WGM * nN, gid = wgid / nig, fm = gid * WGM, gsz = (nM - fm) < WGM ? (nM - fm) : WGM;
        u.pm = fm + ((wgid % nig) % gsz); u.pn = (wgid % nig) / gsz; return true;
    }
    __device__ __forceinline__ void a_ready(const Unit&) const {}
    __device__ __forceinline__ void done(const Unit&) const {}
};

__device__ __forceinline__ unsigned cvt_pk_bf16(float lo, float hi) { unsigned r; asm volatile("v_cvt_pk_bf16_f32 %0, %1, %2" : "=v"(r) : "v"(lo), "v"(hi)); return r; }
typedef unsigned u32x2 __attribute__((ext_vector_type(2)));
constexpr float C2Q = 0.125f * 1.4426950408889634f;
struct EpiInProj {
    static constexpr bool PERM = true, AFTER_DRAIN = false;
    bf16_t* P; bf16_t* QKV; size_t ty_stride; const float* sa; const float* sw;
    __device__ __forceinline__ void operator()(const f32x4 (&acc)[2][2][4][2], const Unit& u, int wr, int wc, int fr, int fq) const {
        const int row0 = u.pm * BM + wr * 64 + fr;
        f32x4 swv[2][2];
#pragma unroll
        for (int bj = 0; bj < 2; ++bj)
#pragma unroll
            for (int n = 0; n < 2; ++n) swv[bj][n] = *(const f32x4*)(sw + u.pn * BM + bj * HALF + wc * 32 + 8 * fq + 4 * n);
#define PG8_I2F(x) __builtin_convertvector(__builtin_bit_cast(i32x4, (x)), f32x4)
        if (u.pn == 0) {
#pragma unroll
            for (int ai = 0; ai < 2; ++ai)
#pragma unroll
                for (int m = 0; m < 4; ++m) { bf16_t* rowp = P + (size_t)(row0 + ai * HALF + m * 16) * 256 + wc * 32 + 8 * fq; const float sar = sa[row0 + ai * HALF + m * 16];
#pragma unroll
                    for (int bj = 0; bj < 2; ++bj) { const f32x4 v0 = PG8_I2F(acc[ai][bj][m][0]) * swv[bj][0] * sar, v1 = PG8_I2F(acc[ai][bj][m][1]) * swv[bj][1] * sar;
                        u32x4 w; w.x = cvt_pk_bf16(v0[0], v0[1]); w.y = cvt_pk_bf16(v0[2], v0[3]); w.z = cvt_pk_bf16(v1[0], v1[1]); w.w = cvt_pk_bf16(v1[2], v1[3]);
                        *(u32x4*)(rowp + bj * HALF) = w; } }
        } else {
            const int ty = (u.pn - 1) / 3, g = (u.pn - 1) % 3, sh = 2 * g;
            const float sc = (ty == 0) ? C2Q : 1.f;
            bf16_t* base = QKV + (size_t)ty * ty_stride;
#pragma unroll
            for (int ai = 0; ai < 2; ++ai)
#pragma unroll
                for (int m = 0; m < 4; ++m) { const int row = row0 + ai * HALF + m * 16, b = row >> 11, pos = row & 2047;
                    const int seqp = ((pos & ((1 << sh) - 1)) << (11 - sh)) | (pos >> sh); const float sar = sa[row] * sc;
#pragma unroll
                    for (int bj = 0; bj < 2; ++bj) { const int cl = bj * HALF + wc * 32 + 8 * fq, hd = 4 * g + (cl >> 6), c = cl & 63;
                        const f32x4 v0 = PG8_I2F(acc[ai][bj][m][0]) * swv[bj][0] * sar, v1 = PG8_I2F(acc[ai][bj][m][1]) * swv[bj][1] * sar;
                        u32x4 w; w.x = cvt_pk_bf16(v0[0], v0[1]); w.y = cvt_pk_bf16(v0[2], v0[3]); w.z = cvt_pk_bf16(v1[0], v1[1]); w.w = cvt_pk_bf16(v1[2], v1[3]);
                        *(u32x4*)(base + ((size_t)((b * 12 + hd) * 2048 + seqp)) * 64 + c) = w; } }
        }
#undef PG8_I2F
    }
};
struct EpiOutProj {
    static constexpr bool PERM = true, AFTER_DRAIN = false;
    const float* x; bf16_t* x2b; float* rowss;
    __device__ __forceinline__ void operator()(const f32x4 (&acc)[2][2][4][2], const Unit& u, int wr, int wc, int fr, int fq) const {
        const int col0 = u.pn * BM + wc * 32 + 8 * fq;
#pragma unroll
        for (int ai = 0; ai < 2; ++ai)
#pragma unroll
            for (int m = 0; m < 4; ++m) { const int row = u.pm * BM + ai * HALF + wr * 64 + m * 16 + fr; const size_t off = (size_t)row * 1024 + col0; float ss = 0.f;
#pragma unroll
                for (int bj = 0; bj < 2; ++bj) { const size_t o2 = off + bj * HALF;
                    const f32x4 o0 = *(const f32x4*)(x + o2) + acc[ai][bj][m][0], o1 = *(const f32x4*)(x + o2 + 4) + acc[ai][bj][m][1];
                    ss += ((o0[0] * o0[0] + o0[1] * o0[1]) + (o0[2] * o0[2] + o0[3] * o0[3])) + ((o1[0] * o1[0] + o1[1] * o1[1]) + (o1[2] * o1[2] + o1[3] * o1[3]));
                    u32x4 w; w.x = cvt_pk_bf16(o0[0], o0[1]); w.y = cvt_pk_bf16(o0[2], o0[3]); w.z = cvt_pk_bf16(o1[0], o1[1]); w.w = cvt_pk_bf16(o1[2], o1[3]);
                    *(u32x4*)(x2b + o2) = w; }
                ss += __shfl_xor(ss, 16); ss += __shfl_xor(ss, 32);
                if (fq == 0) atomicAdd(rowss + row, ss); }
    }
};
struct EpiPeerQ {
    static constexpr bool PERM = true, AFTER_DRAIN = false;
    bf16_t* O; const float* rowss;
    __device__ __forceinline__ void operator()(const f32x4 (&acc)[2][2][4][2], const Unit& u, int wr, int wc, int fr, int fq) const {
        const int row0 = u.pm * BM + wr * 64 + fr, col0 = u.pn * BM + wc * 32 + 8 * fq;
#pragma unroll
        for (int ai = 0; ai < 2; ++ai)
#pragma unroll
            for (int m = 0; m < 4; ++m) { const int row = row0 + ai * HALF + m * 16; const float rs = rsqrtf(rowss[row] * (1.f / 1024.f) + 1e-6f);
                bf16_t* rowp = O + (size_t)row * 2048 + col0;
#pragma unroll
                for (int bj = 0; bj < 2; ++bj) { const f32x4 v0 = acc[ai][bj][m][0] * rs, v1 = acc[ai][bj][m][1] * rs;
                    u32x4 w; w.x = cvt_pk_bf16(v0[0], v0[1]); w.y = cvt_pk_bf16(v0[2], v0[3]); w.z = cvt_pk_bf16(v1[0], v1[1]); w.w = cvt_pk_bf16(v1[2], v1[3]);
                    *(u32x4*)(rowp + bj * HALF) = w; } }
    }
};
template <class Epi, class Sched, bool ALIGN_EPI = false, bool SP2 = false, bool I8 = false>
__device__ __forceinline__ void gemm_phase(PG8_LAS unsigned char* lds, const Gemm g, const Sched& S, const Epi& E, int wid) {
    const int lane = lane_now(), tid = wid * 64 + lane, wr = wid >> 2, wc = wid & 3, fr = lane & 15, fq = lane >> 4;
    const int K = g.K, nt = K / BK;
    unsigned voffA[2], voffB[2];
#pragma unroll
    for (int i = 0; i < 2; ++i) { int R, C; stage_rc(tid * 16 + i * 8192, R, C); const int Rb = Epi::PERM ? ((R & ~31) + perm32(R & 31)) : R;
        voffA[i] = (unsigned)(R * K + C) * 2u; voffB[i] = (unsigned)(Rb * K + C) * 2u; }
    const size_t kstep = (size_t)(BK * 2);
    const size_t hstep = (size_t)HALF * K * 2;
    const size_t tstep = 2 * hstep;
    const unsigned ldsw = (unsigned)wid * 1024u;
    const int aoff = lds_byte(wr * 64 + fr, fq * 8), boff = lds_byte(wc * 32 + fr, fq * 8);
#define PG8_SA(b, h) (((b) * 2 + (h)) * HTB)
#define PG8_SB(b, h) ((4 + (b) * 2 + (h)) * HTB)
#define PG8_STAGE(bufoff, gbase, voff) do { _Pragma("unroll") for (int _i = 0; _i < 2; ++_i) \
        __builtin_amdgcn_global_load_lds((const unsigned*)((const char*)(gbase) + (voff)[_i]), (PG8_LAS unsigned*)(lds + (bufoff) + ldsw + _i * 8192), 16, 0, 0); } while (0)
#define PG8_LDA(dst, b, h) do { _Pragma("unroll") for (int m = 0; m < 4; ++m) _Pragma("unroll") for (int k = 0; k < 2; ++k) dst[m][k] = *(const PG8_LAS bf16x8*)(lds + PG8_SA(b, h) + aoff + m * 2048 + k * 1024); } while (0)
#define PG8_LDB(dst, b, h) do { _Pragma("unroll") for (int n = 0; n < 2; ++n) _Pragma("unroll") for (int k = 0; k < 2; ++k) dst[n][k] = *(const PG8_LAS bf16x8*)(lds + PG8_SB(b, h) + boff + n * 2048 + k * 1024); } while (0)
#define PG8_MMA(ai, bj, At, Bt) do { __builtin_amdgcn_s_setprio(1); _Pragma("unroll") for (int m = 0; m < 4; ++m) _Pragma("unroll") for (int n = 0; n < 2; ++n) _Pragma("unroll") for (int k = 0; k < 2; ++k) \
        { if constexpr (I8) acc[ai][bj][m][n] = __builtin_bit_cast(f32x4, __builtin_amdgcn_mfma_i32_16x16x64_i8(__builtin_bit_cast(i32x4, Bt[n][k]), __builtin_bit_cast(i32x4, At[m][k]), __builtin_bit_cast(i32x4, acc[ai][bj][m][n]), 0, 0, 0)); \
          else acc[ai][bj][m][n] = __builtin_amdgcn_mfma_f32_16x16x32_bf16(Bt[n][k], At[m][k], acc[ai][bj][m][n], 0, 0, 0); } __builtin_amdgcn_s_setprio(0); } while (0)
#define PG8_WAIT_V(n) asm volatile("s_waitcnt vmcnt(" #n ")" ::: "memory")
#define PG8_WAIT_L(n) asm volatile("s_waitcnt lgkmcnt(" #n ")" ::: "memory")
#define PG8_BAR __builtin_amdgcn_s_barrier()
#define PG8_SCHED __builtin_amdgcn_sched_barrier(0)
    Unit cur, nxt; int ui = 0;
    if (!S.next(0, cur)) return;
    f32x4 acc[2][2][4][2];
#pragma unroll
    for (int a = 0; a < 2; ++a)
#pragma unroll
        for (int b = 0; b < 2; ++b)
#pragma unroll
            for (int m = 0; m < 4; ++m)
#pragma unroll
                for (int n = 0; n < 2; ++n) acc[a][b][m][n] = (f32x4){0.f, 0.f, 0.f, 0.f};
    bf16x8 At[4][2], B0[2][2], B1[2][2];
    const char* cA = (const char*)g.A + (size_t)cur.pm * tstep; const char* cB = (const char*)g.Bt + (size_t)cur.pn * tstep;
    S.a_ready(cur);
    if constexpr (SP2) {
        PG8_STAGE(PG8_SB(0, 0), cB, voffB); PG8_STAGE(PG8_SB(0, 1), cB + hstep, voffB); PG8_STAGE(PG8_SA(0, 0), cA, voffA); PG8_STAGE(PG8_SA(0, 1), cA + hstep, voffA);
        if (wr == 1) PG8_BAR;
        PG8_WAIT_V(2); PG8_BAR;
        PG8_STAGE(PG8_SB(1, 0), cB + kstep, voffB); PG8_STAGE(PG8_SA(1, 0), cA + kstep, voffA); PG8_STAGE(PG8_SB(1, 1), cB + hstep + kstep, voffB);
        PG8_WAIT_V(6); PG8_BAR;
    } else {
        PG8_STAGE(PG8_SB(0, 0), cB, voffB); PG8_STAGE(PG8_SA(0, 0), cA, voffA); PG8_STAGE(PG8_SB(0, 1), cB + hstep, voffB); PG8_STAGE(PG8_SA(0, 1), cA + hstep, voffA);
        if (wr == 1) PG8_BAR;
        PG8_WAIT_V(4); PG8_BAR;
        PG8_STAGE(PG8_SB(1, 0), cB + kstep, voffB); PG8_STAGE(PG8_SA(1, 0), cA + kstep, voffA); PG8_STAGE(PG8_SB(1, 1), cB + hstep + kstep, voffB);
        PG8_WAIT_V(6); PG8_BAR;
    }
    for (;;) {
        const bool has_next = S.next(ui + 1, nxt);
        const char* nA = has_next ? (const char*)g.A + (size_t)nxt.pm * tstep : cA; const char* nB = has_next ? (const char*)g.Bt + (size_t)nxt.pn * tstep : cB;
        for (int t = 0; t < nt; t += 2) {
            const bool last = (t == nt - 2);
            const char* a1 = cA + (size_t)(t + 1) * kstep;
            const char* a2 = last ? nA : cA + (size_t)(t + 2) * kstep; const char* b2 = last ? nB : cB + (size_t)(t + 2) * kstep;
            const char* a3 = a2 + kstep; const char* b3 = b2 + kstep;
            if (last && has_next) S.a_ready(nxt);
            if constexpr (SP2) {
            PG8_LDB(B0, 0, 0); PG8_LDB(B1, 0, 1); PG8_SCHED; PG8_LDA(At, 0, 0); PG8_STAGE(PG8_SA(1, 1), a1 + hstep, voffA);
            PG8_WAIT_V(8); PG8_WAIT_L(0); PG8_BAR; PG8_MMA(0, 0, At, B0); PG8_MMA(0, 1, At, B1); PG8_BAR; PG8_SCHED;
            PG8_LDA(At, 0, 1); PG8_STAGE(PG8_SB(0, 0), b2, voffB); PG8_STAGE(PG8_SB(0, 1), b2 + hstep, voffB); PG8_STAGE(PG8_SA(0, 0), a2, voffA);
            PG8_WAIT_V(8); PG8_WAIT_L(0); PG8_BAR; PG8_MMA(1, 0, At, B0); PG8_MMA(1, 1, At, B1); PG8_BAR; PG8_SCHED;
            PG8_LDB(B0, 1, 0); PG8_LDB(B1, 1, 1); PG8_SCHED; PG8_LDA(At, 1, 0); PG8_STAGE(PG8_SA(0, 1), a2 + hstep, voffA);
            PG8_WAIT_V(8); PG8_WAIT_L(0); PG8_BAR; PG8_MMA(0, 0, At, B0); PG8_MMA(0, 1, At, B1); PG8_BAR; PG8_SCHED;
            PG8_LDA(At, 1, 1); PG8_STAGE(PG8_SB(1, 0), b3, voffB); PG8_STAGE(PG8_SB(1, 1), b3 + hstep, voffB); PG8_STAGE(PG8_SA(1, 0), a3, voffA);
            PG8_WAIT_V(8); PG8_WAIT_L(0); PG8_BAR; PG8_MMA(1, 0, At, B0); PG8_MMA(1, 1, At, B1); PG8_BAR; PG8_SCHED;
            } else {
            PG8_LDB(B0, 0, 0); PG8_SCHED; PG8_LDA(At, 0, 0); PG8_STAGE(PG8_SA(1, 1), a1 + hstep, voffA);
            PG8_WAIT_L(8); PG8_BAR; PG8_WAIT_L(0); PG8_MMA(0, 0, At, B0); PG8_BAR; PG8_SCHED;
            PG8_LDB(B1, 0, 1); PG8_STAGE(PG8_SB(0, 0), b2, voffB);
            PG8_BAR; PG8_WAIT_L(0); PG8_MMA(0, 1, At, B1); PG8_BAR;
            PG8_LDA(At, 0, 1); PG8_STAGE(PG8_SA(0, 0), a2, voffA);
            PG8_BAR; PG8_WAIT_L(0); PG8_MMA(1, 0, At, B0); PG8_BAR; PG8_SCHED;
            PG8_STAGE(PG8_SB(0, 1), b2 + hstep, voffB);
            PG8_WAIT_V(6); PG8_BAR; PG8_MMA(1, 1, At, B1); PG8_BAR;
            PG8_LDB(B0, 1, 0); PG8_SCHED; PG8_LDA(At, 1, 0); PG8_STAGE(PG8_SA(0, 1), a2 + hstep, voffA);
            PG8_WAIT_L(8); PG8_BAR; PG8_WAIT_L(0); PG8_MMA(0, 0, At, B0); PG8_BAR; PG8_SCHED;
            PG8_LDB(B1, 1, 1); PG8_STAGE(PG8_SB(1, 0), b3, voffB);
            PG8_BAR; PG8_WAIT_L(0); PG8_MMA(0, 1, At, B1); PG8_BAR;
            PG8_LDA(At, 1, 1); PG8_STAGE(PG8_SA(1, 0), a3, voffA);
            PG8_BAR; PG8_WAIT_L(0); PG8_MMA(1, 0, At, B0); PG8_BAR; PG8_SCHED;
            PG8_STAGE(PG8_SB(1, 1), b3 + hstep, voffB);
            PG8_WAIT_V(6); PG8_BAR; PG8_MMA(1, 1, At, B1); PG8_BAR;
            }
        }
        if constexpr (ALIGN_EPI) { if (wr == 0) PG8_BAR; }
        if constexpr (!Epi::AFTER_DRAIN) { E(acc, cur, wr, wc, fr, fq); S.done(cur); }
        if (!has_next) break;
#pragma unroll
        for (int a = 0; a < 2; ++a)
#pragma unroll
            for (int b = 0; b < 2; ++b)
#pragma unroll
                for (int m = 0; m < 4; ++m)
#pragma unroll
                    for (int n = 0; n < 2; ++n) acc[a][b][m][n] = (f32x4){0.f, 0.f, 0.f, 0.f};
        cur = nxt; cA = nA; cB = nB; ++ui;
        if constexpr (ALIGN_EPI) { if (wr == 1) PG8_BAR; }
    }
    PG8_WAIT_V(0);
    if constexpr (!ALIGN_EPI) { if (wr == 0) PG8_BAR; }
    PG8_BAR;
    if constexpr (Epi::AFTER_DRAIN) { E.fused(acc, cur, wr, wc, fr, fq, lds, wid, lane); S.done(cur); }
#undef PG8_SA
#undef PG8_SB
#undef PG8_STAGE
#undef PG8_LDA
#undef PG8_LDB
#undef PG8_MMA
#undef PG8_WAIT_V
#undef PG8_WAIT_L
#undef PG8_BAR
#undef PG8_SCHED
}
}
constexpr int M = 32768, D = 1024, S = 2048;
constexpr int NPROJ = 2560, NQ = 2048, NEXP = 16384;
typedef unsigned short bf16;
constexpr size_t MiB = 1u << 20;
constexpr size_t WS_CTL = 0, CTL_ZERO_BYTES = 1 * MiB;
constexpr size_t WS_WIN = 2 * MiB, WS_WOUT = 8 * MiB, WS_WQ = 10 * MiB;
constexpr size_t WS_SK = 14 * MiB, WS_WPT = 14 * MiB + 512 * 1024;
constexpr size_t WS_SA = 15 * MiB + 640 * 1024, WS_SWIN = 15 * MiB + 768 * 1024;
constexpr size_t WS_SU = 15 * MiB, WS_SV = 15 * MiB + 64 * 1024, WS_ROWSS = 15 * MiB + 512 * 1024;
constexpr size_t WS_U8 = 16 * MiB, WS_V8 = 32 * MiB;
constexpr size_t WS_XN = 48 * MiB;
constexpr size_t WS_P = 112 * MiB;
constexpr size_t WS_Q = 128 * MiB, WS_K = 176 * MiB, WS_V = 224 * MiB;
constexpr size_t WS_ORAW = 272 * MiB, WS_LSE = 320 * MiB, WS_MIXIN = 322 * MiB, WS_END = 386 * MiB;
constexpr size_t WS_QP = 128 * MiB, WS_IDX = 256 * MiB, WS_GATE = 264 * MiB, WS_X8 = 280 * MiB;
constexpr size_t WS_PROJ = 386 * MiB;
constexpr int CW_BAR = 4096;
constexpr int CW_CMAX = CW_BAR + 2 * 3456, CW_CCNT = CW_CMAX + NPROJ, CW_END = CW_CCNT + NPROJ / 32;

constexpr int RING_BYTES = 147456;
constexpr int LDSCTL_OFF = RING_BYTES, MISC_OFF = LDSCTL_OFF;
constexpr int LDS_BYTES = RING_BYTES + 128;
constexpr int NWAVES = 8;

#define GAS __attribute__((address_space(1)))
#define LAS __attribute__((address_space(3)))
typedef unsigned v4u __attribute__((ext_vector_type(4)));
typedef float f32x4 __attribute__((ext_vector_type(4)));
typedef GAS unsigned gu32;
#define LDS_WAIT() asm volatile("s_waitcnt lgkmcnt(0)" ::: "memory")
#define VM_WAIT() asm volatile("s_waitcnt vmcnt(0)" ::: "memory")
__device__ __forceinline__ unsigned f2bf(float f) { unsigned u = __builtin_bit_cast(unsigned, f); return (u + 0x7fffu + ((u >> 16) & 1u)) >> 16; }
__device__ __forceinline__ unsigned pk2(float lo, float hi) { return f2bf(lo) | (f2bf(hi) << 16); }
__device__ __forceinline__ float bf2f(unsigned short b) { return __builtin_bit_cast(float, (unsigned)b << 16); }
template <int CTRL> __device__ __forceinline__ float dpp_mov(float v) { return __builtin_bit_cast(float, __builtin_amdgcn_mov_dpp(__builtin_bit_cast(int, v), CTRL, 0xF, 0xF, true)); }
__device__ __forceinline__ float lane_val(float v, int l) { return __builtin_bit_cast(float, __builtin_amdgcn_readlane(__builtin_bit_cast(int, v), l)); }
__device__ __forceinline__ float wave_sum(float v) {
    v += dpp_mov<0xB1>(v); v += dpp_mov<0x4E>(v); v += dpp_mov<0x141>(v); v += dpp_mov<0x140>(v);
    return (lane_val(v, 0) + lane_val(v, 16)) + (lane_val(v, 32) + lane_val(v, 48));
}
__device__ __forceinline__ float wave_max(float v) {
    v = fmaxf(v, dpp_mov<0xB1>(v)); v = fmaxf(v, dpp_mov<0x4E>(v)); v = fmaxf(v, dpp_mov<0x141>(v)); v = fmaxf(v, dpp_mov<0x140>(v));
    return fmaxf(fmaxf(lane_val(v, 0), lane_val(v, 16)), fmaxf(lane_val(v, 32), lane_val(v, 48)));
}
#define XB_TMO      128
#define XB_XCNT(j)  (256  + 64 * (j))
#define XB_XSUB(j)  (1280 + 64 * (j))
#define XB_XGEN(j)  (2304 + 64 * (j))
#define XB_TOP      3328
#define XB_TOPGEN   3392
#define XCD_BAR_WORDS 3456
#define XB_SPIN_CAP (1u << 18)

__device__ __forceinline__ unsigned xb_ld(unsigned* p)              { return __hip_atomic_load(p, __ATOMIC_RELAXED, __HIP_MEMORY_SCOPE_AGENT); }
__device__ __forceinline__ unsigned xb_add(unsigned* p, unsigned v) { return __hip_atomic_fetch_add(p, v, __ATOMIC_RELAXED, __HIP_MEMORY_SCOPE_AGENT); }
__device__ __forceinline__ unsigned xb_xcc_id() { return (unsigned)__builtin_amdgcn_s_getreg((3 << 11) | 20) & 0xFu; }
#define XB_SPIN(cond, bar) do { unsigned _sp = 0; while (cond) { __builtin_amdgcn_s_sleep(1); \
    if ((++_sp & 255u) == 0u) { if (xb_ld(&(bar)[XB_TMO])) break; if (_sp > XB_SPIN_CAP) { atomicAdd(&(bar)[XB_TMO], 1u); break; } } } } while (0)

struct XcdBarrier {
    unsigned* bar; unsigned x;
    volatile LAS unsigned* st;
};

__device__ __forceinline__ XcdBarrier xcd_barrier_post(unsigned* bar, volatile LAS unsigned* st) {
    XcdBarrier b; b.bar = bar; b.x = xb_xcc_id(); b.st = st;
    if (threadIdx.x == 0) (void)xb_add(&bar[XB_XCNT(b.x)], 1u);
    return b;
}
__device__ __forceinline__ void xcd_barrier_complete(unsigned* bar, unsigned x, unsigned& nloc, unsigned& nx) {
    const unsigned G = gridDim.x * gridDim.y * gridDim.z;
    unsigned sum, cnt, mine, sp = 0u;
    for (;;) {
        sum = 0u; cnt = 0u; mine = 0u;
#pragma unroll
        for (unsigned j = 0; j < 16; ++j) { const unsigned c = xb_ld(&bar[XB_XCNT(j)]); sum += c; cnt += (c > 0u) ? 1u : 0u; mine = (j == x) ? c : mine; }
        if (sum == G) break;
        __builtin_amdgcn_s_sleep(1);
        if ((++sp & 255u) == 0u) { if (xb_ld(&bar[XB_TMO])) break; if (sp > XB_SPIN_CAP) { atomicAdd(&bar[XB_TMO], 1u); break; } }
    }
    nloc = mine > 0u ? mine : 1u; nx = cnt > 0u ? cnt : 1u;
}

__device__ __forceinline__ void xcd_barrier(const XcdBarrier& b, int wave_) {
    asm volatile("s_waitcnt vmcnt(0)" ::: "memory");
    __syncthreads();
    if (wave_ == 0 && lane_now() == 0) {
        unsigned* bar = b.bar;
        __builtin_amdgcn_s_waitcnt(0);
        unsigned nloc = b.st[0], nx = b.st[1];
        if (nloc == 0u) { xcd_barrier_complete(bar, b.x, nloc, nx); b.st[0] = nloc; b.st[1] = nx; }
        const unsigned old = xb_add(&bar[XB_XSUB(b.x)], 1u);
        const unsigned gen = old / nloc;
        if (old + 1u == (gen + 1u) * nloc) {
            __builtin_amdgcn_fence(__ATOMIC_RELEASE, "agent");
            asm volatile("s_waitcnt vmcnt(0)" ::: "memory");
            const unsigned og = xb_add(&bar[XB_TOP], 1u);
            const unsigned tg = og / nx;
            if (og + 1u == (tg + 1u) * nx) xb_add(&bar[XB_TOPGEN], 1u);
            else XB_SPIN(xb_ld(&bar[XB_TOPGEN]) == tg, bar);
            __builtin_amdgcn_fence(__ATOMIC_ACQUIRE, "agent");
            xb_add(&bar[XB_XGEN(b.x)], 1u);
            asm volatile("s_waitcnt vmcnt(0)" ::: "memory");
        } else {
            XB_SPIN(xb_ld(&bar[XB_XGEN(b.x)]) == gen, bar);
            __builtin_amdgcn_fence(__ATOMIC_ACQUIRE, "agent");
            asm volatile("s_waitcnt vmcnt(0)" ::: "memory");
        }
    }
    __syncthreads();
}
struct Args { const float* in[12]; float* out; unsigned char* ws; int ph_lo, ph_hi, li, pad; };

__device__ __forceinline__ void p0_transpose_item(const float* W, int K, int N, bf16* WT, const float* kscale, LAS float* scr, int item, int lane) {
    const int nblk = N / 32, kb = item / nblk, nb = item % nblk, k0 = 64 * kb, n0 = 32 * nb;
#pragma unroll 8
    for (int i = 0; i < 32; ++i) { const int kk = 2 * i + (lane >> 5); float w = W[(size_t)(k0 + kk) * N + n0 + (lane & 31)]; if (kscale) w *= kscale[k0 + kk]; scr[kk * 33 + (lane & 31)] = w; }
    LDS_WAIT(); asm volatile("" ::: "memory");
    const int c = lane & 7;
#pragma unroll
    for (int j = 0; j < 4; ++j) { const int n = (lane >> 3) + 8 * j; const LAS float* s = scr + (8 * c) * 33 + n;
        v4u o; o.x = pk2(s[0 * 33], s[1 * 33]); o.y = pk2(s[2 * 33], s[3 * 33]); o.z = pk2(s[4 * 33], s[5 * 33]); o.w = pk2(s[6 * 33], s[7 * 33]);
        *(GAS v4u*)(WT + (size_t)(n0 + n) * K + k0 + 8 * c) = o; }
    LDS_WAIT(); asm volatile("" ::: "memory");
}
__device__ __forceinline__ void p0_quant_publish(const float* W, int N, unsigned* cmax, unsigned* ccnt, LAS float* scr, int item, int lane) {
    const int nblk = N / 32, kb = item / nblk, nb = item % nblk, k0 = 64 * kb, n0 = 32 * nb;
    float mx = 0.f;
#pragma unroll 8
    for (int i = 0; i < 32; ++i) { const int kk = 2 * i + (lane >> 5); const float w = W[(size_t)(k0 + kk) * N + n0 + (lane & 31)]; scr[kk * 33 + (lane & 31)] = w; mx = fmaxf(mx, fabsf(w)); }
    { const auto rr = __builtin_amdgcn_permlane32_swap(__builtin_bit_cast(unsigned, mx), __builtin_bit_cast(unsigned, mx), false, false);
      mx = fmaxf(__builtin_bit_cast(float, (unsigned)rr[0]), __builtin_bit_cast(float, (unsigned)rr[1])); }
    if (lane < 32) __hip_atomic_fetch_max(cmax + n0 + lane, __builtin_bit_cast(unsigned, mx), __ATOMIC_RELAXED, __HIP_MEMORY_SCOPE_AGENT);
    asm volatile("s_waitcnt vmcnt(0)" ::: "memory");
    if (lane == 0) __hip_atomic_fetch_add(ccnt + nb, 1u, __ATOMIC_RELAXED, __HIP_MEMORY_SCOPE_AGENT);
}
__device__ __forceinline__ void p0_quant_finish(int N, signed char* W8, float* sw, unsigned* cmax, unsigned* ccnt, LAS float* scr, int item, int lane) {
    const int nblk = N / 32, kb = item / nblk, nb = item % nblk, k0 = 64 * kb, n0 = 32 * nb;
    if (lane == 0) { unsigned sp = 0; while (__hip_atomic_load(ccnt + nb, __ATOMIC_RELAXED, __HIP_MEMORY_SCOPE_AGENT) < 16u) { __builtin_amdgcn_s_sleep(1); if (++sp > (1u << 22)) break; } }
    asm volatile("s_waitcnt vmcnt(0) lgkmcnt(0)" ::: "memory");
    __builtin_amdgcn_wave_barrier();
#pragma unroll
    for (int j = 0; j < 2; ++j) { const int n = 16 * j + (lane >> 2), ck = lane & 3;
        const float cm = __builtin_bit_cast(float, __hip_atomic_load(cmax + n0 + n, __ATOMIC_RELAXED, __HIP_MEMORY_SCOPE_AGENT));
        const float inv = cm > 0.f ? 127.f / cm : 0.f;
        if (kb == 0 && ck == 0) sw[n0 + n] = cm > 0.f ? cm * (1.f / 127.f) : 1.f;
        v4u o;
#pragma unroll
        for (int q = 0; q < 4; ++q) { const LAS float* sp_ = scr + (16 * ck + 4 * q) * 33 + n;
            const int a = (int)rintf(sp_[0] * inv), b = (int)rintf(sp_[33] * inv), c = (int)rintf(sp_[66] * inv), d = (int)rintf(sp_[99] * inv);
            o[q] = (unsigned)(a & 0xff) | ((unsigned)(b & 0xff) << 8) | ((unsigned)(c & 0xff) << 16) | ((unsigned)(d & 0xff) << 24); }
        *(GAS v4u*)(W8 + (size_t)(n0 + n) * 1024 + k0 + 16 * ck) = o; }
    LDS_WAIT(); asm volatile("" ::: "memory");
}
__device__ __forceinline__ void p0_quant_item(const float* W, int N, signed char* W8, float* sw, unsigned* cmax, unsigned* ccnt, LAS float* scr, int item, int lane) {
    p0_quant_publish(W, N, cmax, ccnt, scr, item, lane); p0_quant_finish(N, W8, sw, cmax, ccnt, scr, item, lane);
}
__device__ __forceinline__ void rms_row_to_bf16(const float* xrow, const float* g, bf16* orow, int lane) {
    const GAS f32x4* xr = (const GAS f32x4*)xrow + lane;
    f32x4 v[4]; float s = 0.f;
#pragma unroll
    for (int j = 0; j < 4; ++j) { v[j] = xr[64 * j]; s += (v[j].x * v[j].x + v[j].y * v[j].y) + (v[j].z * v[j].z + v[j].w * v[j].w); }
    const float r = rsqrtf(wave_sum(s) * (1.f / D) + 1e-6f);
    GAS unsigned long long* o8 = (GAS unsigned long long*)orow + lane;
#pragma unroll
    for (int j = 0; j < 4; ++j) { const f32x4 gg = ((const GAS f32x4*)g)[lane + 64 * j];
        o8[64 * j] = (unsigned long long)pk2(v[j].x * r * gg.x, v[j].y * r * gg.y) | ((unsigned long long)pk2(v[j].z * r * gg.z, v[j].w * r * gg.w) << 32); }
}
__device__ __forceinline__ void quant_row_i8(const float* src, const float* gsc, signed char* dst, float* scale_out, int lane) {
    const GAS f32x4* p = (const GAS f32x4*)src + 4 * lane;
    f32x4 v[4]; float amax = 0.f;
#pragma unroll
    for (int j = 0; j < 4; ++j) { v[j] = p[j]; if (gsc) v[j] = v[j] * ((const GAS f32x4*)gsc)[4 * lane + j];
        amax = fmaxf(amax, fmaxf(fmaxf(fabsf(v[j].x), fabsf(v[j].y)), fmaxf(fabsf(v[j].z), fabsf(v[j].w)))); }
    amax = wave_max(amax);
    const float inv = amax > 0.f ? 127.f / amax : 0.f;
    v4u w;
#pragma unroll
    for (int j = 0; j < 4; ++j) { const int a = (int)rintf(v[j].x * inv), b = (int)rintf(v[j].y * inv), c = (int)rintf(v[j].z * inv), d = (int)rintf(v[j].w * inv);
        w[j] = (unsigned)(a & 0xff) | ((unsigned)(b & 0xff) << 8) | ((unsigned)(c & 0xff) << 16) | ((unsigned)(d & 0xff) << 24); }
    *(GAS v4u*)(dst + (size_t)(lane >> 3) * ((size_t)NEXP * 128) + 16 * (lane & 7)) = w;
    if (lane == 0) *scale_out = amax > 0.f ? amax * (1.f / 127.f) : 1.f;
}
__device__ __forceinline__ void quant_row_load(const float* src, f32x4 (&v)[4], int lane) {
    const GAS f32x4* p = (const GAS f32x4*)src + 4 * lane;
#pragma unroll
    for (int j = 0; j < 4; ++j) v[j] = p[j];
}
__device__ __forceinline__ void quant_row_finish(f32x4 (&v)[4], const float* gsc, signed char* dst, float* scale_out, int lane) {
    float amax = 0.f;
#pragma unroll
    for (int j = 0; j < 4; ++j) { if (gsc) v[j] = v[j] * ((const GAS f32x4*)gsc)[4 * lane + j];
        amax = fmaxf(amax, fmaxf(fmaxf(fabsf(v[j].x), fabsf(v[j].y)), fmaxf(fabsf(v[j].z), fabsf(v[j].w)))); }
    amax = wave_max(amax);
    const float inv = amax > 0.f ? 127.f / amax : 0.f;
    v4u w;
#pragma unroll
    for (int j = 0; j < 4; ++j) { const int a = (int)rintf(v[j].x * inv), b = (int)rintf(v[j].y * inv), c = (int)rintf(v[j].z * inv), d = (int)rintf(v[j].w * inv);
        w[j] = (unsigned)(a & 0xff) | ((unsigned)(b & 0xff) << 8) | ((unsigned)(c & 0xff) << 16) | ((unsigned)(d & 0xff) << 24); }
    *(GAS v4u*)(dst + (size_t)(lane >> 3) * ((size_t)NEXP * 128) + 16 * (lane & 7)) = w;
    if (lane == 0) *scale_out = amax > 0.f ? amax * (1.f / 127.f) : 1.f;
}
__device__ __forceinline__ void p0_prologue(const Args& a, LAS unsigned char* lds, int gw, int NGW, int wave, int lane) {
    unsigned char* ws = a.ws;
    LAS float* scr = (LAS float*)(lds + wave * 17408);
    LAS float* scr2 = scr + 64 * 33;
    const float* w_in = a.in[2]; const float* w_pool = a.in[3]; const float* w_out = a.in[5]; const float* g_ffn = a.in[6]; const float* w_q = a.in[7];
    constexpr int I_IN = (D / 64) * (NPROJ / 32), I_OUT = (D / 64) * (D / 32), I_Q = (D / 64) * (NQ / 32), I_P = 4 * 2;
    constexpr int NITEMS = I_IN + I_OUT + I_Q + I_P;
    unsigned* cmax_ = (unsigned*)(ws + WS_CTL) + CW_CMAX; unsigned* ccnt_ = (unsigned*)(ws + WS_CTL) + CW_CCNT;
    const bool defer = gw < I_IN;
    if (defer) p0_quant_publish(w_in, NPROJ, cmax_, ccnt_, scr, gw, lane);
    for (int it = defer ? gw + NGW : gw; it < NITEMS; it += NGW) {
        int r = it;
        if (r < I_IN) { p0_quant_item(w_in, NPROJ, (signed char*)(ws + WS_WIN), (float*)(ws + WS_SWIN), cmax_, ccnt_, scr2, r, lane); continue; } r -= I_IN;
        if (r < I_OUT) { p0_transpose_item(w_out, D, D, (bf16*)(ws + WS_WOUT), nullptr, scr2, r, lane); continue; } r -= I_OUT;
        if (r < I_Q) { p0_transpose_item(w_q, D, NQ, (bf16*)(ws + WS_WQ), g_ffn, scr2, r, lane); continue; } r -= I_Q;
        p0_transpose_item(w_pool + (r >> 1) * 4096, 64, 64, (bf16*)(ws + WS_WPT) + (r >> 1) * 4096, nullptr, scr2, r & 1, lane);
    }
    constexpr int R_X = M, R_SK = 256, R_Z = 32, NROWS = R_X + R_SK + R_Z;
    for (int c4 = gw; c4 < R_X / 4; c4 += NGW) {
        const GAS f32x4* xr = (const GAS f32x4*)(a.in[0] + (size_t)c4 * 4 * D) + lane;
        f32x4 v[4][4]; float ssq[4];
#pragma unroll
        for (int rr = 0; rr < 4; ++rr)
#pragma unroll
            for (int j = 0; j < 4; ++j) v[rr][j] = xr[rr * (D / 4) + 64 * j];
#pragma unroll
        for (int rr = 0; rr < 4; ++rr) { float s_ = 0.f;
#pragma unroll
            for (int j = 0; j < 4; ++j) s_ += (v[rr][j].x * v[rr][j].x + v[rr][j].y * v[rr][j].y) + (v[rr][j].z * v[rr][j].z + v[rr][j].w * v[rr][j].w);
            ssq[rr] = s_; }
#pragma unroll
        for (int rr = 0; rr < 4; ++rr) ssq[rr] = wave_sum(ssq[rr]);
#pragma unroll
        for (int rr = 0; rr < 4; ++rr) { const float rs = rsqrtf(ssq[rr] * (1.f / D) + 1e-6f);
            GAS unsigned* o4 = (GAS unsigned*)((signed char*)(ws + WS_XN) + ((size_t)c4 * 4 + rr) * D) + lane;
            f32x4 y[4]; float am = 0.f;
#pragma unroll
            for (int j = 0; j < 4; ++j) { const f32x4 gg = ((const GAS f32x4*)a.in[1])[lane + 64 * j]; y[j] = v[rr][j] * gg * rs;
                am = fmaxf(am, fmaxf(fmaxf(fabsf(y[j].x), fabsf(y[j].y)), fmaxf(fabsf(y[j].z), fabsf(y[j].w)))); }
            am = wave_max(am); const float qi = am > 0.f ? 127.f / am : 0.f;
#pragma unroll
            for (int j = 0; j < 4; ++j) { const int q0 = (int)rintf(y[j].x * qi), q1 = (int)rintf(y[j].y * qi), q2 = (int)rintf(y[j].z * qi), q3 = (int)rintf(y[j].w * qi);
                o4[64 * j] = (unsigned)(q0 & 0xff) | ((unsigned)(q1 & 0xff) << 8) | ((unsigned)(q2 & 0xff) << 16) | ((unsigned)q3 << 24); }
            if (lane == 0) ((float*)(ws + WS_SA))[(size_t)c4 * 4 + rr] = am > 0.f ? am * (1.f / 127.f) : 1.f; }
    }
    for (int it = R_X + gw; it < NROWS; it += NGW) {
        int r = it - R_X;
        if (r < R_SK) { const GAS f32x4* p = (const GAS f32x4*)(a.in[8] + (size_t)r * 1024) + lane; GAS unsigned long long* o8 = (GAS unsigned long long*)((bf16*)(ws + WS_SK) + (size_t)r * 1024) + lane;
#pragma unroll
            for (int j = 0; j < 4; ++j) { const f32x4 v = p[64 * j]; o8[64 * j] = (unsigned long long)pk2(v.x, v.y) | ((unsigned long long)pk2(v.z, v.w) << 32); }
            continue; } r -= R_SK;
        { GAS f32x4* z = (GAS f32x4*)((float*)(ws + WS_ROWSS) + (size_t)r * 1024) + lane;
#pragma unroll
          for (int j = 0; j < 4; ++j) z[64 * j] = (f32x4){0.f, 0.f, 0.f, 0.f}; }
    }
    if (defer) p0_quant_finish(NPROJ, (signed char*)(ws + WS_WIN), (float*)(ws + WS_SWIN), cmax_, ccnt_, scr, gw, lane);
}
namespace attn {
typedef short bf16x8 __attribute__((ext_vector_type(8)));
typedef short s16x4 __attribute__((ext_vector_type(4)));
typedef float f32x16 __attribute__((ext_vector_type(16)));
typedef float f32x2_t __attribute__((ext_vector_type(2)));
typedef __bf16 bf16x2_t __attribute__((ext_vector_type(2)));
typedef unsigned u32x4 __attribute__((ext_vector_type(4)));
typedef unsigned u32x2 __attribute__((ext_vector_type(2)));
constexpr int KROW = 144;
constexpr int SLOT = 2 * 256 * KROW;
__device__ __forceinline__ unsigned cvtpk(float lo, float hi) { f32x2_t v = {lo, hi}; bf16x2_t b = __builtin_convertvector(v, bf16x2_t); return __builtin_bit_cast(unsigned, b); }
__device__ __forceinline__ s16x4 vtr(LAS const unsigned char* p) { return __builtin_bit_cast(s16x4, __builtin_amdgcn_ds_read_tr16_b64_v4i16((LAS s16x4*)p)); }

__device__ __forceinline__ void attn_phase(unsigned char* ws, LAS unsigned char* lds, int vcu, int G, int tid) {
    const int lane = tid & 63, wv = __builtin_amdgcn_readfirstlane(tid >> 6), grp = wv >> 2, w = wv & 3, tl = tid & 255;
    const int ql = lane & 31, h = lane >> 5;
    LAS unsigned char* Ks = lds + grp * SLOT; LAS unsigned char* Vs = Ks + 256 * KROW;
    const bf16* Qd = (const bf16*)(ws + WS_Q); const bf16* Kd = (const bf16*)(ws + WS_K); const bf16* Vd = (const bf16*)(ws + WS_V);
    bf16* ORAW = (bf16*)(ws + WS_ORAW); float* LSE = (float*)(ws + WS_LSE);
#define ATT_UNIT(pi_) const int uid = 2 * (pi_) + grp, bh = uid >> 4, cu = uid & 15, hd = bh % 12, b = bh / 12, sh = 2 * (hd >> 2), L = 2048 >> sh; \
        const int r = cu >> (4 - sh), n = cu & ((16 >> sh) - 1), q0 = 128 * n; const size_t pbase = ((size_t)bh * 2048 + (size_t)r * L) * 64;
#define ATT_LOAD(pi_) do { ATT_UNIT(pi_) (void)b; (void)hd; const bf16* Kp = Kd + pbase; const bf16* Vp = Vd + pbase; const bf16* Qp = Qd + pbase; \
        _Pragma("unroll") for (int j = 0; j < 8; ++j) { const int id = tl + 256 * j, row = id >> 3, ch = id & 7; int kr = q0 - 64 + row; kr = kr < 0 ? 0 : (kr > L - 1 ? L - 1 : kr); \
            kreg[j] = *(const u32x4*)(Kp + (size_t)kr * 64 + ch * 8); vreg[j] = *(const u32x4*)(Vp + (size_t)kr * 64 + ch * 8); } \
        _Pragma("unroll") for (int ks = 0; ks < 4; ++ks) qn[ks] = *(const bf16x8*)(Qp + (size_t)(q0 + 32 * w + ql) * 64 + 16 * ks + 8 * h); } while (0)
    u32x4 kreg[8], vreg[8]; bf16x8 qn[4];
    if (vcu < 1536) ATT_LOAD(vcu);
    for (int pi = vcu; pi < 1536; pi += G) {
        ATT_UNIT(pi)
        __syncthreads();
        int hh = h, qll = ql; asm volatile("" : "+v"(hh), "+v"(qll));
#pragma unroll
        for (int j = 0; j < 8; ++j) { const int id = tl + 256 * j, row = id >> 3, ch = id & 7; *(LAS u32x4*)(Ks + row * KROW + ch * 16) = kreg[j]; *(LAS u32x4*)(Vs + row * KROW + ch * 16) = vreg[j]; }
        bf16x8 qf[4];
#pragma unroll
        for (int ks = 0; ks < 4; ++ks) qf[ks] = qn[ks];
        __syncthreads();
        if (pi + G < 1536) ATT_LOAD(pi + G);
        const float slope2 = exp2f(-8.f * (float)(hd + 1) / 12.f) * (float)(1 << sh) * 1.4426950408889634f;
        const int nb = qll - 4 * hh;
        const float sbp = -slope2 * (float)nb;
        bool tv[5];
#pragma unroll
        for (int kt = 0; kt < 5; ++kt) { const int klo = q0 + 32 * w + 32 * kt - 64; tv[kt] = (klo >= 0) && (klo + 32 <= L); }
        f32x16 sT[5]; float mx = -1e30f;
#pragma unroll
        for (int kt = 0; kt < 5; ++kt) {
            if (tv[kt]) {
                const float c0 = kt < 2 ? sbp : (kt == 2 ? 0.f : -sbp);
                f32x16 acc;
#pragma unroll
                for (int rr = 0; rr < 16; ++rr) acc[rr] = c0;
#pragma unroll
                for (int ks = 0; ks < 4; ++ks) { const bf16x8 af = *(LAS const bf16x8*)(Ks + (32 * w + 32 * kt + ql) * KROW + ks * 32 + h * 16);
                    acc = __builtin_amdgcn_mfma_f32_32x32x16_bf16(af, qf[ks], acc, 0, 0, 0); }
#pragma unroll
                for (int rr = 0; rr < 16; ++rr) { const int c = (rr & 3) + 8 * (rr >> 2); float sv = acc[rr];
                    if (kt < 2) sv = fmaf(slope2, (float)(32 * kt - 64 + c), sv);
                    else if (kt > 2) sv = fmaf(-slope2, (float)(32 * kt - 64 + c), sv);
                    else sv = fmaf(-slope2, fabsf((float)c - (float)nb), sv);
                    if (kt == 0) sv = (c >= nb) ? sv : -1e30f;
                    if (kt == 4) sv = (c <= nb) ? sv : -1e30f;
                    acc[rr] = sv; mx = fmaxf(mx, sv); }
                sT[kt] = acc; } }
        { const auto rr_ = __builtin_amdgcn_permlane32_swap(__builtin_bit_cast(unsigned, mx), __builtin_bit_cast(unsigned, mx), false, false); mx = fmaxf(__builtin_bit_cast(float, (unsigned)rr_[0]), __builtin_bit_cast(float, (unsigned)rr_[1])); }
        float den = 0.f;
#pragma unroll
        for (int kt = 0; kt < 5; ++kt)
            if (tv[kt]) {
#pragma unroll
                for (int rr = 0; rr < 16; ++rr) { const float p = __builtin_amdgcn_exp2f(sT[kt][rr] - mx); sT[kt][rr] = p; den += p; } }
        { const auto rr_ = __builtin_amdgcn_permlane32_swap(__builtin_bit_cast(unsigned, den), __builtin_bit_cast(unsigned, den), false, false); den = __builtin_bit_cast(float, (unsigned)rr_[0]) + __builtin_bit_cast(float, (unsigned)rr_[1]); }
        f32x16 o[2]; o[0] = f32x16{}; o[1] = f32x16{};
        const int g4 = lane >> 4, i16 = lane & 15, qq = i16 >> 2, pp = i16 & 3;
        LAS const unsigned char* vb = Vs + (32 * w + 4 * h + qq) * KROW + (16 * (g4 & 1) + 4 * pp) * 2;
#pragma unroll
        for (int s2 = 0; s2 < 10; ++s2) { const int kt = s2 >> 1, rb = 8 * (s2 & 1);
            if (tv[kt]) {
            u32x4 pw; pw.x = cvtpk(sT[kt][rb + 0], sT[kt][rb + 1]); pw.y = cvtpk(sT[kt][rb + 2], sT[kt][rb + 3]); pw.z = cvtpk(sT[kt][rb + 4], sT[kt][rb + 5]); pw.w = cvtpk(sT[kt][rb + 6], sT[kt][rb + 7]);
            const bf16x8 pf = __builtin_bit_cast(bf16x8, pw);
#pragma unroll
            for (int ct = 0; ct < 2; ++ct) { const s16x4 lo = vtr(vb + (16 * s2) * KROW + ct * 64), hi4 = vtr(vb + (16 * s2 + 8) * KROW + ct * 64);
                const bf16x8 af = (bf16x8){lo[0], lo[1], lo[2], lo[3], hi4[0], hi4[1], hi4[2], hi4[3]};
                o[ct] = __builtin_amdgcn_mfma_f32_32x32x16_bf16(af, pf, o[ct], 0, 0, 0); } } }
        const float inv = 1.f / den;
        __syncthreads();
        LAS unsigned char* ost = Ks + w * (32 * KROW);
#pragma unroll
        for (int ct = 0; ct < 2; ++ct)
#pragma unroll
            for (int a4 = 0; a4 < 4; ++a4) { u32x2 wv2; wv2.x = cvtpk(o[ct][4 * a4] * inv, o[ct][4 * a4 + 1] * inv); wv2.y = cvtpk(o[ct][4 * a4 + 2] * inv, o[ct][4 * a4 + 3] * inv);
                *(LAS u32x2*)(ost + ql * KROW + (32 * ct + 8 * a4 + 4 * h) * 2) = wv2; }
        {   const int pos = ((q0 + 32 * w + ql) << sh) + r; const size_t t = (size_t)b * 2048 + pos;
            if (h == 0) LSE[t * 12 + hd] = 0.6931471805599453f * (mx + __builtin_amdgcn_logf(den)); }
        asm volatile("s_waitcnt lgkmcnt(0)" ::: "memory");
#pragma unroll
        for (int i = 0; i < 4; ++i) { const int qr = 8 * i + (lane >> 3), ch = lane & 7;
            const u32x4 v = *(LAS const u32x4*)(ost + qr * KROW + ch * 16);
            const size_t t = (size_t)b * 2048 + (((q0 + 32 * w + qr) << sh) + r);
            *(u32x4*)(ORAW + t * 768 + hd * 64 + ch * 8) = v; }
    }
    __syncthreads();
#undef ATT_UNIT
#undef ATT_LOAD
}
}
namespace mixp {
typedef short bf16x8 __attribute__((ext_vector_type(8)));
typedef unsigned u32x4 __attribute__((ext_vector_type(4)));
__device__ __forceinline__ void unpack8(const u32x4 v, float (&f)[8]) {
#pragma unroll
    for (int i = 0; i < 4; ++i) { f[2 * i] = __builtin_bit_cast(float, v[i] << 16); f[2 * i + 1] = __builtin_bit_cast(float, v[i] & 0xffff0000u); }
}
__device__ __forceinline__ void mix_phase(const Args& a, LAS unsigned char* lds, int gw, int NGW, int wave, int lane) {
    unsigned char* ws = a.ws;
    LAS float* al = (LAS float*)(lds + wave * 1024);
    constexpr int PROW = 528;
    LAS unsigned char* pst = lds + 8192 + wave * (32 * PROW);
    const bf16* P = (const bf16*)(ws + WS_P); const bf16* ORAW = (const bf16*)(ws + WS_ORAW); const float* LSE = (const float*)(ws + WS_LSE);
    bf16* MIXIN = (bf16*)(ws + WS_MIXIN); const bf16* WpT = (const bf16*)(ws + WS_WPT); const float* pool_scale = a.in[4];
    for (int u = gw; u < M / 16; u += NGW) {
        const int t0 = 16 * u;
#pragma unroll
        for (int j = 0; j < 3; ++j) { const int id = lane + 64 * j, tk = id / 12, hd = id % 12, s = hd & 3, g = hd >> 2;
            const float* lp = LSE + (size_t)(t0 + tk) * 12 + s; const float l0 = lp[0], l1 = lp[4], l2 = lp[8];
            const float mx = fmaxf(l0, fmaxf(l1, l2)); const float e0 = __expf(l0 - mx), e1 = __expf(l1 - mx), e2 = __expf(l2 - mx);
            al[id] = (g == 0 ? e0 : (g == 1 ? e1 : e2)) / (e0 + e1 + e2); }
        asm volatile("s_waitcnt lgkmcnt(0)" ::: "memory");
#pragma unroll 12
        for (int it = 0; it < 24; ++it) { const int id = lane + 64 * it, tk = id / 96, ch = id % 96, hd = ch >> 3;
            const u32x4 v = *(const u32x4*)(ORAW + (size_t)(t0 + tk) * 768 + ch * 8); const float alpha = al[tk * 12 + hd];
            float f[8]; unpack8(v, f); u32x4 o;
#pragma unroll
            for (int i = 0; i < 4; ++i) o[i] = pk2(f[2 * i] * alpha, f[2 * i + 1] * alpha);
            *(u32x4*)(MIXIN + (size_t)(t0 + tk) * D + 256 + ch * 8) = o; }
        asm volatile("s_waitcnt lgkmcnt(0)" ::: "memory");
        const int ti = lane & 15, kq = lane >> 4, pos = (t0 + ti) & 2047, b0 = t0 - (t0 & 2047);
#pragma unroll
        for (int j = 0; j < 16; ++j) { const int rr = 2 * j + (lane >> 5), ch = lane & 31; int tr = t0 - 8 + rr; tr = tr < b0 ? b0 : (tr > b0 + 2047 ? b0 + 2047 : tr);
            const u32x4 v = *(const u32x4*)(P + (size_t)tr * 256 + ch * 8); *(LAS u32x4*)(pst + rr * PROW + ch * 16) = v; }
        asm volatile("s_waitcnt lgkmcnt(0)" ::: "memory");
        f32x4 acc[4][4];
#pragma unroll
        for (int gi = 0; gi < 4; ++gi) { const int hw = 1 << gi;
#pragma unroll
            for (int dt = 0; dt < 4; ++dt) acc[gi][dt] = (f32x4){0.f, 0.f, 0.f, 0.f};
#pragma unroll
            for (int kk = 0; kk < 2; ++kk) { const int cg = 64 * gi + 32 * kk + 8 * kq;
                float sum[8]; int cnt = 0;
#pragma unroll
                for (int i = 0; i < 8; ++i) sum[i] = 0.f;
#pragma unroll
                for (int dj = -hw; dj < hw; ++dj) { const int p2 = pos + dj; const bool ok = (p2 >= 0) && (p2 < 2048);
                    const u32x4 v = *(LAS const u32x4*)(pst + (ti + 8 + dj) * PROW + cg * 2); float f[8]; unpack8(v, f);
                    if (ok) {
#pragma unroll
                        for (int i = 0; i < 8; ++i) sum[i] += f[i];
                        ++cnt; } }
                const u32x4 ov = *(LAS const u32x4*)(pst + (ti + 8) * PROW + cg * 2); float own[8]; unpack8(ov, own);
                const float rc = 1.f / (float)cnt; u32x4 aw;
#pragma unroll
                for (int i = 0; i < 4; ++i) aw[i] = pk2(sum[2 * i] * rc - own[2 * i], sum[2 * i + 1] * rc - own[2 * i + 1]);
                const bf16x8 af = __builtin_bit_cast(bf16x8, aw);
#pragma unroll
                for (int dt = 0; dt < 4; ++dt) { const bf16x8 bfr = *(const bf16x8*)(WpT + gi * 4096 + (16 * dt + ti) * 64 + 32 * kk + 8 * kq);
                    acc[gi][dt] = __builtin_amdgcn_mfma_f32_16x16x32_bf16(af, bfr, acc[gi][dt], 0, 0, 0); } } }
        asm volatile("s_waitcnt lgkmcnt(0)" ::: "memory");
#pragma unroll
        for (int gi = 0; gi < 4; ++gi)
#pragma unroll
            for (int dt = 0; dt < 4; ++dt) { const int d = 64 * gi + 16 * dt + ti; const float sc = pool_scale[d];
#pragma unroll
                for (int rg = 0; rg < 4; ++rg) { const float fv = acc[gi][dt][rg]; *(LAS unsigned short*)(pst + (4 * kq + rg) * PROW + d * 2) = (unsigned short)f2bf(fv * sc); } }
        asm volatile("s_waitcnt lgkmcnt(0)" ::: "memory");
#pragma unroll
        for (int j = 0; j < 8; ++j) { const int rr = 2 * j + (lane >> 5), ch = lane & 31;
            const u32x4 v = *(LAS const u32x4*)(pst + rr * PROW + ch * 16); *(u32x4*)(MIXIN + (size_t)(t0 + rr) * D + ch * 8) = v; }
        asm volatile("s_waitcnt lgkmcnt(0)" ::: "memory");
    }
}
}
namespace peer {
typedef unsigned u32x4 __attribute__((ext_vector_type(4)));
typedef unsigned u32x2 __attribute__((ext_vector_type(2)));
typedef int i32x4 __attribute__((ext_vector_type(4)));
constexpr int TOK_PER_BLK = 128, TOK_PER_WAVE = 16;
constexpr int L_SRT = 0, L_IDX = 0, L_ZW = 65536, L_XS = 65536, L_TOK = 131072, L_SS = 132096, L_TMP = 136192;
constexpr size_t SLICE_BYTES = (size_t)NEXP * 128;
__device__ __forceinline__ float gelu_erf(float v) { return 0.5f * v * (1.f + erff(v * 0.70710678118654752f)); }
__device__ __forceinline__ int lane_xor1(int v) { return __builtin_amdgcn_mov_dpp(v, 0xB1, 0xF, 0xF, true); }
__device__ __forceinline__ int lane_xor2(int v) { return __builtin_amdgcn_mov_dpp(v, 0x4E, 0xF, 0xF, true); }
__device__ __forceinline__ int lane_hmirror(int v) { return __builtin_amdgcn_mov_dpp(v, 0x141, 0xF, 0xF, true); }
__device__ __forceinline__ float bf_lo(unsigned w) { return __builtin_bit_cast(float, w << 16); }
__device__ __forceinline__ float bf_hi(unsigned w) { return __builtin_bit_cast(float, w & 0xffff0000u); }

__device__ __forceinline__ void gather_phase(const Args& a, LAS unsigned char* lds, int vcu, int G, int wave, int lane) {
    unsigned char* ws = a.ws; float* out = a.out;
    const unsigned char* U8 = ws + WS_U8; const unsigned char* V8 = ws + WS_V8;
    const float* SU = (const float*)(ws + WS_SU); const float* SV = (const float*)(ws + WS_SV);
    const unsigned short* IDX = (const unsigned short*)(ws + WS_IDX); const float* GATE = (const float*)(ws + WS_GATE);
    unsigned char* X8 = ws + WS_X8; const float* g_final = a.in[11];
    bf16* X2B = (bf16*)(ws + WS_XN);
    for (int tb = vcu; tb < M / TOK_PER_BLK; tb += G) {
        __syncthreads();
        const int T0 = tb * TOK_PER_BLK + wave * TOK_PER_WAVE, tl0 = wave * TOK_PER_WAVE;
        LAS unsigned short* idxl = (LAS unsigned short*)(lds + L_IDX) + tl0 * 128;
        LAS int* zw = (LAS int*)(lds + L_ZW) + tl0 * 128;
        LAS float* tokf = (LAS float*)(lds + L_TOK) + tl0 * 2;
        LAS float* ssl = (LAS float*)(lds + L_SS) + tl0 * 8;
        for (int tk4 = 0; tk4 < TOK_PER_WAVE; tk4 += 4) {
          u32x4 xbA[4], xbB[4];
#pragma unroll
          for (int u = 0; u < 4; ++u) { const int t = T0 + tk4 + u; xbA[u] = *(const u32x4*)(X2B + (size_t)t * D + 16 * lane); xbB[u] = *(const u32x4*)(X2B + (size_t)t * D + 16 * lane + 8); }
#pragma unroll
          for (int u = 0; u < 4; ++u) { const int tk = tk4 + u, t = T0 + tk;
            f32x4 x2[4]; float ss = 0.f, amax = 0.f;
            const u32x4 xb0 = xbA[u], xb1 = xbB[u];
#pragma unroll
            for (int j = 0; j < 4; ++j) { const unsigned w0 = (j < 2 ? xb0 : xb1)[2 * (j & 1)], w1 = (j < 2 ? xb0 : xb1)[2 * (j & 1) + 1];
                x2[j] = (f32x4){bf_lo(w0), bf_hi(w0), bf_lo(w1), bf_hi(w1)};
                ss += (x2[j].x * x2[j].x + x2[j].y * x2[j].y) + (x2[j].z * x2[j].z + x2[j].w * x2[j].w);
                amax = fmaxf(amax, fmaxf(fmaxf(fabsf(x2[j].x), fabsf(x2[j].y)), fmaxf(fabsf(x2[j].z), fabsf(x2[j].w)))); }
            ss = wave_sum(ss); amax = wave_max(amax);
            const float rstd = rsqrtf(ss * (1.f / D) + 1e-6f), inv = amax > 0.f ? 127.f / amax : 0.f, sx = amax * (1.f / 127.f);
            u32x4 xq;
#pragma unroll
            for (int j = 0; j < 4; ++j) { const int q0 = (int)rintf(x2[j].x * inv), q1 = (int)rintf(x2[j].y * inv), q2 = (int)rintf(x2[j].z * inv), q3 = (int)rintf(x2[j].w * inv);
                xq[j] = (unsigned)(q0 & 0xff) | ((unsigned)(q1 & 0xff) << 8) | ((unsigned)(q2 & 0xff) << 16) | ((unsigned)q3 << 24); }
            *(u32x4*)(X8 + (size_t)t * D + 16 * lane) = xq;
            if (lane < 8) ssl[tk * 8 + lane] = 0.f;
            if (lane == 0) { tokf[tk * 2] = sx * rstd; tokf[tk * 2 + 1] = 0.f; } } }
        asm volatile("s_waitcnt vmcnt(0) lgkmcnt(0)" ::: "memory");
        const int tid = wave * 64 + lane;
        const unsigned rot = (unsigned)(vcu & 31) * 64u + (unsigned)(vcu >> 5) * 8u;
        LAS unsigned* cnt = (LAS unsigned*)(lds + L_ZW);
        LAS unsigned* srt = (LAS unsigned*)(lds + L_SRT);
        const unsigned short* IDXb = IDX + (size_t)tb * TOK_PER_BLK * 128;
        const unsigned char* X8b = X8 + (size_t)tb * TOK_PER_BLK * D;
        {   u32x4 iv[4];
#pragma unroll
            for (int j = 0; j < 4; ++j) iv[j] = *(const u32x4*)(IDXb + 32 * tid + 8 * j);
#pragma unroll
            for (int j = 0; j < 4; ++j) *(LAS u32x4*)(lds + L_ZW + 8192 * j + 16 * tid) = (u32x4){0u, 0u, 0u, 0u};
            __syncthreads();
            unsigned er[32];
#pragma unroll
            for (int j = 0; j < 32; ++j) { const unsigned w_ = iv[j >> 3][(j >> 1) & 3]; const unsigned e = (j & 1) ? (w_ >> 16) : (w_ & 0xffffu); const unsigned ek = (e + rot) & 0x3fffu, sh = (ek & 1u) << 4;
                const unsigned old = __hip_atomic_fetch_add(cnt + (ek >> 1), 1u << sh, __ATOMIC_RELAXED, __HIP_MEMORY_SCOPE_WORKGROUP);
                er[j] = e | (((old >> sh) & 0xffffu) << 14); }
            __syncthreads();
            u32x4 cw[4]; unsigned tot = 0;
#pragma unroll
            for (int j = 0; j < 4; ++j) { cw[j] = *(LAS const u32x4*)(lds + L_ZW + 64 * tid + 16 * j);
#pragma unroll
                for (int i = 0; i < 4; ++i) tot += (cw[j][i] & 0xffffu) + (cw[j][i] >> 16); }
            unsigned inc = tot;
#pragma unroll
            for (int d = 1; d < 64; d <<= 1) { const unsigned t_ = (unsigned)__shfl_up((int)inc, d, 64); if (lane >= d) inc += t_; }
            LAS unsigned* tmp = (LAS unsigned*)(lds + L_TMP);
            if (lane == 63) tmp[wave] = inc;
            __syncthreads();
            unsigned run = inc - tot;
#pragma unroll
            for (int w_ = 0; w_ < 8; ++w_) { const unsigned t_ = tmp[w_]; if (w_ < wave) run += t_; }
#pragma unroll
            for (int j = 0; j < 4; ++j) {
#pragma unroll
                for (int i = 0; i < 4; ++i) { const unsigned w_ = cw[j][i]; const unsigned lo_ = run; run += w_ & 0xffffu; const unsigned hi_ = run; run += w_ >> 16; cw[j][i] = lo_ | (hi_ << 16); }
                *(LAS u32x4*)(lds + L_ZW + 64 * tid + 16 * j) = cw[j]; }
            __syncthreads();
#pragma unroll
            for (int j = 0; j < 32; ++j) { const unsigned e = er[j] & 0x3fffu, rank = er[j] >> 14, ek = (e + rot) & 0x3fffu; const unsigned w_ = cnt[ek >> 1]; const unsigned off = (w_ >> ((ek & 1u) << 4)) & 0xffffu;
                srt[off + rank] = (e << 14) | (unsigned)(32 * tid + j); }
            __syncthreads();
        }
        { const int g = lane >> 3, i8 = lane & 7;
#define PEER_ULOAD(buf, s, vp) do { const unsigned char* Us_ = U8 + (size_t)(s) * SLICE_BYTES; const u32x4 ea_ = *(LAS const u32x4*)(srt_g + (vp) * 256), eb_ = *(LAS const u32x4*)(srt_g + (vp) * 256 + 16); \
            _Pragma("unroll") for (int it = 0; it < 8; ++it) { const unsigned en_ = it < 4 ? ea_[it] : eb_[it - 4]; buf[it] = *(const u32x4*)(Us_ + (((en_ >> 7) & 0x1fff80u) | lo16u)); } } while (0)
#define PEER_UCOMP(buf, s, vp) do { const u32x4 ea_ = *(LAS const u32x4*)(srt_g + (vp) * 256), eb_ = *(LAS const u32x4*)(srt_g + (vp) * 256 + 16); \
            LAS const unsigned char* xs_ = lds + L_XS + ((s) & 1) * 16384 + lo16u; int d_[8], a_[4], b_[2]; \
            _Pragma("unroll") for (int it = 0; it < 8; ++it) { const unsigned en_ = it < 4 ? ea_[it] : eb_[it - 4]; const u32x4 xv = *(LAS const u32x4*)(xs_ + (en_ & 0x3f80u)); \
                int d = __builtin_amdgcn_sdot4((int)buf[it].x, (int)xv.x, 0, false); d = __builtin_amdgcn_sdot4((int)buf[it].y, (int)xv.y, d, false); \
                d = __builtin_amdgcn_sdot4((int)buf[it].z, (int)xv.z, d, false); d_[it] = __builtin_amdgcn_sdot4((int)buf[it].w, (int)xv.w, d, false); } \
              \
              \
            _Pragma("unroll") for (int p = 0; p < 4; ++p) { const int keep = q2 ? d_[4 + p] : d_[p], send = q2 ? d_[p] : d_[4 + p]; a_[p] = keep + lane_hmirror(send); } \
            _Pragma("unroll") for (int p = 0; p < 2; ++p) { const int keep = q0 ? a_[2 * p + 1] : a_[2 * p], send = q0 ? a_[2 * p] : a_[2 * p + 1]; b_[p] = keep + lane_xor1(send); } \
            { const int keep = q1 ? b_[1] : b_[0], send = q1 ? b_[0] : b_[1]; zreg[vp] += keep + lane_xor2(send); } } while (0)
        {   const bool q0 = lane & 1, q1 = lane & 2, q2 = lane & 4; const unsigned lo16u = (unsigned)i8 << 4;
            LAS const unsigned char* srt_g = lds + L_SRT + (wave * 2048 + 8 * g) * 4;
            const unsigned char* xsrc = X8b + (size_t)(tid >> 2) * D + 32 * (tid & 3);
            LAS unsigned char* xdst = lds + L_XS + (tid >> 2) * 128 + 32 * (tid & 3);
            u32x4 xsa = *(const u32x4*)xsrc, xsb = *(const u32x4*)(xsrc + 16);
            *(LAS u32x4*)xdst = xsa; *(LAS u32x4*)(xdst + 16) = xsb;
            int zreg[32];
#pragma unroll
            for (int vp = 0; vp < 32; ++vp) zreg[vp] = 0;
            u32x4 u0[8], u1[8];
            PEER_ULOAD(u0, 0, 0);
            asm volatile("s_waitcnt lgkmcnt(0)\n\ts_barrier" ::: "memory");
            for (int s = 0; s < 8; ++s) {
                const int sn = s + 1 < 8 ? s + 1 : 7;
                xsa = *(const u32x4*)(xsrc + 128 * sn); xsb = *(const u32x4*)(xsrc + 128 * sn + 16);
#pragma unroll
                for (int vp = 0; vp < 32; vp += 2) {
                    PEER_ULOAD(u1, s, vp + 1); PEER_UCOMP(u0, s, vp);
                    if (vp + 2 < 32) PEER_ULOAD(u0, s, vp + 2); else PEER_ULOAD(u0, sn, 0);
                    PEER_UCOMP(u1, s, vp + 1);
                }
                *(LAS u32x4*)(xdst + ((s + 1) & 1) * 16384) = xsa; *(LAS u32x4*)(xdst + ((s + 1) & 1) * 16384 + 16) = xsb;
                asm volatile("s_waitcnt lgkmcnt(0)\n\ts_barrier" ::: "memory");
            }
#pragma unroll
            for (int vp = 0; vp < 32; ++vp) { const unsigned en = *(LAS const unsigned*)(lds + L_SRT + (wave * 2048 + 64 * vp + lane) * 4); ((LAS int*)(lds + L_ZW))[en & 0x3fffu] = zreg[vp]; }
            asm volatile("s_waitcnt lgkmcnt(0)\n\ts_barrier" ::: "memory");
            {   u32x4 iv[4];
#pragma unroll
                for (int j = 0; j < 4; ++j) iv[j] = *(const u32x4*)(IDXb + (size_t)tl0 * 128 + 32 * lane + 8 * j);
#pragma unroll
                for (int j = 0; j < 4; ++j) *(LAS u32x4*)((LAS unsigned char*)idxl + 64 * lane + 16 * j) = iv[j]; }
        }
#undef PEER_ULOAD
#undef PEER_UCOMP
        }
        asm volatile("s_waitcnt lgkmcnt(0)" ::: "memory");
        for (int tk = 0; tk < TOK_PER_WAVE; ++tk) { const int t = T0 + tk; const float cs = tokf[tk * 2];
            float w[2];
#pragma unroll
            for (int hf = 0; hf < 2; ++hf) { const int k = lane + 64 * hf; const unsigned e = idxl[tk * 128 + k];
                const float z = (float)zw[tk * 128 + k] * (SU[e] * cs);
                w[hf] = GATE[(size_t)t * 128 + k] * gelu_erf(z) * SV[e]; }
            const float wm = wave_max(fmaxf(fabsf(w[0]), fabsf(w[1]))), winv = wm > 0.f ? 127.f / wm : 0.f;
            asm volatile("s_waitcnt lgkmcnt(0)" ::: "memory");
            LAS signed char* wpb = (LAS signed char*)(zw + tk * 128);
            wpb[lane] = (signed char)(int)rintf(w[0] * winv); wpb[64 + lane] = (signed char)(int)rintf(w[1] * winv);
            if (lane == 0) tokf[tk * 2 + 1] = wm * (1.f / 127.f); }
        asm volatile("s_waitcnt lgkmcnt(0)" ::: "memory");
        {   const int g = lane >> 3, i8 = lane & 7; const unsigned lo16 = (unsigned)i8 << 4;
#define PEER_DLOAD(QB, WP, qi) do { const int s_ = (qi) >> 6, tok_ = 8 * (((qi) >> 5) & 1) + g, q_ = (qi) & 31; \
            const u32x2 id_ = *(LAS const u32x2*)(idxl + tok_ * 128 + 4 * q_); WP = zw[tok_ * 128 + q_]; const unsigned char* Vs_ = V8 + (size_t)s_ * SLICE_BYTES; \
            QB[0] = *(const u32x4*)(Vs_ + (((id_.x << 7) & 0x7fff80u) | lo16)); QB[1] = *(const u32x4*)(Vs_ + (((id_.x >> 9) & 0x7fff80u) | lo16)); \
            QB[2] = *(const u32x4*)(Vs_ + (((id_.y << 7) & 0x7fff80u) | lo16)); QB[3] = *(const u32x4*)(Vs_ + (((id_.y >> 9) & 0x7fff80u) | lo16)); } while (0)
#define PEER_DACC(QB, WP) do { \
            _Pragma("unroll") for (int j = 0; j < 4; ++j) { const unsigned A_ = QB[0][j], B_ = QB[1][j], C_ = QB[2][j], D_ = QB[3][j]; \
                const unsigned t0 = __builtin_amdgcn_perm(B_, A_, 0x05010400u), t1 = __builtin_amdgcn_perm(B_, A_, 0x07030602u); \
                const unsigned u0 = __builtin_amdgcn_perm(D_, C_, 0x05010400u), u1 = __builtin_amdgcn_perm(D_, C_, 0x07030602u); \
                acc[4 * j + 0] = __builtin_amdgcn_sdot4((int)__builtin_amdgcn_perm(u0, t0, 0x05040100u), WP, acc[4 * j + 0], false); \
                acc[4 * j + 1] = __builtin_amdgcn_sdot4((int)__builtin_amdgcn_perm(u0, t0, 0x07060302u), WP, acc[4 * j + 1], false); \
                acc[4 * j + 2] = __builtin_amdgcn_sdot4((int)__builtin_amdgcn_perm(u1, t1, 0x05040100u), WP, acc[4 * j + 2], false); \
                acc[4 * j + 3] = __builtin_amdgcn_sdot4((int)__builtin_amdgcn_perm(u1, t1, 0x07060302u), WP, acc[4 * j + 3], false); } } while (0)
#define PEER_DX2(qi) do { const int s_ = (qi) >> 6, tok_ = 8 * (((qi) >> 5) & 1) + g; const bf16* xp_ = X2B + (size_t)(T0 + tok_) * D + 128 * s_ + 16 * i8; \
            x2a = *(const u32x4*)xp_; x2b = *(const u32x4*)(xp_ + 8); } while (0)
#define PEER_DFIN(qi) do { const int s_ = (qi) >> 6, tok_ = 8 * (((qi) >> 5) & 1) + g; const float wsc = tokf[tok_ * 2 + 1]; float ssq = 0.f; u32x4 oa, ob; \
            _Pragma("unroll") for (int j = 0; j < 4; ++j) { const unsigned w_ = x2a[j]; const float f0 = bf_lo(w_) + (float)acc[2 * j] * wsc, f1 = bf_hi(w_) + (float)acc[2 * j + 1] * wsc; ssq += f0 * f0 + f1 * f1; oa[j] = pk2(f0, f1); } \
            _Pragma("unroll") for (int j = 0; j < 4; ++j) { const unsigned w_ = x2b[j]; const float f0 = bf_lo(w_) + (float)acc[8 + 2 * j] * wsc, f1 = bf_hi(w_) + (float)acc[8 + 2 * j + 1] * wsc; ssq += f0 * f0 + f1 * f1; ob[j] = pk2(f0, f1); } \
            bf16* xp_ = X2B + (size_t)(T0 + tok_) * D + 128 * s_ + 16 * i8; *(u32x4*)xp_ = oa; *(u32x4*)(xp_ + 8) = ob; \
            __hip_atomic_fetch_add(ssl + tok_ * 8 + i8, ssq, __ATOMIC_RELAXED, __HIP_MEMORY_SCOPE_WORKGROUP); } while (0)
            u32x4 q0[4], q1[4], q2[4], q3[4], q4[4], q5[4], q6[4], q7[4], x2a, x2b; int w0, w1, w2, w3, w4, w5, w6, w7, acc[16];
            PEER_DLOAD(q0, w0, 0); PEER_DLOAD(q1, w1, 1); PEER_DLOAD(q2, w2, 2); PEER_DLOAD(q3, w3, 3); PEER_DLOAD(q4, w4, 4); PEER_DLOAD(q5, w5, 5); PEER_DLOAD(q6, w6, 6);
            for (int i = 0; i < 512 / 8 - 1; ++i) {
                const int qi = 8 * i;
                if ((i & 3) == 0) {
#pragma unroll
                    for (int c = 0; c < 16; ++c) acc[c] = 0; }
                if ((i & 3) == 3) PEER_DX2(qi);
                PEER_DLOAD(q7, w7, qi + 7); PEER_DACC(q0, w0); PEER_DLOAD(q0, w0, qi + 8); PEER_DACC(q1, w1); PEER_DLOAD(q1, w1, qi + 9); PEER_DACC(q2, w2); PEER_DLOAD(q2, w2, qi + 10); PEER_DACC(q3, w3); PEER_DLOAD(q3, w3, qi + 11); PEER_DACC(q4, w4); PEER_DLOAD(q4, w4, qi + 12); PEER_DACC(q5, w5); PEER_DLOAD(q5, w5, qi + 13); PEER_DACC(q6, w6); PEER_DLOAD(q6, w6, qi + 14); PEER_DACC(q7, w7);
                if ((i & 3) == 3) PEER_DFIN(qi);
            }
            PEER_DX2(504); PEER_DLOAD(q7, w7, 511); PEER_DACC(q0, w0); PEER_DACC(q1, w1); PEER_DACC(q2, w2); PEER_DACC(q3, w3); PEER_DACC(q4, w4); PEER_DACC(q5, w5); PEER_DACC(q6, w6); PEER_DACC(q7, w7); PEER_DFIN(504);
#undef PEER_DLOAD
#undef PEER_DACC
#undef PEER_DX2
#undef PEER_DFIN
#undef PEER_DSTEP
        }
        asm volatile("s_waitcnt vmcnt(0) lgkmcnt(0)" ::: "memory");
        {   f32x4 gg[4];
#pragma unroll
            for (int j = 0; j < 4; ++j) gg[j] = ((const f32x4*)g_final)[lane + 64 * j];
            for (int tk4 = 0; tk4 < TOK_PER_WAVE; tk4 += 4) { u32x2 xb[4][4];
#pragma unroll
                for (int u = 0; u < 4; ++u)
#pragma unroll
                    for (int j = 0; j < 4; ++j) xb[u][j] = *(const u32x2*)(X2B + (size_t)(T0 + tk4 + u) * D + 4 * (lane + 64 * j));
#pragma unroll
                for (int u = 0; u < 4; ++u) { const int tk = tk4 + u, t = T0 + tk;
                    float sq = ssl[tk * 8 + (lane & 7)]; sq += dpp_mov<0xB1>(sq); sq += dpp_mov<0x4E>(sq); sq += dpp_mov<0x141>(sq);
                    const float r3 = rsqrtf(sq * (1.f / D) + 1e-6f);
#pragma unroll
                    for (int j = 0; j < 4; ++j) { const u32x2 w_ = xb[u][j]; const f32x4 x3 = (f32x4){bf_lo(w_.x), bf_hi(w_.x), bf_lo(w_.y), bf_hi(w_.y)};
                        *((f32x4*)(out + (size_t)t * D) + lane + 64 * j) = x3 * gg[j] * r3; } } } }
    }
}
}
namespace topk {
typedef short bf16x8 __attribute__((ext_vector_type(8)));
typedef float f32x16 __attribute__((ext_vector_type(16)));
typedef unsigned u32x4 __attribute__((ext_vector_type(4)));
constexpr int SKROW = 272;
__device__ __forceinline__ float fmax_(float a, float b) { float t; asm("v_max_f32 %0, %1, %2" : "=v"(t) : "v"(a), "v"(b)); return t; }
__device__ __forceinline__ void cswap(float& a, float& b) { float t, u; asm("v_max_f32 %0, %1, %2" : "=v"(t) : "v"(a), "v"(b)); asm("v_min_f32 %0, %1, %2" : "=v"(u) : "v"(a), "v"(b)); a = t; b = u; }
__device__ __forceinline__ void merge16(float (&c)[16]) {
#pragma unroll
    for (int j = 8; j > 0; j >>= 1)
#pragma unroll
        for (int i = 0; i < 16; ++i) { const int l = i ^ j; if (l > i) cswap(c[i], c[l]); }
}
__device__ __forceinline__ void sort16(float (&v)[16]) {
    constexpr int SA[60] = {0,1,2,3,4,5,7,9, 0,1,2,3,6,8,10,11, 0,2,4,6,7,10,12,14, 0,1,4,5,6,8,12,13, 1,3,4,5,8,9,13, 1,2,5,7,9,11, 2,3,9,11, 3,6,7,10, 3,5,7,9,11, 6,8};
    constexpr int SB[60] = {13,12,15,14,8,6,11,10, 5,7,9,4,13,14,15,12, 1,3,5,8,9,11,13,15, 2,3,10,11,7,9,14,15, 2,12,6,7,10,11,14, 4,6,8,10,13,14, 4,6,12,13, 5,8,9,12, 4,6,8,10,12, 7,9};
#pragma unroll
    for (int i = 0; i < 60; ++i) cswap(v[SA[i]], v[SB[i]]);
}
__device__ __forceinline__ void topmerge(float (&a)[16], const float (&b)[16]) {
#pragma unroll
    for (int i = 0; i < 16; ++i) a[i] = fmax_(a[i], b[15 - i]);
    merge16(a);
}
__device__ __forceinline__ void insert16(float (&a)[16], float x) {
#pragma unroll
    for (int i = 0; i < 16; ++i) cswap(a[i], x);
}
__device__ __forceinline__ float cand(float a, float b, unsigned ca, unsigned cb) { return __builtin_bit_cast(float, (__builtin_bit_cast(unsigned, a + b) & ~0x3fffu) | ca | cb); }

__device__ __forceinline__ void qhalf_load(u32x4 (&q)[8], const bf16* QPw, int lane) {
#pragma unroll
    for (int j = 0; j < 8; ++j) q[j] = *(const u32x4*)(QPw + (size_t)(4 * j + (lane >> 4)) * NQ + (lane & 15) * 8);
}
__device__ __forceinline__ void qhalf_stage(const u32x4 (&q)[8], LAS unsigned char* qst, int lane) {
#pragma unroll
    for (int j = 0; j < 8; ++j) *(LAS u32x4*)(qst + (4 * j + (lane >> 4)) * SKROW + (lane & 15) * 16) = q[j];
}
__device__ __forceinline__ void half_top16(float (&e)[16], LAS const unsigned char* qst, LAS const unsigned char* sk, int ql, int hh) {
    unsigned qoff = (unsigned)(ql * SKROW + hh * 16);
    float m0[16], m1[16];
#pragma unroll
    for (int kt = 0; kt < 4; ++kt) { f32x16 acc = {}; float v[16];
        asm volatile("" : "+v"(qoff));
#pragma unroll
        for (int ks = 0; ks < 8; ++ks) { const bf16x8 af = *(LAS const bf16x8*)(sk + (32 * kt + ql) * SKROW + ks * 32 + hh * 16);
            const bf16x8 bfr = *(LAS const bf16x8*)(qst + qoff + ks * 32);
            acc = __builtin_amdgcn_mfma_f32_32x32x16_bf16(af, bfr, acc, 0, 0, 0); }
#pragma unroll
        for (int rr = 0; rr < 16; ++rr) { const unsigned key = (unsigned)(32 * kt + (rr & 3) + 8 * (rr >> 2)) + 4u * (unsigned)hh;
            const float fv = acc[rr];
            v[rr] = __builtin_bit_cast(float, (__builtin_bit_cast(unsigned, fv) & ~0x7fu) | key); }
        sort16(v);
        if (kt == 0) {
#pragma unroll
            for (int i = 0; i < 16; ++i) m0[i] = v[i]; }
        else if (kt == 1) topmerge(m0, v);
        else if (kt == 2) {
#pragma unroll
            for (int i = 0; i < 16; ++i) m1[i] = v[i]; }
        else topmerge(m1, v); }
    topmerge(m0, m1);
#pragma unroll
    for (int i = 0; i < 16; ++i) { const unsigned x = __builtin_bit_cast(unsigned, m0[15 - i]);
        const auto rr = __builtin_amdgcn_permlane32_swap(x, x, false, false);
        const unsigned lo_ = rr[0], hi_ = rr[1];
        e[i] = fmax_(m0[i], __builtin_bit_cast(float, hh ? lo_ : hi_)); }
    merge16(e);
}

__device__ __forceinline__ void topk_phase(const Args& a, LAS unsigned char* lds, int bx, int G, int tid) {
    unsigned char* ws = a.ws;
    const int lane = tid & 63, wave = __builtin_amdgcn_readfirstlane(tid >> 6);
    const bf16* QP = (const bf16*)(ws + WS_QP); const bf16* SK = (const bf16*)(ws + WS_SK);
    unsigned short* IDX = (unsigned short*)(ws + WS_IDX); float* GATE = (float*)(ws + WS_GATE);
    const float* pu = a.in[9]; const float* pv = a.in[10]; const float* g_ffn = a.in[6];
    signed char* U8 = (signed char*)(ws + WS_U8); signed char* V8 = (signed char*)(ws + WS_V8); float* SU = (float*)(ws + WS_SU); float* SV = (float*)(ws + WS_SV);
    pg8::StaticOrder So; So.init(M, NQ, G, bx); pg8::Unit un;
    int h_staged = -1;
    int nun = 0; while (So.next(nun, un)) ++nun;
    const int ne = (nun + 1) >> 1;
    LAS unsigned char* qst = lds + 256 * SKROW + wave * (32 * SKROW);
    u32x4 qa[8], qb[8];
    if (nun > 0) { So.next(0, un); qhalf_load(qa, QP + (size_t)(256 * un.pm + 32 * wave) * NQ + un.pn * 256, lane); }
    for (int uo = 0; uo < nun; ++uo) {
        const int ui = uo < ne ? 2 * uo : 2 * (uo - ne) + 1; So.next(ui, un);
        const int h = un.pn, tt = un.pm;
        int lane_ = lane; asm volatile("" : "+v"(lane_));
        const int ql = lane_ & 31, hh = lane_ >> 5, tid_ = wave * 64 + lane_;
        const int er0 = ((ui * G + bx) * 8 + wave) * 2;
        if (h != h_staged) {
            __syncthreads();
#pragma unroll
            for (int j = 0; j < 8; ++j) { const int id = tid_ + 512 * j, row = id >> 4, ch = id & 15;
                const u32x4 v = *(const u32x4*)(SK + ((size_t)h * 256 + row) * 128 + ch * 8); *(LAS u32x4*)(lds + row * SKROW + ch * 16) = v; }
            __syncthreads(); h_staged = h;
        }
        const int t = 256 * tt + 32 * wave + ql;
        const bf16* QPw = QP + (size_t)(256 * tt + 32 * wave) * NQ + h * 256;
        float A[16], B[16];
        f32x4 rw[4];
        qhalf_stage(qa, qst, lane_);
        qhalf_load(qb, QPw + 128, lane_);
        quant_row_load(pu + (size_t)er0 * D, rw, lane_);
        half_top16(A, qst, lds, ql, hh);
        quant_row_finish(rw, g_ffn, U8 + (size_t)er0 * 128, SU + er0, lane_);
        qhalf_stage(qb, qst, lane_);
        if (uo + 1 < nun) { const int un_ = uo + 1, ui2 = un_ < ne ? 2 * un_ : 2 * (un_ - ne) + 1; pg8::Unit u2; So.next(ui2, u2);
            qhalf_load(qa, QP + (size_t)(256 * u2.pm + 32 * wave) * NQ + u2.pn * 256, lane_); }
        quant_row_load(pv + (size_t)er0 * D, rw, lane_);
        half_top16(B, qst, lds + 128 * SKROW, ql, hh);
        quant_row_finish(rw, nullptr, V8 + (size_t)er0 * 128, SV + er0, lane_);
        f32x4 rw2[4];
        quant_row_load(pu + (size_t)(er0 + 1) * D, rw, lane_); quant_row_load(pv + (size_t)(er0 + 1) * D, rw2, lane_);
        unsigned ca[16], cb[16];
#pragma unroll
        for (int i = 0; i < 16; ++i) { ca[i] = (__builtin_bit_cast(unsigned, A[i]) & 0x7fu) << 7; cb[i] = __builtin_bit_cast(unsigned, B[i]) & 0x7fu; }
        float X0[16], X1[16], X2[16];
#pragma unroll
        for (int j = 0; j < 16; ++j) X0[j] = cand(A[0], B[j], ca[0], cb[j]);
#pragma unroll
        for (int j = 0; j < 8; ++j) X1[j] = cand(A[1], B[j], ca[1], cb[j]);
#pragma unroll
        for (int j = 0; j < 5; ++j) X1[8 + j] = cand(A[2], B[j], ca[2], cb[j]);
#pragma unroll
        for (int j = 0; j < 3; ++j) X1[13 + j] = cand(A[4], B[j], ca[4], cb[j]);
#pragma unroll
        for (int j = 0; j < 4; ++j) X2[j] = cand(A[3], B[j], ca[3], cb[j]);
#pragma unroll
        for (int i = 5; i < 8; ++i)
#pragma unroll
            for (int j = 0; j < 2; ++j) X2[4 + 2 * (i - 5) + j] = cand(A[i], B[j], ca[i], cb[j]);
#pragma unroll
        for (int i = 8; i < 14; ++i) X2[10 + (i - 8)] = cand(A[i], B[0], ca[i], cb[0]);
        const float x14 = cand(A[14], B[0], ca[14], cb[0]), x15 = cand(A[15], B[0], ca[15], cb[0]);
        sort16(X1); sort16(X2);
        topmerge(X1, X2); topmerge(X0, X1); insert16(X0, x14); insert16(X0, x15);
        float sc[16]; float den = 0.f;
#pragma unroll
        for (int i = 0; i < 16; ++i) { sc[i] = __builtin_bit_cast(float, __builtin_bit_cast(unsigned, X0[i]) & ~0x3fffu); }
        const float m0 = sc[0];
#pragma unroll
        for (int i = 0; i < 16; ++i) { sc[i] = __expf(sc[i] - m0); den += sc[i]; }
        const float rd = 1.f / den;
        if (hh == 0) { u32x4 w0, w1;
#pragma unroll
            for (int i = 0; i < 4; ++i) { w0[i] = (__builtin_bit_cast(unsigned, X0[2 * i]) & 0x3fffu) | ((__builtin_bit_cast(unsigned, X0[2 * i + 1]) & 0x3fffu) << 16);
                w1[i] = (__builtin_bit_cast(unsigned, X0[8 + 2 * i]) & 0x3fffu) | ((__builtin_bit_cast(unsigned, X0[8 + 2 * i + 1]) & 0x3fffu) << 16); }
            u32x4* ip = (u32x4*)(IDX + (size_t)t * 128 + h * 16); ip[0] = w0; ip[1] = w1;
        } else { f32x4* gp = (f32x4*)(GATE + (size_t)t * 128 + h * 16);
#pragma unroll
            for (int i = 0; i < 4; ++i) gp[i] = (f32x4){sc[4 * i] * rd, sc[4 * i + 1] * rd, sc[4 * i + 2] * rd, sc[4 * i + 3] * rd}; }
        quant_row_finish(rw, g_ffn, U8 + (size_t)(er0 + 1) * 128, SU + er0 + 1, lane_); quant_row_finish(rw2, nullptr, V8 + (size_t)(er0 + 1) * 128, SV + er0 + 1, lane_);
    }
    __syncthreads();
}
}
__global__ void __launch_bounds__(NWAVES * 64, 2) mega_fwd(Args a) {
    extern __shared__ __attribute__((aligned(16))) unsigned char lds_raw[];
    LAS unsigned char* lds = (LAS unsigned char*)lds_raw;
    volatile LAS unsigned* MISC = (volatile LAS unsigned*)(lds + MISC_OFF);
    const int wave = __builtin_amdgcn_readfirstlane((int)threadIdx.x >> 6);
#define TID_NOW (wave * 64 + lane_now())
    const int G = gridDim.x, bx = blockIdx.x, vcu = (G % 8 == 0) ? (bx % 8) * (G / 8) + bx / 8 : bx;
    unsigned char* ws = a.ws;
    if (threadIdx.x < 32) ((LAS unsigned*)(lds + LDSCTL_OFF))[threadIdx.x] = 0u;
    __syncthreads();
    XcdBarrier bar = xcd_barrier_post((unsigned*)(ws + WS_CTL) + CW_BAR + a.li * XCD_BAR_WORDS, MISC + 8);
    const int lo = a.ph_lo, hi = a.ph_hi;
#define IN(k) (lo <= (k) && (k) < hi)
#define BOTH(k) (IN(k) && IN((k) + 1))
    if (IN(0)) { p0_prologue(a, lds, vcu * NWAVES + wave, G * NWAVES, wave, lane_now()); if (BOTH(0)) xcd_barrier(bar, wave); }
    if (IN(1)) {
        pg8::Gemm g{(const bf16*)(ws + WS_XN), (const bf16*)(ws + WS_WIN), M, NPROJ, D / 2}; pg8::StaticOrder So; So.init(M, NPROJ, G, bx);
        pg8::EpiInProj E{(bf16*)(ws + WS_P), (bf16*)(ws + WS_Q), (size_t)(WS_K - WS_Q) / 2, (const float*)(ws + WS_SA), (const float*)(ws + WS_SWIN)};
        pg8::gemm_phase<pg8::EpiInProj, pg8::StaticOrder, true, true, true>(lds, g, So, E, wave);
        if (BOTH(1)) xcd_barrier(bar, wave);
    }
    if (IN(2)) { attn::attn_phase(ws, lds, vcu, G, TID_NOW); if (BOTH(2)) xcd_barrier(bar, wave); }
    if (IN(3)) { mixp::mix_phase(a, lds, vcu * NWAVES + wave, G * NWAVES, wave, lane_now()); if (BOTH(3)) xcd_barrier(bar, wave); }
    if (IN(4)) {
        pg8::Gemm g{(const bf16*)(ws + WS_MIXIN), (const bf16*)(ws + WS_WOUT), M, D, D}; pg8::StaticOrder So; So.init(M, D, G, bx);
        pg8::EpiOutProj E{a.in[0], (bf16*)(ws + WS_XN), (float*)(ws + WS_ROWSS)};
        pg8::gemm_phase<pg8::EpiOutProj, pg8::StaticOrder, true, true>(lds, g, So, E, wave);
        if (BOTH(4)) xcd_barrier(bar, wave);
    }
    if (IN(5)) {
        pg8::Gemm g{(const bf16*)(ws + WS_XN), (const bf16*)(ws + WS_WQ), M, NQ, D}; pg8::StaticOrder So; So.init(M, NQ, G, bx);
        pg8::EpiPeerQ E{(bf16*)(ws + WS_QP), (const float*)(ws + WS_ROWSS)};
        pg8::gemm_phase<pg8::EpiPeerQ, pg8::StaticOrder, true, true>(lds, g, So, E, wave);
    }
    if (IN(6)) { topk::topk_phase(a, lds, bx, G, TID_NOW); if (BOTH(6)) xcd_barrier(bar, wave); }
    if (IN(7)) { peer::gather_phase(a, lds, vcu, G, wave, lane_now()); }
#undef IN
#undef BOTH
#undef TID_NOW
}
extern "C" void kernel_launch(void* const* d_in, const int* in_sizes, int n_in, void* d_out, int out_size, void* d_ws, size_t ws_size, hipStream_t stream) {
    static int grid = 0;
    if (grid == 0) {
        if (n_in != 12 || in_sizes[0] != M * D || out_size != M * D || ws_size < WS_END) { fprintf(stderr, "kernel_launch: unexpected shapes (n_in %d, in0 %d, out %d, ws %zu)\n", n_in, n_in > 0 ? in_sizes[0] : -1, out_size, ws_size); grid = -1; return; }
        int dev = 0, cus = 0, per_cu = 0;
        if (hipGetDevice(&dev) != hipSuccess || hipDeviceGetAttribute(&cus, hipDeviceAttributeMultiprocessorCount, dev) != hipSuccess) { fprintf(stderr, "kernel_launch: device query failed\n"); grid = -1; return; }
        if (hipFuncSetAttribute((const void*)mega_fwd, hipFuncAttributeMaxDynamicSharedMemorySize, LDS_BYTES) != hipSuccess) { fprintf(stderr, "kernel_launch: hipFuncSetAttribute failed\n"); grid = -1; return; }
        if (hipOccupancyMaxActiveBlocksPerMultiprocessor(&per_cu, (const void*)mega_fwd, NWAVES * 64, LDS_BYTES) != hipSuccess || per_cu < 1) { fprintf(stderr, "kernel_launch: occupancy query says %d blocks per CU\n", per_cu); grid = -1; (void)hipGetLastError(); return; }
        grid = cus;
    }
    if (grid < 0) return;
    (void)hipMemsetAsync((char*)d_ws + WS_CTL + CW_BAR * 4, 0, (CW_END - CW_BAR) * 4, stream);
    Args a{};
    for (int i = 0; i < 12; ++i) a.in[i] = (const float*)d_in[i];
    a.out = (float*)d_out; a.ws = (unsigned char*)d_ws; a.ph_lo = 0; a.ph_hi = 8; a.li = 0;
    hipLaunchKernelGGL(mega_fwd, dim3(grid), dim3(NWAVES * 64), LDS_BYTES, stream, a);
#ifdef PROBE_LO
    a.ph_lo = PROBE_LO; a.ph_hi = PROBE_HI; a.li = 1;
    hipLaunchKernelGGL(mega_fwd, dim3(grid), dim3(NWAVES * 64), LDS_BYTES, stream, a);
#endif
}
```

```cpp
#include <hip/hip_runtime.h>
#include <cstdio>
#include <cstdint>
__device__ __forceinline__ int lane_now() { int l; asm volatile("v_mbcnt_lo_u32_b32 %0, -1, 0\n\tv_mbcnt_hi_u32_b32 %0, -1, %0" : "=v"(l)); return l; }
namespace pg8 {
#define PG8_LAS __attribute__((address_space(3)))
typedef unsigned short bf16_t;
typedef short bf16x8 __attribute__((ext_vector_type(8)));
typedef float f32x4 __attribute__((ext_vector_type(4)));
typedef unsigned u32x4 __attribute__((ext_vector_type(4)));
typedef int i32x4 __attribute__((ext_vector_type(4)));
constexpr int BM = 256, BK = 64, HALF = 128, HTB = HALF * BK * 2  , STAGE_BYTES = 8 * HTB, NXCD = 8, WGM = 8;

__host__ __device__ __forceinline__ int lds_byte(int r, int c) { const int st = (r >> 4) * 2 + (c >> 5), rr = r & 15, cc = c & 31, ob = rr * 64 + cc * 2; return st * 1024 + (ob ^ (((ob >> 9) & 1) << 5)); }
__host__ __device__ __forceinline__ void stage_rc(int b, int& R, int& C) { const int st = b / 1024, sb = b % 1024, swz = sb ^ (((sb >> 9) & 1) << 5); R = (st >> 1) * 16 + swz / 64; C = (st & 1) * 32 + (swz % 64) / 2; }
__host__ __device__ __forceinline__ int perm32(int rho) { const int n = rho >> 4, i = rho & 15; return 8 * (i >> 2) + 4 * n + (i & 3); }

struct Unit { int pm, pn; };
struct Gemm { const bf16_t* A; const bf16_t* Bt; int M, N, K; };

struct StaticOrder {
    int nM, nN, nwg, G, c;
    __host__ __device__ void init(int M, int N, int G_, int c_) { nM = M / BM; nN = N / BM; nwg = nM * nN; G = G_; c = c_; }
    __host__ __device__ bool next(int i, Unit& u) const {
        const long L = (long)i * G + c; if (L >= nwg) return false;
        int wgid = (int)L; { const int q = nwg / NXCD, r = nwg % NXCD, xcd = wgid % NXCD, off = wgid / NXCD; wgid = (xcd < r ? xcd * (q + 1) : r * (q + 1) + (xcd - r) * q) + off; }
        const int nig = WGM * nN, gid = wgid / nig, fm = gid * WGM, gsz = (nM - fm) < WGM ? (nM - fm) : WGM;
        u.pm = fm + ((wgid % nig) % gsz); u.pn = (wgid % nig) / gsz; return true;
    }
    __device__ __forceinline__ void a_ready(const Unit&) const {}
    __device__ __forceinline__ void done(const Unit&) const {}
};

__device__ __forceinline__ unsigned cvt_pk_bf16(float lo, float hi) { unsigned r; asm volatile("v_cvt_pk_bf16_f32 %0, %1, %2" : "=v"(r) : "v"(lo), "v"(hi)); return r; }
typedef unsigned u32x2 __attribute__((ext_vector_type(2)));
constexpr float C2Q = 0.125f * 1.4426950408889634f;
struct EpiInProj {
    static constexpr bool PERM = true, AFTER_DRAIN = false;
    bf16_t* P; bf16_t* QKV; size_t ty_stride; const float* sa; const float* sw;
    __device__ __forceinline__ void operator()(const f32x4 (&acc)[2][2][4][2], const Unit& u, int wr, int wc, int fr, int fq) const {
        const int row0 = u.pm * BM + wr * 64 + fr;
        f32x4 swv[2][2];
#pragma unroll
        for (int bj = 0; bj < 2; ++bj)
#pragma unroll
            for (int n = 0; n < 2; ++n) swv[bj][n] = *(const f32x4*)(sw + u.pn * BM + bj * HALF + wc * 32 + 8 * fq + 4 * n);
#define PG8_I2F(x) __builtin_convertvector(__builtin_bit_cast(i32x4, (x)), f32x4)
        if (u.pn == 0) {
#pragma unroll
            for (int ai = 0; ai < 2; ++ai)
#pragma unroll
                for (int m = 0; m < 4; ++m) { bf16_t* rowp = P + (size_t)(row0 + ai * HALF + m * 16) * 256 + wc * 32 + 8 * fq; const float sar = sa[row0 + ai * HALF + m * 16];
#pragma unroll
                    for (int bj = 0; bj < 2; ++bj) { const f32x4 v0 = PG8_I2F(acc[ai][bj][m][0]) * swv[bj][0] * sar, v1 = PG8_I2F(acc[ai][bj][m][1]) * swv[bj][1] * sar;
                        u32x4 w; w.x = cvt_pk_bf16(v0[0], v0[1]); w.y = cvt_pk_bf16(v0[2], v0[3]); w.z = cvt_pk_bf16(v1[0], v1[1]); w.w = cvt_pk_bf16(v1[2], v1[3]);
                        *(u32x4*)(rowp + bj * HALF) = w; } }
        } else {
            const int ty = (u.pn - 1) / 3, g = (u.pn - 1) % 3, sh = 2 * g;
            const float sc = (ty == 0) ? C2Q : 1.f;
            bf16_t* base = QKV + (size_t)ty * ty_stride;
#pragma unroll
            for (int ai = 0; ai < 2; ++ai)
#pragma unroll
                for (int m = 0; m < 4; ++m) { const int row = row0 + ai * HALF + m * 16, b = row >> 11, pos = row & 2047;
                    const int seqp = ((pos & ((1 << sh) - 1)) << (11 - sh)) | (pos >> sh); const float sar = sa[row] * sc;
#pragma unroll
                    for (int bj = 0; bj < 2; ++bj) { const int cl = bj * HALF + wc * 32 + 8 * fq, hd = 4 * g + (cl >> 6), c = cl & 63;
                        const f32x4 v0 = PG8_I2F(acc[ai][bj][m][0]) * swv[bj][0] * sar, v1 = PG8_I2F(acc[ai][bj][m][1]) * swv[bj][1] * sar;
                        u32x4 w; w.x = cvt_pk_bf16(v0[0], v0[1]); w.y = cvt_pk_bf16(v0[2], v0[3]); w.z = cvt_pk_bf16(v1[0], v1[1]); w.w = cvt_pk_bf16(v1[2], v1[3]);
                        *(u32x4*)(base + ((size_t)((b * 12 + hd) * 2048 + seqp)) * 64 + c) = w; } }
        }
#undef PG8_I2F
    }
};
struct EpiOutProj {
    static constexpr bool PERM = true, AFTER_DRAIN = false;
    const float* x; bf16_t* x2b; float* rowss;
    __device__ __forceinline__ void operator()(const f32x4 (&acc)[2][2][4][2], const Unit& u, int wr, int wc, int fr, int fq) const {
        const int col0 = u.pn * BM + wc * 32 + 8 * fq;
#pragma unroll
        for (int ai = 0; ai < 2; ++ai)
#pragma unroll
            for (int m = 0; m < 4; ++m) { const int row = u.pm * BM + ai * HALF + wr * 64 + m * 16 + fr; const size_t off = (size_t)row * 1024 + col0; float ss = 0.f;
#pragma unroll
                for (int bj = 0; bj < 2; ++bj) { const size_t o2 = off + bj * HALF;
                    const f32x4 o0 = *(const f32x4*)(x + o2) + acc[ai][bj][m][0], o1 = *(const f32x4*)(x + o2 + 4) + acc[ai][bj][m][1];
                    ss += ((o0[0] * o0[0] + o0[1] * o0[1]) + (o0[2] * o0[2] + o0[3] * o0[3])) + ((o1[0] * o1[0] + o1[1] * o1[1]) + (o1[2] * o1[2] + o1[3] * o1[3]));
                    u32x4 w; w.x = cvt_pk_bf16(o0[0], o0[1]); w.y = cvt_pk_bf16(o0[2], o0[3]); w.z = cvt_pk_bf16(o1[0], o1[1]); w.w = cvt_pk_bf16(o1[2], o1[3]);
                    *(u32x4*)(x2b + o2) = w; }
                ss += __shfl_xor(ss, 16); ss += __shfl_xor(ss, 32);
                if (fq == 0) atomicAdd(rowss + row, ss); }
    }
};
struct EpiPeerQ {
    static constexpr bool PERM = true, AFTER_DRAIN = false;
    bf16_t* O; const float* rowss;
    __device__ __forceinline__ void operator()(const f32x4 (&acc)[2][2][4][2], const Unit& u, int wr, int wc, int fr, int fq) const {
        const int row0 = u.pm * BM + wr * 64 + fr, col0 = u.pn * BM + wc * 32 + 8 * fq;
#pragma unroll
        for (int ai = 0; ai < 2; ++ai)
#pragma unroll
            for (int m = 0; m < 4; ++m) { const int row = row0 + ai * HALF + m * 16; const float rs = rsqrtf(rowss[row] * (1.f / 1024.f) + 1e-6f);
                bf16_t* rowp = O + (size_t)row * 2048 + col0;
#pragma unroll
                for (int bj = 0; bj < 2; ++bj) { const f32x4 v0 = acc[ai][bj][m][0] * rs, v1 = acc[ai][bj][m][1] * rs;
                    u32x4 w; w.x = cvt_pk_bf16(v0[0], v0[1]); w.y = cvt_pk_bf16(v0[2], v0[3]); w.z = cvt_pk_bf16(v1[0], v1[1]); w.w = cvt_pk_bf16(v1[2], v1[3]);
                    *(u32x4*)(rowp + bj * HALF) = w; } }
    }
};
template <class Epi, class Sched, bool ALIGN_EPI = false, bool SP2 = false, bool I8 = false>
__device__ __forceinline__ void gemm_phase(PG8_LAS unsigned char* lds, const Gemm g, const Sched& S, const Epi& E, int wid) {
    const int lane = lane_now(), tid = wid * 64 + lane, wr = wid >> 2, wc = wid & 3, fr = lane & 15, fq = lane >> 4;
    const int K = g.K, nt = K / BK;
    unsigned voffA[2], voffB[2];
#pragma unroll
    for (int i = 0; i < 2; ++i) { int R, C; stage_rc(tid * 16 + i * 8192, R, C); const int Rb = Epi::PERM ? ((R & ~31) + perm32(R & 31)) : R;
        voffA[i] = (unsigned)(R * K + C) * 2u; voffB[i] = (unsigned)(Rb * K + C) * 2u; }
    const size_t kstep = (size_t)(BK * 2);
    const size_t hstep = (size_t)HALF * K * 2;
    const size_t tstep = 2 * hstep;
    const unsigned ldsw = (unsigned)wid * 1024u;
    const int aoff = lds_byte(wr * 64 + fr, fq * 8), boff = lds_byte(wc * 32 + fr, fq * 8);
#define PG8_SA(b, h) (((b) * 2 + (h)) * HTB)
#define PG8_SB(b, h) ((4 + (b) * 2 + (h)) * HTB)
#define PG8_STAGE(bufoff, gbase, voff) do { _Pragma("unroll") for (int _i = 0; _i < 2; ++_i) \
        __builtin_amdgcn_global_load_lds((const unsigned*)((const char*)(gbase) + (voff)[_i]), (PG8_LAS unsigned*)(lds + (bufoff) + ldsw + _i * 8192), 16, 0, 0); } while (0)
#define PG8_LDA(dst, b, h) do { _Pragma("unroll") for (int m = 0; m < 4; ++m) _Pragma("unroll") for (int k = 0; k < 2; ++k) dst[m][k] = *(const PG8_LAS bf16x8*)(lds + PG8_SA(b, h) + aoff + m * 2048 + k * 1024); } while (0)
#define PG8_LDB(dst, b, h) do { _Pragma("unroll") for (int n = 0; n < 2; ++n) _Pragma("unroll") for (int k = 0; k < 2; ++k) dst[n][k] = *(const PG8_LAS bf16x8*)(lds + PG8_SB(b, h) + boff + n * 2048 + k * 1024); } while (0)
#define PG8_MMA(ai, bj, At, Bt) do { __builtin_amdgcn_s_setprio(1); _Pragma("unroll") for (int m = 0; m < 4; ++m) _Pragma("unroll") for (int n = 0; n < 2; ++n) _Pragma("unroll") for (int k = 0; k < 2; ++k) \
        { if constexpr (I8) acc[ai][bj][m][n] = __builtin_bit_cast(f32x4, __builtin_amdgcn_mfma_i32_16x16x64_i8(__builtin_bit_cast(i32x4, Bt[n][k]), __builtin_bit_cast(i32x4, At[m][k]), __builtin_bit_cast(i32x4, acc[ai][bj][m][n]), 0, 0, 0)); \
          else acc[ai][bj][m][n] = __builtin_amdgcn_mfma_f32_16x16x32_bf16(Bt[n][k], At[m][k], acc[ai][bj][m][n], 0, 0, 0); } __builtin_amdgcn_s_setprio(0); } while (0)
#define PG8_WAIT_V(n) asm volatile("s_waitcnt vmcnt(" #n ")" ::: "memory")
#define PG8_WAIT_L(n) asm volatile("s_waitcnt lgkmcnt(" #n ")" ::: "memory")
#define PG8_BAR __builtin_amdgcn_s_barrier()
#define PG8_SCHED __builtin_amdgcn_sched_barrier(0)
    Unit cur, nxt; int ui = 0;
    if (!S.next(0, cur)) return;
    f32x4 acc[2][2][4][2];
#pragma unroll
    for (int a = 0; a < 2; ++a)
#pragma unroll
        for (int b = 0; b < 2; ++b)
#pragma unroll
            for (int m = 0; m < 4; ++m)
#pragma unroll
                for (int n = 0; n < 2; ++n) acc[a][b][m][n] = (f32x4){0.f, 0.f, 0.f, 0.f};
    bf16x8 At[4][2], B0[2][2], B1[2][2];
    const char* cA = (const char*)g.A + (size_t)cur.pm * tstep; const char* cB = (const char*)g.Bt + (size_t)cur.pn * tstep;
    S.a_ready(cur);
    if constexpr (SP2) {
        PG8_STAGE(PG8_SB(0, 0), cB, voffB); PG8_STAGE(PG8_SB(0, 1), cB + hstep, voffB); PG8_STAGE(PG8_SA(0, 0), cA, voffA); PG8_STAGE(PG8_SA(0, 1), cA + hstep, voffA);
        if (wr == 1) PG8_BAR;
        PG8_WAIT_V(2); PG8_BAR;
        PG8_STAGE(PG8_SB(1, 0), cB + kstep, voffB); PG8_STAGE(PG8_SA(1, 0), cA + kstep, voffA); PG8_STAGE(PG8_SB(1, 1), cB + hstep + kstep, voffB);
        PG8_WAIT_V(6); PG8_BAR;
    } else {
        PG8_STAGE(PG8_SB(0, 0), cB, voffB); PG8_STAGE(PG8_SA(0, 0), cA, voffA); PG8_STAGE(PG8_SB(0, 1), cB + hstep, voffB); PG8_STAGE(PG8_SA(0, 1), cA + hstep, voffA);
        if (wr == 1) PG8_BAR;
        PG8_WAIT_V(4); PG8_BAR;
        PG8_STAGE(PG8_SB(1, 0), cB + kstep, voffB); PG8_STAGE(PG8_SA(1, 0), cA + kstep, voffA); PG8_STAGE(PG8_SB(1, 1), cB + hstep + kstep, voffB);
        PG8_WAIT_V(6); PG8_BAR;
    }
    for (;;) {
        const bool has_next = S.next(ui + 1, nxt);
        const char* nA = has_next ? (const char*)g.A + (size_t)nxt.pm * tstep : cA; const char* nB = has_next ? (const char*)g.Bt + (size_t)nxt.pn * tstep : cB;
        for (int t = 0; t < nt; t += 2) {
            const bool last = (t == nt - 2);
            const char* a1 = cA + (size_t)(t + 1) * kstep;
            const char* a2 = last ? nA : cA + (size_t)(t + 2) * kstep; const char* b2 = last ? nB : cB + (size_t)(t + 2) * kstep;
            const char* a3 = a2 + kstep; const char* b3 = b2 + kstep;
            if (last && has_next) S.a_ready(nxt);
            if constexpr (SP2) {
            PG8_LDB(B0, 0, 0); PG8_LDB(B1, 0, 1); PG8_SCHED; PG8_LDA(At, 0, 0); PG8_STAGE(PG8_SA(1, 1), a1 + hstep, voffA);
            PG8_WAIT_V(8); PG8_WAIT_L(0); PG8_BAR; PG8_MMA(0, 0, At, B0); PG8_MMA(0, 1, At, B1); PG8_BAR; PG8_SCHED;
            PG8_LDA(At, 0, 1); PG8_STAGE(PG8_SB(0, 0), b2, voffB); PG8_STAGE(PG8_SB(0, 1), b2 + hstep, voffB); PG8_STAGE(PG8_SA(0, 0), a2, voffA);
            PG8_WAIT_V(8); PG8_WAIT_L(0); PG8_BAR; PG8_MMA(1, 0, At, B0); PG8_MMA(1, 1, At, B1); PG8_BAR; PG8_SCHED;
            PG8_LDB(B0, 1, 0); PG8_LDB(B1, 1, 1); PG8_SCHED; PG8_LDA(At, 1, 0); PG8_STAGE(PG8_SA(0, 1), a2 + hstep, voffA);
            PG8_WAIT_V(8); PG8_WAIT_L(0); PG8_BAR; PG8_MMA(0, 0, At, B0); PG8_MMA(0, 1, At, B1); PG8_BAR; PG8_SCHED;
            PG8_LDA(At, 1, 1); PG8_STAGE(PG8_SB(1, 0), b3, voffB); PG8_STAGE(PG8_SB(1, 1), b3 + hstep, voffB); PG8_STAGE(PG8_SA(1, 0), a3, voffA);
            PG8_WAIT_V(8); PG8_WAIT_L(0); PG8_BAR; PG8_MMA(1, 0, At, B0); PG8_MMA(1, 1, At, B1); PG8_BAR; PG8_SCHED;
            } else {
            PG8_LDB(B0, 0, 0); PG8_SCHED; PG8_LDA(At, 0, 0); PG8_STAGE(PG8_SA(1, 1), a1 + hstep, voffA);
            PG8_WAIT_L(8); PG8_BAR; PG8_WAIT_L(0); PG8_MMA(0, 0, At, B0); PG8_BAR; PG8_SCHED;
            PG8_LDB(B1, 0, 1); PG8_STAGE(PG8_SB(0, 0), b2, voffB);
            PG8_BAR; PG8_WAIT_L(0); PG8_MMA(0, 1, At, B1); PG8_BAR;
            PG8_LDA(At, 0, 1); PG8_STAGE(PG8_SA(0, 0), a2, voffA);
            PG8_BAR; PG8_WAIT_L(0); PG8_MMA(1, 0, At, B0); PG8_BAR; PG8_SCHED;
            PG8_STAGE(PG8_SB(0, 1), b2 + hstep, voffB);
            PG8_WAIT_V(6); PG8_BAR; PG8_MMA(1, 1, At, B1); PG8_BAR;
            PG8_LDB(B0, 1, 0); PG8_SCHED; PG8_LDA(At, 1, 0); PG8_STAGE(PG8_SA(0, 1), a2 + hstep, voffA);
            PG8_WAIT_L(8); PG8_BAR; PG8_WAIT_L(0); PG8_MMA(0, 0, At, B0); PG8_BAR; PG8_SCHED;
            PG8_LDB(B1, 1, 1); PG8_STAGE(PG8_SB(1, 0), b3, voffB);
            PG8_BAR; PG8_WAIT_L(0); PG8_MMA(0, 1, At, B1); PG8_BAR;
            PG8_LDA(At, 1, 1); PG8_STAGE(PG8_SA(1, 0), a3, voffA);
            PG8_BAR; PG8_WAIT_L(0); PG8_MMA(1, 0, At, B0); PG8_BAR; PG8_SCHED;
            PG8_STAGE(PG8_SB(1, 1), b3 + hstep, voffB);
            PG8_WAIT_V(6); PG8_BAR; PG8_MMA(1, 1, At, B1); PG8_BAR;
            }
        }
        if constexpr (ALIGN_EPI) { if (wr == 0) PG8_BAR; }
        if constexpr (!Epi::AFTER_DRAIN) { E(acc, cur, wr, wc, fr, fq); S.done(cur); }
        if (!has_next) break;
#pragma unroll
        for (int a = 0; a < 2; ++a)
#pragma unroll
            for (int b = 0; b < 2; ++b)
#pragma unroll
                for (int m = 0; m < 4; ++m)
#pragma unroll
                    for (int n = 0; n < 2; ++n) acc[a][b][m][n] = (f32x4){0.f, 0.f, 0.f, 0.f};
        cur = nxt; cA = nA; cB = nB; ++ui;
        if constexpr (ALIGN_EPI) { if (wr == 1) PG8_BAR; }
    }
    PG8_WAIT_V(0);
    if constexpr (!ALIGN_EPI) { if (wr == 0) PG8_BAR; }
    PG8_BAR;
    if constexpr (Epi::AFTER_DRAIN) { E.fused(acc, cur, wr, wc, fr, fq, lds, wid, lane); S.done(cur); }
#undef PG8_SA
#undef PG8_SB
#undef PG8_STAGE
#undef PG8_LDA
#undef PG8_LDB
#undef PG8_MMA
#undef PG8_WAIT_V
#undef PG8_WAIT_L
#undef PG8_BAR
#undef PG8_SCHED
}
}
constexpr int M = 32768, D = 1024, S = 2048;
constexpr int NPROJ = 2560, NQ = 2048, NEXP = 16384;
typedef unsigned short bf16;
constexpr size_t MiB = 1u << 20;
constexpr size_t WS_CTL = 0, CTL_ZERO_BYTES = 1 * MiB;
constexpr size_t WS_WIN = 2 * MiB, WS_WOUT = 8 * MiB, WS_WQ = 10 * MiB;
constexpr size_t WS_SK = 14 * MiB, WS_WPT = 14 * MiB + 512 * 1024;
constexpr size_t WS_SA = 15 * MiB + 640 * 1024, WS_SWIN = 15 * MiB + 768 * 1024;
constexpr size_t WS_SU = 15 * MiB, WS_SV = 15 * MiB + 64 * 1024, WS_USUM = 15 * MiB + 128 * 1024, WS_ROWSS = 15 * MiB + 512 * 1024;
constexpr size_t WS_U8 = 16 * MiB, WS_V8 = 32 * MiB;
constexpr size_t WS_XN = 48 * MiB;
constexpr size_t WS_P = 112 * MiB;
constexpr size_t WS_Q = 128 * MiB, WS_K = 176 * MiB, WS_V = 224 * MiB;
constexpr size_t WS_ORAW = 272 * MiB, WS_LSE = 320 * MiB, WS_MIXIN = 322 * MiB, WS_END = 386 * MiB;
constexpr size_t WS_QP = 128 * MiB, WS_IDX = 256 * MiB, WS_GATE = 264 * MiB, WS_X8 = 280 * MiB;
constexpr size_t WS_PROJ = 386 * MiB;
constexpr int CW_BAR = 4096;
constexpr int CW_CMAX = CW_BAR + 2 * 3456, CW_CCNT = CW_CMAX + NPROJ, CW_END = CW_CCNT + NPROJ / 32;

constexpr int RING_BYTES = 147456;
constexpr int LDSCTL_OFF = RING_BYTES, MISC_OFF = LDSCTL_OFF;
constexpr int LDS_BYTES = RING_BYTES + 128;
constexpr int NWAVES = 8;

#define GAS __attribute__((address_space(1)))
#define LAS __attribute__((address_space(3)))
typedef unsigned v4u __attribute__((ext_vector_type(4)));
typedef float f32x4 __attribute__((ext_vector_type(4)));
typedef GAS unsigned gu32;
#define LDS_WAIT() asm volatile("s_waitcnt lgkmcnt(0)" ::: "memory")
#define VM_WAIT() asm volatile("s_waitcnt vmcnt(0)" ::: "memory")
__device__ __forceinline__ unsigned f2bf(float f) { unsigned u = __builtin_bit_cast(unsigned, f); return (u + 0x7fffu + ((u >> 16) & 1u)) >> 16; }
__device__ __forceinline__ unsigned pk2(float lo, float hi) { return f2bf(lo) | (f2bf(hi) << 16); }
__device__ __forceinline__ float bf2f(unsigned short b) { return __builtin_bit_cast(float, (unsigned)b << 16); }
template <int CTRL> __device__ __forceinline__ float dpp_mov(float v) { return __builtin_bit_cast(float, __builtin_amdgcn_mov_dpp(__builtin_bit_cast(int, v), CTRL, 0xF, 0xF, true)); }
__device__ __forceinline__ float lane_val(float v, int l) { return __builtin_bit_cast(float, __builtin_amdgcn_readlane(__builtin_bit_cast(int, v), l)); }
__device__ __forceinline__ float wave_sum(float v) {
    v += dpp_mov<0xB1>(v); v += dpp_mov<0x4E>(v); v += dpp_mov<0x141>(v); v += dpp_mov<0x140>(v);
    return (lane_val(v, 0) + lane_val(v, 16)) + (lane_val(v, 32) + lane_val(v, 48));
}
__device__ __forceinline__ float wave_max(float v) {
    v = fmaxf(v, dpp_mov<0xB1>(v)); v = fmaxf(v, dpp_mov<0x4E>(v)); v = fmaxf(v, dpp_mov<0x141>(v)); v = fmaxf(v, dpp_mov<0x140>(v));
    return fmaxf(fmaxf(lane_val(v, 0), lane_val(v, 16)), fmaxf(lane_val(v, 32), lane_val(v, 48)));
}
#define XB_TMO      128
#define XB_XCNT(j)  (256  + 64 * (j))
#define XB_XSUB(j)  (1280 + 64 * (j))
#define XB_XGEN(j)  (2304 + 64 * (j))
#define XB_TOP      3328
#define XB_TOPGEN   3392
#define XCD_BAR_WORDS 3456
#define XB_SPIN_CAP (1u << 18)

__device__ __forceinline__ unsigned xb_ld(unsigned* p)              { return __hip_atomic_load(p, __ATOMIC_RELAXED, __HIP_MEMORY_SCOPE_AGENT); }
__device__ __forceinline__ unsigned xb_add(unsigned* p, unsigned v) { return __hip_atomic_fetch_add(p, v, __ATOMIC_RELAXED, __HIP_MEMORY_SCOPE_AGENT); }
__device__ __forceinline__ unsigned xb_xcc_id() { return (unsigned)__builtin_amdgcn_s_getreg((3 << 11) | 20) & 0xFu; }
#define XB_SPIN(cond, bar) do { unsigned _sp = 0; while (cond) { __builtin_amdgcn_s_sleep(1); \
    if ((++_sp & 255u) == 0u) { if (xb_ld(&(bar)[XB_TMO])) break; if (_sp > XB_SPIN_CAP) { atomicAdd(&(bar)[XB_TMO], 1u); break; } } } } while (0)

struct XcdBarrier {
    unsigned* bar; unsigned x;
    volatile LAS unsigned* st;
};

__device__ __forceinline__ XcdBarrier xcd_barrier_post(unsigned* bar, volatile LAS unsigned* st) {
    XcdBarrier b; b.bar = bar; b.x = xb_xcc_id(); b.st = st;
    if (threadIdx.x == 0) (void)xb_add(&bar[XB_XCNT(b.x)], 1u);
    return b;
}
__device__ __forceinline__ void xcd_barrier_complete(unsigned* bar, unsigned x, unsigned& nloc, unsigned& nx) {
    const unsigned G = gridDim.x * gridDim.y * gridDim.z;
    unsigned sum, cnt, mine, sp = 0u;
    for (;;) {
        sum = 0u; cnt = 0u; mine = 0u;
#pragma unroll
        for (unsigned j = 0; j < 16; ++j) { const unsigned c = xb_ld(&bar[XB_XCNT(j)]); sum += c; cnt += (c > 0u) ? 1u : 0u; mine = (j == x) ? c : mine; }
        if (sum == G) break;
        __builtin_amdgcn_s_sleep(1);
        if ((++sp & 255u) == 0u) { if (xb_ld(&bar[XB_TMO])) break; if (sp > XB_SPIN_CAP) { atomicAdd(&bar[XB_TMO], 1u); break; } }
    }
    nloc = mine > 0u ? mine : 1u; nx = cnt > 0u ? cnt : 1u;
}

__device__ __forceinline__ void xcd_barrier(const XcdBarrier& b, int wave_) {
    asm volatile("s_waitcnt vmcnt(0)" ::: "memory");
    __syncthreads();
    if (wave_ == 0 && lane_now() == 0) {
        unsigned* bar = b.bar;
        __builtin_amdgcn_s_waitcnt(0);
        unsigned nloc = b.st[0], nx = b.st[1];
        if (nloc == 0u) { xcd_barrier_complete(bar, b.x, nloc, nx); b.st[0] = nloc; b.st[1] = nx; }
        const unsigned old = xb_add(&bar[XB_XSUB(b.x)], 1u);
        const unsigned gen = old / nloc;
        if (old + 1u == (gen + 1u) * nloc) {
            __builtin_amdgcn_fence(__ATOMIC_RELEASE, "agent");
            asm volatile("s_waitcnt vmcnt(0)" ::: "memory");
            const unsigned og = xb_add(&bar[XB_TOP], 1u);
            const unsigned tg = og / nx;
            if (og + 1u == (tg + 1u) * nx) xb_add(&bar[XB_TOPGEN], 1u);
            else XB_SPIN(xb_ld(&bar[XB_TOPGEN]) == tg, bar);
            __builtin_amdgcn_fence(__ATOMIC_ACQUIRE, "agent");
            xb_add(&bar[XB_XGEN(b.x)], 1u);
            asm volatile("s_waitcnt vmcnt(0)" ::: "memory");
        } else {
            XB_SPIN(xb_ld(&bar[XB_XGEN(b.x)]) == gen, bar);
            __builtin_amdgcn_fence(__ATOMIC_ACQUIRE, "agent");
            asm volatile("s_waitcnt vmcnt(0)" ::: "memory");
        }
    }
    __syncthreads();
}
struct Args { const float* in[12]; float* out; unsigned char* ws; int ph_lo, ph_hi, li, pad; };

__device__ __forceinline__ void p0_transpose_item(const float* W, int K, int N, bf16* WT, const float* kscale, LAS float* scr, int item, int lane) {
    const int nblk = N / 32, kb = item / nblk, nb = item % nblk, k0 = 64 * kb, n0 = 32 * nb;
#pragma unroll 8
    for (int i = 0; i < 32; ++i) { const int kk = 2 * i + (lane >> 5); float w = W[(size_t)(k0 + kk) * N + n0 + (lane & 31)]; if (kscale) w *= kscale[k0 + kk]; scr[kk * 33 + (lane & 31)] = w; }
    LDS_WAIT(); asm volatile("" ::: "memory");
    const int c = lane & 7;
#pragma unroll
    for (int j = 0; j < 4; ++j) { const int n = (lane >> 3) + 8 * j; const LAS float* s = scr + (8 * c) * 33 + n;
        v4u o; o.x = pk2(s[0 * 33], s[1 * 33]); o.y = pk2(s[2 * 33], s[3 * 33]); o.z = pk2(s[4 * 33], s[5 * 33]); o.w = pk2(s[6 * 33], s[7 * 33]);
        *(GAS v4u*)(WT + (size_t)(n0 + n) * K + k0 + 8 * c) = o; }
    LDS_WAIT(); asm volatile("" ::: "memory");
}
__device__ __forceinline__ void p0_quant_publish(const float* W, int N, unsigned* cmax, unsigned* ccnt, LAS float* scr, int item, int lane) {
    const int nblk = N / 32, kb = item / nblk, nb = item % nblk, k0 = 64 * kb, n0 = 32 * nb;
    float mx = 0.f;
#pragma unroll 8
    for (int i = 0; i < 32; ++i) { const int kk = 2 * i + (lane >> 5); const float w = W[(size_t)(k0 + kk) * N + n0 + (lane & 31)]; scr[kk * 33 + (lane & 31)] = w; mx = fmaxf(mx, fabsf(w)); }
    { const auto rr = __builtin_amdgcn_permlane32_swap(__builtin_bit_cast(unsigned, mx), __builtin_bit_cast(unsigned, mx), false, false);
      mx = fmaxf(__builtin_bit_cast(float, (unsigned)rr[0]), __builtin_bit_cast(float, (unsigned)rr[1])); }
    if (lane < 32) __hip_atomic_fetch_max(cmax + n0 + lane, __builtin_bit_cast(unsigned, mx), __ATOMIC_RELAXED, __HIP_MEMORY_SCOPE_AGENT);
    asm volatile("s_waitcnt vmcnt(0)" ::: "memory");
    if (lane == 0) __hip_atomic_fetch_add(ccnt + nb, 1u, __ATOMIC_RELAXED, __HIP_MEMORY_SCOPE_AGENT);
}
__device__ __forceinline__ void p0_quant_finish(int N, signed char* W8, float* sw, unsigned* cmax, unsigned* ccnt, LAS float* scr, int item, int lane) {
    const int nblk = N / 32, kb = item / nblk, nb = item % nblk, k0 = 64 * kb, n0 = 32 * nb;
    if (lane == 0) { unsigned sp = 0; while (__hip_atomic_load(ccnt + nb, __ATOMIC_RELAXED, __HIP_MEMORY_SCOPE_AGENT) < 16u) { __builtin_amdgcn_s_sleep(1); if (++sp > (1u << 22)) break; } }
    asm volatile("s_waitcnt vmcnt(0) lgkmcnt(0)" ::: "memory");
    __builtin_amdgcn_wave_barrier();
#pragma unroll
    for (int j = 0; j < 2; ++j) { const int n = 16 * j + (lane >> 2), ck = lane & 3;
        const float cm = __builtin_bit_cast(float, __hip_atomic_load(cmax + n0 + n, __ATOMIC_RELAXED, __HIP_MEMORY_SCOPE_AGENT));
        const float inv = cm > 0.f ? 127.f / cm : 0.f;
        if (kb == 0 && ck == 0) sw[n0 + n] = cm > 0.f ? cm * (1.f / 127.f) : 1.f;
        v4u o;
#pragma unroll
        for (int q = 0; q < 4; ++q) { const LAS float* sp_ = scr + (16 * ck + 4 * q) * 33 + n;
            const int a = (int)rintf(sp_[0] * inv), b = (int)rintf(sp_[33] * inv), c = (int)rintf(sp_[66] * inv), d = (int)rintf(sp_[99] * inv);
            o[q] = (unsigned)(a & 0xff) | ((unsigned)(b & 0xff) << 8) | ((unsigned)(c & 0xff) << 16) | ((unsigned)(d & 0xff) << 24); }
        *(GAS v4u*)(W8 + (size_t)(n0 + n) * 1024 + k0 + 16 * ck) = o; }
    LDS_WAIT(); asm volatile("" ::: "memory");
}
__device__ __forceinline__ void p0_quant_item(const float* W, int N, signed char* W8, float* sw, unsigned* cmax, unsigned* ccnt, LAS float* scr, int item, int lane) {
    p0_quant_publish(W, N, cmax, ccnt, scr, item, lane); p0_quant_finish(N, W8, sw, cmax, ccnt, scr, item, lane);
}
__device__ __forceinline__ void rms_row_to_bf16(const float* xrow, const float* g, bf16* orow, int lane) {
    const GAS f32x4* xr = (const GAS f32x4*)xrow + lane;
    f32x4 v[4]; float s = 0.f;
#pragma unroll
    for (int j = 0; j < 4; ++j) { v[j] = xr[64 * j]; s += (v[j].x * v[j].x + v[j].y * v[j].y) + (v[j].z * v[j].z + v[j].w * v[j].w); }
    const float r = rsqrtf(wave_sum(s) * (1.f / D) + 1e-6f);
    GAS unsigned long long* o8 = (GAS unsigned long long*)orow + lane;
#pragma unroll
    for (int j = 0; j < 4; ++j) { const f32x4 gg = ((const GAS f32x4*)g)[lane + 64 * j];
        o8[64 * j] = (unsigned long long)pk2(v[j].x * r * gg.x, v[j].y * r * gg.y) | ((unsigned long long)pk2(v[j].z * r * gg.z, v[j].w * r * gg.w) << 32); }
}
__device__ __forceinline__ void quant_row_i8(const float* src, const float* gsc, signed char* dst, float* scale_out, int lane) {
    const GAS f32x4* p = (const GAS f32x4*)src + 4 * lane;
    f32x4 v[4]; float amax = 0.f;
#pragma unroll
    for (int j = 0; j < 4; ++j) { v[j] = p[j]; if (gsc) v[j] = v[j] * ((const GAS f32x4*)gsc)[4 * lane + j];
        amax = fmaxf(amax, fmaxf(fmaxf(fabsf(v[j].x), fabsf(v[j].y)), fmaxf(fabsf(v[j].z), fabsf(v[j].w)))); }
    amax = wave_max(amax);
    const float inv = amax > 0.f ? 127.f / amax : 0.f;
    v4u w;
#pragma unroll
    for (int j = 0; j < 4; ++j) { const int a = (int)rintf(v[j].x * inv), b = (int)rintf(v[j].y * inv), c = (int)rintf(v[j].z * inv), d = (int)rintf(v[j].w * inv);
        w[j] = (unsigned)(a & 0xff) | ((unsigned)(b & 0xff) << 8) | ((unsigned)(c & 0xff) << 16) | ((unsigned)(d & 0xff) << 24); }
    *(GAS v4u*)(dst + (size_t)(lane >> 3) * ((size_t)NEXP * 128) + 16 * (lane & 7)) = w;
    if (lane == 0) *scale_out = amax > 0.f ? amax * (1.f / 127.f) : 1.f;
}
__device__ __forceinline__ void quant_row_load(const float* src, f32x4 (&v)[4], int lane) {
    const GAS f32x4* p = (const GAS f32x4*)src + 4 * lane;
#pragma unroll
    for (int j = 0; j < 4; ++j) v[j] = p[j];
}
__device__ __forceinline__ void quant_row_finish(f32x4 (&v)[4], const float* gsc, signed char* dst, float* scale_out, int lane) {
    float amax = 0.f;
#pragma unroll
    for (int j = 0; j < 4; ++j) { if (gsc) v[j] = v[j] * ((const GAS f32x4*)gsc)[4 * lane + j];
        amax = fmaxf(amax, fmaxf(fmaxf(fabsf(v[j].x), fabsf(v[j].y)), fmaxf(fabsf(v[j].z), fabsf(v[j].w)))); }
    amax = wave_max(amax);
    const float inv = amax > 0.f ? 127.f / amax : 0.f;
    v4u w;
#pragma unroll
    for (int j = 0; j < 4; ++j) { const int a = (int)rintf(v[j].x * inv), b = (int)rintf(v[j].y * inv), c = (int)rintf(v[j].z * inv), d = (int)rintf(v[j].w * inv);
        w[j] = (unsigned)(a & 0xff) | ((unsigned)(b & 0xff) << 8) | ((unsigned)(c & 0xff) << 16) | ((unsigned)(d & 0xff) << 24); }
    *(GAS v4u*)(dst + (size_t)(lane >> 3) * ((size_t)NEXP * 128) + 16 * (lane & 7)) = w;
    if (lane == 0) *scale_out = amax > 0.f ? amax * (1.f / 127.f) : 1.f;
}
__device__ __forceinline__ void quant_row_finish_u4(f32x4 (&v)[4], const float* gsc, unsigned char* dst, float* scale_out, float* usum_out, int lane) {
    float amax = 0.f, ssq = 0.f;
#pragma unroll
    for (int j = 0; j < 4; ++j) { v[j] = v[j] * ((const GAS f32x4*)gsc)[4 * lane + j];
        amax = fmaxf(amax, fmaxf(fmaxf(fabsf(v[j].x), fabsf(v[j].y)), fmaxf(fabsf(v[j].z), fabsf(v[j].w))));
        ssq += (v[j].x * v[j].x + v[j].y * v[j].y) + (v[j].z * v[j].z + v[j].w * v[j].w); }
    amax = wave_max(amax); ssq = wave_sum(ssq);
    const float clipv = fminf(amax, 2.7f * sqrtf(ssq * (1.f / D)));
    const float inv = clipv > 0.f ? 7.f / clipv : 0.f;
    unsigned w[2] = {0u, 0u}; float cs_ = 0.f;
#pragma unroll
    for (int j = 0; j < 4; ++j) { const float f_[4] = {v[j].x, v[j].y, v[j].z, v[j].w};
#pragma unroll
        for (int c = 0; c < 4; ++c) { const float q = fminf(fmaxf(rintf(f_[c] * inv), -7.f), 7.f) + 8.f; cs_ += q; w[j >> 1] |= (unsigned)(int)q << (4 * (4 * (j & 1) + c)); } }
    typedef unsigned v2u_ __attribute__((ext_vector_type(2)));
    *(GAS v2u_*)(dst + (size_t)(lane >> 4) * ((size_t)NEXP * 128) + 8 * (lane & 15)) = (v2u_){w[0], w[1]};
    cs_ = wave_sum(cs_);
    if (lane == 0) { *scale_out = clipv > 0.f ? clipv * (1.f / 7.f) : 1.f; *usum_out = cs_; }
}
__device__ __forceinline__ void p0_prologue(const Args& a, LAS unsigned char* lds, int gw, int NGW, int wave, int lane) {
    unsigned char* ws = a.ws;
    LAS float* scr = (LAS float*)(lds + wave * 17408);
    LAS float* scr2 = scr + 64 * 33;
    const float* w_in = a.in[2]; const float* w_pool = a.in[3]; const float* w_out = a.in[5]; const float* g_ffn = a.in[6]; const float* w_q = a.in[7];
    constexpr int I_IN = (D / 64) * (NPROJ / 32), I_OUT = (D / 64) * (D / 32), I_Q = (D / 64) * (NQ / 32), I_P = 4 * 2;
    constexpr int NITEMS = I_IN + I_OUT + I_Q + I_P;
    unsigned* cmax_ = (unsigned*)(ws + WS_CTL) + CW_CMAX; unsigned* ccnt_ = (unsigned*)(ws + WS_CTL) + CW_CCNT;
    const bool defer = gw < I_IN;
    if (defer) p0_quant_publish(w_in, NPROJ, cmax_, ccnt_, scr, gw, lane);
    for (int it = defer ? gw + NGW : gw; it < NITEMS; it += NGW) {
        int r = it;
        if (r < I_IN) { p0_quant_item(w_in, NPROJ, (signed char*)(ws + WS_WIN), (float*)(ws + WS_SWIN), cmax_, ccnt_, scr2, r, lane); continue; } r -= I_IN;
        if (r < I_OUT) { p0_transpose_item(w_out, D, D, (bf16*)(ws + WS_WOUT), nullptr, scr2, r, lane); continue; } r -= I_OUT;
        if (r < I_Q) { p0_transpose_item(w_q, D, NQ, (bf16*)(ws + WS_WQ), g_ffn, scr2, r, lane); continue; } r -= I_Q;
        p0_transpose_item(w_pool + (r >> 1) * 4096, 64, 64, (bf16*)(ws + WS_WPT) + (r >> 1) * 4096, nullptr, scr2, r & 1, lane);
    }
    constexpr int R_X = M, R_SK = 256, R_Z = 32, NROWS = R_X + R_SK + R_Z;
    for (int c4 = gw; c4 < R_X / 4; c4 += NGW) {
        const GAS f32x4* xr = (const GAS f32x4*)(a.in[0] + (size_t)c4 * 4 * D) + lane;
        f32x4 v[4][4]; float ssq[4];
#pragma unroll
        for (int rr = 0; rr < 4; ++rr)
#pragma unroll
            for (int j = 0; j < 4; ++j) v[rr][j] = xr[rr * (D / 4) + 64 * j];
#pragma unroll
        for (int rr = 0; rr < 4; ++rr) { float s_ = 0.f;
#pragma unroll
            for (int j = 0; j < 4; ++j) s_ += (v[rr][j].x * v[rr][j].x + v[rr][j].y * v[rr][j].y) + (v[rr][j].z * v[rr][j].z + v[rr][j].w * v[rr][j].w);
            ssq[rr] = s_; }
#pragma unroll
        for (int rr = 0; rr < 4; ++rr) ssq[rr] = wave_sum(ssq[rr]);
#pragma unroll
        for (int rr = 0; rr < 4; ++rr) { const float rs = rsqrtf(ssq[rr] * (1.f / D) + 1e-6f);
            GAS unsigned* o4 = (GAS unsigned*)((signed char*)(ws + WS_XN) + ((size_t)c4 * 4 + rr) * D) + lane;
            f32x4 y[4]; float am = 0.f;
#pragma unroll
            for (int j = 0; j < 4; ++j) { const f32x4 gg = ((const GAS f32x4*)a.in[1])[lane + 64 * j]; y[j] = v[rr][j] * gg * rs;
                am = fmaxf(am, fmaxf(fmaxf(fabsf(y[j].x), fabsf(y[j].y)), fmaxf(fabsf(y[j].z), fabsf(y[j].w)))); }
            am = wave_max(am); const float qi = am > 0.f ? 127.f / am : 0.f;
#pragma unroll
            for (int j = 0; j < 4; ++j) { const int q0 = (int)rintf(y[j].x * qi), q1 = (int)rintf(y[j].y * qi), q2 = (int)rintf(y[j].z * qi), q3 = (int)rintf(y[j].w * qi);
                o4[64 * j] = (unsigned)(q0 & 0xff) | ((unsigned)(q1 & 0xff) << 8) | ((unsigned)(q2 & 0xff) << 16) | ((unsigned)q3 << 24); }
            if (lane == 0) ((float*)(ws + WS_SA))[(size_t)c4 * 4 + rr] = am > 0.f ? am * (1.f / 127.f) : 1.f; }
    }
    for (int it = R_X + gw; it < NROWS; it += NGW) {
        int r = it - R_X;
        if (r < R_SK) { const GAS f32x4* p = (const GAS f32x4*)(a.in[8] + (size_t)r * 1024) + lane; GAS unsigned long long* o8 = (GAS unsigned long long*)((bf16*)(ws + WS_SK) + (size_t)r * 1024) + lane;
#pragma unroll
            for (int j = 0; j < 4; ++j) { const f32x4 v = p[64 * j]; o8[64 * j] = (unsigned long long)pk2(v.x, v.y) | ((unsigned long long)pk2(v.z, v.w) << 32); }
            continue; } r -= R_SK;
        { GAS f32x4* z = (GAS f32x4*)((float*)(ws + WS_ROWSS) + (size_t)r * 1024) + lane;
#pragma unroll
          for (int j = 0; j < 4; ++j) z[64 * j] = (f32x4){0.f, 0.f, 0.f, 0.f}; }
    }
    if (defer) p0_quant_finish(NPROJ, (signed char*)(ws + WS_WIN), (float*)(ws + WS_SWIN), cmax_, ccnt_, scr, gw, lane);
}
namespace attn {
typedef short bf16x8 __attribute__((ext_vector_type(8)));
typedef short s16x4 __attribute__((ext_vector_type(4)));
typedef float f32x16 __attribute__((ext_vector_type(16)));
typedef float f32x2_t __attribute__((ext_vector_type(2)));
typedef __bf16 bf16x2_t __attribute__((ext_vector_type(2)));
typedef unsigned u32x4 __attribute__((ext_vector_type(4)));
typedef unsigned u32x2 __attribute__((ext_vector_type(2)));
constexpr int KROW = 144;
constexpr int SLOT = 2 * 256 * KROW;
__device__ __forceinline__ unsigned cvtpk(float lo, float hi) { f32x2_t v = {lo, hi}; bf16x2_t b = __builtin_convertvector(v, bf16x2_t); return __builtin_bit_cast(unsigned, b); }
__device__ __forceinline__ s16x4 vtr(LAS const unsigned char* p) { return __builtin_bit_cast(s16x4, __builtin_amdgcn_ds_read_tr16_b64_v4i16((LAS s16x4*)p)); }

__device__ __forceinline__ void attn_phase(unsigned char* ws, LAS unsigned char* lds, int vcu, int G, int tid) {
    const int lane = tid & 63, wv = __builtin_amdgcn_readfirstlane(tid >> 6), grp = wv >> 2, w = wv & 3, tl = tid & 255;
    const int ql = lane & 31, h = lane >> 5;
    LAS unsigned char* Ks = lds + grp * SLOT; LAS unsigned char* Vs = Ks + 256 * KROW;
    const bf16* Qd = (const bf16*)(ws + WS_Q); const bf16* Kd = (const bf16*)(ws + WS_K); const bf16* Vd = (const bf16*)(ws + WS_V);
    bf16* ORAW = (bf16*)(ws + WS_ORAW); float* LSE = (float*)(ws + WS_LSE);
#define ATT_UNIT(pi_) const int uid = 2 * (pi_) + grp, bh = uid >> 4, cu = uid & 15, hd = bh % 12, b = bh / 12, sh = 2 * (hd >> 2), L = 2048 >> sh; \
        const int r = cu >> (4 - sh), n = cu & ((16 >> sh) - 1), q0 = 128 * n; const size_t pbase = ((size_t)bh * 2048 + (size_t)r * L) * 64;
#define ATT_LOAD(pi_) do { ATT_UNIT(pi_) (void)b; (void)hd; const bf16* Kp = Kd + pbase; const bf16* Vp = Vd + pbase; const bf16* Qp = Qd + pbase; \
        _Pragma("unroll") for (int j = 0; j < 8; ++j) { const int id = tl + 256 * j, row = id >> 3, ch = id & 7; int kr = q0 - 64 + row; kr = kr < 0 ? 0 : (kr > L - 1 ? L - 1 : kr); \
            kreg[j] = *(const u32x4*)(Kp + (size_t)kr * 64 + ch * 8); vreg[j] = *(const u32x4*)(Vp + (size_t)kr * 64 + ch * 8); } \
        _Pragma("unroll") for (int ks = 0; ks < 4; ++ks) qn[ks] = *(const bf16x8*)(Qp + (size_t)(q0 + 32 * w + ql) * 64 + 16 * ks + 8 * h); } while (0)
    u32x4 kreg[8], vreg[8]; bf16x8 qn[4];
    if (vcu < 1536) ATT_LOAD(vcu);
    for (int pi = vcu; pi < 1536; pi += G) {
        ATT_UNIT(pi)
        __syncthreads();
        int hh = h, qll = ql; asm volatile("" : "+v"(hh), "+v"(qll));
#pragma unroll
        for (int j = 0; j < 8; ++j) { const int id = tl + 256 * j, row = id >> 3, ch = id & 7; *(LAS u32x4*)(Ks + row * KROW + ch * 16) = kreg[j]; *(LAS u32x4*)(Vs + row * KROW + ch * 16) = vreg[j]; }
        bf16x8 qf[4];
#pragma unroll
        for (int ks = 0; ks < 4; ++ks) qf[ks] = qn[ks];
        __syncthreads();
        if (pi + G < 1536) ATT_LOAD(pi + G);
        const float slope2 = exp2f(-8.f * (float)(hd + 1) / 12.f) * (float)(1 << sh) * 1.4426950408889634f;
        const int nb = qll - 4 * hh;
        const float sbp = -slope2 * (float)nb;
        bool tv[5];
#pragma unroll
        for (int kt = 0; kt < 5; ++kt) { const int klo = q0 + 32 * w + 32 * kt - 64; tv[kt] = (klo >= 0) && (klo + 32 <= L); }
        f32x16 sT[5]; float mx = -1e30f;
#pragma unroll
        for (int kt = 0; kt < 5; ++kt) {
            if (tv[kt]) {
                const float c0 = kt < 2 ? sbp : (kt == 2 ? 0.f : -sbp);
                f32x16 acc;
#pragma unroll
                for (int rr = 0; rr < 16; ++rr) acc[rr] = c0;
#pragma unroll
                for (int ks = 0; ks < 4; ++ks) { const bf16x8 af = *(LAS const bf16x8*)(Ks + (32 * w + 32 * kt + ql) * KROW + ks * 32 + h * 16);
                    acc = __builtin_amdgcn_mfma_f32_32x32x16_bf16(af, qf[ks], acc, 0, 0, 0); }
#pragma unroll
                for (int rr = 0; rr < 16; ++rr) { const int c = (rr & 3) + 8 * (rr >> 2); float sv = acc[rr];
                    if (kt < 2) sv = fmaf(slope2, (float)(32 * kt - 64 + c), sv);
                    else if (kt > 2) sv = fmaf(-slope2, (float)(32 * kt - 64 + c), sv);
                    else sv = fmaf(-slope2, fabsf((float)c - (float)nb), sv);
                    if (kt == 0) sv = (c >= nb) ? sv : -1e30f;
                    if (kt == 4) sv = (c <= nb) ? sv : -1e30f;
                    acc[rr] = sv; mx = fmaxf(mx, sv); }
                sT[kt] = acc; } }
        { const auto rr_ = __builtin_amdgcn_permlane32_swap(__builtin_bit_cast(unsigned, mx), __builtin_bit_cast(unsigned, mx), false, false); mx = fmaxf(__builtin_bit_cast(float, (unsigned)rr_[0]), __builtin_bit_cast(float, (unsigned)rr_[1])); }
        float den = 0.f;
#pragma unroll
        for (int kt = 0; kt < 5; ++kt)
            if (tv[kt]) {
#pragma unroll
                for (int rr = 0; rr < 16; ++rr) { const float p = __builtin_amdgcn_exp2f(sT[kt][rr] - mx); sT[kt][rr] = p; den += p; } }
        { const auto rr_ = __builtin_amdgcn_permlane32_swap(__builtin_bit_cast(unsigned, den), __builtin_bit_cast(unsigned, den), false, false); den = __builtin_bit_cast(float, (unsigned)rr_[0]) + __builtin_bit_cast(float, (unsigned)rr_[1]); }
        f32x16 o[2]; o[0] = f32x16{}; o[1] = f32x16{};
        const int g4 = lane >> 4, i16 = lane & 15, qq = i16 >> 2, pp = i16 & 3;
        LAS const unsigned char* vb = Vs + (32 * w + 4 * h + qq) * KROW + (16 * (g4 & 1) + 4 * pp) * 2;
#pragma unroll
        for (int s2 = 0; s2 < 10; ++s2) { const int kt = s2 >> 1, rb = 8 * (s2 & 1);
            if (tv[kt]) {
            u32x4 pw; pw.x = cvtpk(sT[kt][rb + 0], sT[kt][rb + 1]); pw.y = cvtpk(sT[kt][rb + 2], sT[kt][rb + 3]); pw.z = cvtpk(sT[kt][rb + 4], sT[kt][rb + 5]); pw.w = cvtpk(sT[kt][rb + 6], sT[kt][rb + 7]);
            const bf16x8 pf = __builtin_bit_cast(bf16x8, pw);
#pragma unroll
            for (int ct = 0; ct < 2; ++ct) { const s16x4 lo = vtr(vb + (16 * s2) * KROW + ct * 64), hi4 = vtr(vb + (16 * s2 + 8) * KROW + ct * 64);
                const bf16x8 af = (bf16x8){lo[0], lo[1], lo[2], lo[3], hi4[0], hi4[1], hi4[2], hi4[3]};
                o[ct] = __builtin_amdgcn_mfma_f32_32x32x16_bf16(af, pf, o[ct], 0, 0, 0); } } }
        const float inv = 1.f / den;
        __syncthreads();
        LAS unsigned char* ost = Ks + w * (32 * KROW);
#pragma unroll
        for (int ct = 0; ct < 2; ++ct)
#pragma unroll
            for (int a4 = 0; a4 < 4; ++a4) { u32x2 wv2; wv2.x = cvtpk(o[ct][4 * a4] * inv, o[ct][4 * a4 + 1] * inv); wv2.y = cvtpk(o[ct][4 * a4 + 2] * inv, o[ct][4 * a4 + 3] * inv);
                *(LAS u32x2*)(ost + ql * KROW + (32 * ct + 8 * a4 + 4 * h) * 2) = wv2; }
        {   const int pos = ((q0 + 32 * w + ql) << sh) + r; const size_t t = (size_t)b * 2048 + pos;
            if (h == 0) LSE[t * 12 + hd] = 0.6931471805599453f * (mx + __builtin_amdgcn_logf(den)); }
        asm volatile("s_waitcnt lgkmcnt(0)" ::: "memory");
#pragma unroll
        for (int i = 0; i < 4; ++i) { const int qr = 8 * i + (lane >> 3), ch = lane & 7;
            const u32x4 v = *(LAS const u32x4*)(ost + qr * KROW + ch * 16);
            const size_t t = (size_t)b * 2048 + (((q0 + 32 * w + qr) << sh) + r);
            *(u32x4*)(ORAW + t * 768 + hd * 64 + ch * 8) = v; }
    }
    __syncthreads();
#undef ATT_UNIT
#undef ATT_LOAD
}
}
namespace mixp {
typedef short bf16x8 __attribute__((ext_vector_type(8)));
typedef unsigned u32x4 __attribute__((ext_vector_type(4)));
__device__ __forceinline__ void unpack8(const u32x4 v, float (&f)[8]) {
#pragma unroll
    for (int i = 0; i < 4; ++i) { f[2 * i] = __builtin_bit_cast(float, v[i] << 16); f[2 * i + 1] = __builtin_bit_cast(float, v[i] & 0xffff0000u); }
}
__device__ __forceinline__ void mix_phase(const Args& a, LAS unsigned char* lds, int gw, int NGW, int wave, int lane) {
    unsigned char* ws = a.ws;
    LAS float* al = (LAS float*)(lds + wave * 1024);
    constexpr int PROW = 528;
    LAS unsigned char* pst = lds + 8192 + wave * (32 * PROW);
    const bf16* P = (const bf16*)(ws + WS_P); const bf16* ORAW = (const bf16*)(ws + WS_ORAW); const float* LSE = (const float*)(ws + WS_LSE);
    bf16* MIXIN = (bf16*)(ws + WS_MIXIN); const bf16* WpT = (const bf16*)(ws + WS_WPT); const float* pool_scale = a.in[4];
    for (int u = gw; u < M / 16; u += NGW) {
        const int t0 = 16 * u;
#pragma unroll
        for (int j = 0; j < 3; ++j) { const int id = lane + 64 * j, tk = id / 12, hd = id % 12, s = hd & 3, g = hd >> 2;
            const float* lp = LSE + (size_t)(t0 + tk) * 12 + s; const float l0 = lp[0], l1 = lp[4], l2 = lp[8];
            const float mx = fmaxf(l0, fmaxf(l1, l2)); const float e0 = __expf(l0 - mx), e1 = __expf(l1 - mx), e2 = __expf(l2 - mx);
            al[id] = (g == 0 ? e0 : (g == 1 ? e1 : e2)) / (e0 + e1 + e2); }
        asm volatile("s_waitcnt lgkmcnt(0)" ::: "memory");
#pragma unroll 12
        for (int it = 0; it < 24; ++it) { const int id = lane + 64 * it, tk = id / 96, ch = id % 96, hd = ch >> 3;
            const u32x4 v = *(const u32x4*)(ORAW + (size_t)(t0 + tk) * 768 + ch * 8); const float alpha = al[tk * 12 + hd];
            float f[8]; unpack8(v, f); u32x4 o;
#pragma unroll
            for (int i = 0; i < 4; ++i) o[i] = pk2(f[2 * i] * alpha, f[2 * i + 1] * alpha);
            *(u32x4*)(MIXIN + (size_t)(t0 + tk) * D + 256 + ch * 8) = o; }
        asm volatile("s_waitcnt lgkmcnt(0)" ::: "memory");
        const int ti = lane & 15, kq = lane >> 4, pos = (t0 + ti) & 2047, b0 = t0 - (t0 & 2047);
#pragma unroll
        for (int j = 0; j < 16; ++j) { const int rr = 2 * j + (lane >> 5), ch = lane & 31; int tr = t0 - 8 + rr; tr = tr < b0 ? b0 : (tr > b0 + 2047 ? b0 + 2047 : tr);
            const u32x4 v = *(const u32x4*)(P + (size_t)tr * 256 + ch * 8); *(LAS u32x4*)(pst + rr * PROW + ch * 16) = v; }
        asm volatile("s_waitcnt lgkmcnt(0)" ::: "memory");
        f32x4 acc[4][4];
#pragma unroll
        for (int gi = 0; gi < 4; ++gi) { const int hw = 1 << gi;
#pragma unroll
            for (int dt = 0; dt < 4; ++dt) acc[gi][dt] = (f32x4){0.f, 0.f, 0.f, 0.f};
#pragma unroll
            for (int kk = 0; kk < 2; ++kk) { const int cg = 64 * gi + 32 * kk + 8 * kq;
                float sum[8]; int cnt = 0;
#pragma unroll
                for (int i = 0; i < 8; ++i) sum[i] = 0.f;
#pragma unroll
                for (int dj = -hw; dj < hw; ++dj) { const int p2 = pos + dj; const bool ok = (p2 >= 0) && (p2 < 2048);
                    const u32x4 v = *(LAS const u32x4*)(pst + (ti + 8 + dj) * PROW + cg * 2); float f[8]; unpack8(v, f);
                    if (ok) {
#pragma unroll
                        for (int i = 0; i < 8; ++i) sum[i] += f[i];
                        ++cnt; } }
                const u32x4 ov = *(LAS const u32x4*)(pst + (ti + 8) * PROW + cg * 2); float own[8]; unpack8(ov, own);
                const float rc = 1.f / (float)cnt; u32x4 aw;
#pragma unroll
                for (int i = 0; i < 4; ++i) aw[i] = pk2(sum[2 * i] * rc - own[2 * i], sum[2 * i + 1] * rc - own[2 * i + 1]);
                const bf16x8 af = __builtin_bit_cast(bf16x8, aw);
#pragma unroll
                for (int dt = 0; dt < 4; ++dt) { const bf16x8 bfr = *(const bf16x8*)(WpT + gi * 4096 + (16 * dt + ti) * 64 + 32 * kk + 8 * kq);
                    acc[gi][dt] = __builtin_amdgcn_mfma_f32_16x16x32_bf16(af, bfr, acc[gi][dt], 0, 0, 0); } } }
        asm volatile("s_waitcnt lgkmcnt(0)" ::: "memory");
#pragma unroll
        for (int gi = 0; gi < 4; ++gi)
#pragma unroll
            for (int dt = 0; dt < 4; ++dt) { const int d = 64 * gi + 16 * dt + ti; const float sc = pool_scale[d];
#pragma unroll
                for (int rg = 0; rg < 4; ++rg) { const float fv = acc[gi][dt][rg]; *(LAS unsigned short*)(pst + (4 * kq + rg) * PROW + d * 2) = (unsigned short)f2bf(fv * sc); } }
        asm volatile("s_waitcnt lgkmcnt(0)" ::: "memory");
#pragma unroll
        for (int j = 0; j < 8; ++j) { const int rr = 2 * j + (lane >> 5), ch = lane & 31;
            const u32x4 v = *(LAS const u32x4*)(pst + rr * PROW + ch * 16); *(u32x4*)(MIXIN + (size_t)(t0 + rr) * D + ch * 8) = v; }
        asm volatile("s_waitcnt lgkmcnt(0)" ::: "memory");
    }
}
}
namespace peer {
typedef unsigned u32x4 __attribute__((ext_vector_type(4)));
typedef unsigned u32x2 __attribute__((ext_vector_type(2)));
typedef int i32x4 __attribute__((ext_vector_type(4)));
constexpr int TOK_PER_BLK = 128, TOK_PER_WAVE = 16;
constexpr int L_SRT = 0, L_IDX = 0, L_ZW = 65536, L_XS = 65536, L_TOK = 131072, L_SS = 132096, L_TMP = 136192, L_XSUM = 136256;
constexpr size_t SLICE_BYTES = (size_t)NEXP * 128;
__device__ __forceinline__ float gelu_erf(float v) { return 0.5f * v * (1.f + erff(v * 0.70710678118654752f)); }
__device__ __forceinline__ int lane_xor1(int v) { return __builtin_amdgcn_mov_dpp(v, 0xB1, 0xF, 0xF, true); }
__device__ __forceinline__ int lane_xor2(int v) { return __builtin_amdgcn_mov_dpp(v, 0x4E, 0xF, 0xF, true); }
__device__ __forceinline__ int lane_hmirror(int v) { return __builtin_amdgcn_mov_dpp(v, 0x141, 0xF, 0xF, true); }
__device__ __forceinline__ float bf_lo(unsigned w) { return __builtin_bit_cast(float, w << 16); }
__device__ __forceinline__ float bf_hi(unsigned w) { return __builtin_bit_cast(float, w & 0xffff0000u); }

__device__ __forceinline__ void gather_phase(const Args& a, LAS unsigned char* lds, int vcu, int G, int wave, int lane) {
    unsigned char* ws = a.ws; float* out = a.out;
    const unsigned char* U8 = ws + WS_U8; const unsigned char* V8 = ws + WS_V8;
    const float* SU = (const float*)(ws + WS_SU); const float* SV = (const float*)(ws + WS_SV); const float* USUM = (const float*)(ws + WS_USUM);
    const unsigned short* IDX = (const unsigned short*)(ws + WS_IDX); const float* GATE = (const float*)(ws + WS_GATE);
    unsigned char* X8 = ws + WS_X8; const float* g_final = a.in[11];
    bf16* X2B = (bf16*)(ws + WS_XN);
    for (int tb = vcu; tb < M / TOK_PER_BLK; tb += G) {
        __syncthreads();
        const int T0 = tb * TOK_PER_BLK + wave * TOK_PER_WAVE, tl0 = wave * TOK_PER_WAVE;
        LAS unsigned short* idxl = (LAS unsigned short*)(lds + L_IDX) + tl0 * 128;
        LAS int* zw = (LAS int*)(lds + L_ZW) + tl0 * 128;
        LAS float* tokf = (LAS float*)(lds + L_TOK) + tl0 * 2;
        LAS float* ssl = (LAS float*)(lds + L_SS) + tl0 * 8;
        for (int tk4 = 0; tk4 < TOK_PER_WAVE; tk4 += 4) {
          u32x4 xbA[4], xbB[4];
#pragma unroll
          for (int u = 0; u < 4; ++u) { const int t = T0 + tk4 + u; xbA[u] = *(const u32x4*)(X2B + (size_t)t * D + 16 * lane); xbB[u] = *(const u32x4*)(X2B + (size_t)t * D + 16 * lane + 8); }
#pragma unroll
          for (int u = 0; u < 4; ++u) { const int tk = tk4 + u, t = T0 + tk;
            f32x4 x2[4]; float ss = 0.f, amax = 0.f;
            const u32x4 xb0 = xbA[u], xb1 = xbB[u];
#pragma unroll
            for (int j = 0; j < 4; ++j) { const unsigned w0 = (j < 2 ? xb0 : xb1)[2 * (j & 1)], w1 = (j < 2 ? xb0 : xb1)[2 * (j & 1) + 1];
                x2[j] = (f32x4){bf_lo(w0), bf_hi(w0), bf_lo(w1), bf_hi(w1)};
                ss += (x2[j].x * x2[j].x + x2[j].y * x2[j].y) + (x2[j].z * x2[j].z + x2[j].w * x2[j].w);
                amax = fmaxf(amax, fmaxf(fmaxf(fabsf(x2[j].x), fabsf(x2[j].y)), fmaxf(fabsf(x2[j].z), fabsf(x2[j].w)))); }
            ss = wave_sum(ss); amax = wave_max(amax);
            const float rstd = rsqrtf(ss * (1.f / D) + 1e-6f), inv = amax > 0.f ? 127.f / amax : 0.f, sx = amax * (1.f / 127.f);
            unsigned wh[2] = {0u, 0u}, wl[2] = {0u, 0u}; float xs_ = 0.f;
#pragma unroll
            for (int j = 0; j < 4; ++j) { const float f_[4] = {x2[j].x, x2[j].y, x2[j].z, x2[j].w};
#pragma unroll
                for (int c = 0; c < 4; ++c) { const float qf = rintf(f_[c] * inv) + 128.f; xs_ += qf; const unsigned q_ = (unsigned)(int)qf; const int sh = 4 * (4 * (j & 1) + c);
                    wh[j >> 1] |= (q_ >> 4) << sh; wl[j >> 1] |= (q_ & 15u) << sh; } }
            xs_ = wave_sum(xs_);
            { unsigned char* xp_ = X8 + (size_t)t * D + 256 * (lane >> 4) + 8 * (lane & 15);
              *(u32x2*)xp_ = (u32x2){wh[0], wh[1]}; *(u32x2*)(xp_ + 128) = (u32x2){wl[0], wl[1]}; }
            if (lane == 0) ((LAS float*)(lds + L_XSUM))[tl0 + tk] = xs_;
            if (lane < 8) ssl[tk * 8 + lane] = 0.f;
            if (lane == 0) { tokf[tk * 2] = sx * rstd; tokf[tk * 2 + 1] = 0.f; } } }
        asm volatile("s_waitcnt vmcnt(0) lgkmcnt(0)" ::: "memory");
        const int tid = wave * 64 + lane;
        const unsigned rot = (unsigned)(vcu & 31) * 64u + (unsigned)(vcu >> 5) * 8u;
        LAS unsigned* cnt = (LAS unsigned*)(lds + L_ZW);
        LAS unsigned* srt = (LAS unsigned*)(lds + L_SRT);
        const unsigned short* IDXb = IDX + (size_t)tb * TOK_PER_BLK * 128;
        const unsigned char* X8b = X8 + (size_t)tb * TOK_PER_BLK * D;
        {   u32x4 iv[4];
#pragma unroll
            for (int j = 0; j < 4; ++j) iv[j] = *(const u32x4*)(IDXb + 32 * tid + 8 * j);
#pragma unroll
            for (int j = 0; j < 4; ++j) *(LAS u32x4*)(lds + L_ZW + 8192 * j + 16 * tid) = (u32x4){0u, 0u, 0u, 0u};
            __syncthreads();
            unsigned er[32];
#pragma unroll
            for (int j = 0; j < 32; ++j) { const unsigned w_ = iv[j >> 3][(j >> 1) & 3]; const unsigned e = (j & 1) ? (w_ >> 16) : (w_ & 0xffffu); const unsigned ek = (e + rot) & 0x3fffu, sh = (ek & 1u) << 4;
                const unsigned old = __hip_atomic_fetch_add(cnt + (ek >> 1), 1u << sh, __ATOMIC_RELAXED, __HIP_MEMORY_SCOPE_WORKGROUP);
                er[j] = e | (((old >> sh) & 0xffffu) << 14); }
            __syncthreads();
            u32x4 cw[4]; unsigned tot = 0;
#pragma unroll
            for (int j = 0; j < 4; ++j) { cw[j] = *(LAS const u32x4*)(lds + L_ZW + 64 * tid + 16 * j);
#pragma unroll
                for (int i = 0; i < 4; ++i) tot += (cw[j][i] & 0xffffu) + (cw[j][i] >> 16); }
            unsigned inc = tot;
#pragma unroll
            for (int d = 1; d < 64; d <<= 1) { const unsigned t_ = (unsigned)__shfl_up((int)inc, d, 64); if (lane >= d) inc += t_; }
            LAS unsigned* tmp = (LAS unsigned*)(lds + L_TMP);
            if (lane == 63) tmp[wave] = inc;
            __syncthreads();
            unsigned run = inc - tot;
#pragma unroll
            for (int w_ = 0; w_ < 8; ++w_) { const unsigned t_ = tmp[w_]; if (w_ < wave) run += t_; }
#pragma unroll
            for (int j = 0; j < 4; ++j) {
#pragma unroll
                for (int i = 0; i < 4; ++i) { const unsigned w_ = cw[j][i]; const unsigned lo_ = run; run += w_ & 0xffffu; const unsigned hi_ = run; run += w_ >> 16; cw[j][i] = lo_ | (hi_ << 16); }
                *(LAS u32x4*)(lds + L_ZW + 64 * tid + 16 * j) = cw[j]; }
            __syncthreads();
#pragma unroll
            for (int j = 0; j < 32; ++j) { const unsigned e = er[j] & 0x3fffu, rank = er[j] >> 14, ek = (e + rot) & 0x3fffu; const unsigned w_ = cnt[ek >> 1]; const unsigned off = (w_ >> ((ek & 1u) << 4)) & 0xffffu;
                srt[off + rank] = (e << 14) | (unsigned)(32 * tid + j); }
            __syncthreads();
        }
        { const int g = lane >> 3, i8 = lane & 7;
#define PEER_ULOAD(buf, s, vp) do { const unsigned char* Us_ = U8 + (size_t)(s) * SLICE_BYTES;     const u32x4 ea_ = *(LAS const u32x4*)(srt_g + (vp) * 256), eb_ = *(LAS const u32x4*)(srt_g + (vp) * 256 + 16); \
            _Pragma("unroll") for (int it = 0; it < 8; ++it) { const unsigned en_ = it < 4 ? ea_[it] : eb_[it - 4]; buf[it] = *(const u32x4*)(Us_ + (((en_ >> 7) & 0x1fff80u) | lo16u)); } } while (0)
#define PEER_UCOMP(buf, s, vp) do { const u32x4 ea_ = *(LAS const u32x4*)(srt_g + (vp) * 256), eb_ = *(LAS const u32x4*)(srt_g + (vp) * 256 + 16); \
            LAS const unsigned char* xs_ = lds + L_XS + ((s) & 1) * 32768 + lo16u; int d_[8], a_[4], b_[2]; \
            _Pragma("unroll") for (int it = 0; it < 8; ++it) { const unsigned en_ = it < 4 ? ea_[it] : eb_[it - 4]; const unsigned xo_ = (en_ << 1) & 0x7f00u; \
                const u32x4 xh = *(LAS const u32x4*)(xs_ + xo_), xl = *(LAS const u32x4*)(xs_ + xo_ + 128); \
                unsigned ah = __builtin_amdgcn_udot8(buf[it].x, xh.x, 0u, false), al = __builtin_amdgcn_udot8(buf[it].x, xl.x, 0u, false); \
                ah = __builtin_amdgcn_udot8(buf[it].y, xh.y, ah, false); al = __builtin_amdgcn_udot8(buf[it].y, xl.y, al, false); \
                ah = __builtin_amdgcn_udot8(buf[it].z, xh.z, ah, false); al = __builtin_amdgcn_udot8(buf[it].z, xl.z, al, false); \
                ah = __builtin_amdgcn_udot8(buf[it].w, xh.w, ah, false); al = __builtin_amdgcn_udot8(buf[it].w, xl.w, al, false); \
                d_[it] = (int)((ah << 4) + al); } \
              \
              \
            _Pragma("unroll") for (int p = 0; p < 4; ++p) { const int keep = q2 ? d_[4 + p] : d_[p], send = q2 ? d_[p] : d_[4 + p]; a_[p] = keep + lane_hmirror(send); } \
            _Pragma("unroll") for (int p = 0; p < 2; ++p) { const int keep = q0 ? a_[2 * p + 1] : a_[2 * p], send = q0 ? a_[2 * p] : a_[2 * p + 1]; b_[p] = keep + lane_xor1(send); } \
            { const int keep = q1 ? b_[1] : b_[0], send = q1 ? b_[0] : b_[1]; zreg[vp] += keep + lane_xor2(send); } } while (0)
        {   const bool q0 = lane & 1, q1 = lane & 2, q2 = lane & 4; const unsigned lo16u = (unsigned)i8 << 4;
            LAS const unsigned char* srt_g = lds + L_SRT + (wave * 2048 + 8 * g) * 4;
            const unsigned char* xsrc = X8b + (size_t)(tl0 + (lane >> 4)) * D + 16 * (lane & 15);
#define PEER_XSTAGE(s, b) do { _Pragma("unroll") for (int i_ = 0; i_ < 4; ++i_) \
                __builtin_amdgcn_global_load_lds((const GAS unsigned*)(xsrc + (size_t)(4 * i_) * D + 256 * (s)), (LAS unsigned*)(lds + L_XS + (b) * 32768 + (tl0 + 4 * i_) * 256), 16, 0, 0); } while (0)
            PEER_XSTAGE(0, 0);
            int zreg[32];
#pragma unroll
            for (int vp = 0; vp < 32; ++vp) zreg[vp] = 0;
            u32x4 u0[8], u1[8];
            PEER_ULOAD(u0, 0, 0);
            asm volatile("s_waitcnt vmcnt(0) lgkmcnt(0)\n\ts_barrier" ::: "memory");
            for (int s = 0; s < 4; ++s) {
                const int sn = s + 1 < 4 ? s + 1 : 3;
                PEER_XSTAGE(sn, (s + 1) & 1);
#pragma unroll
                for (int vp = 0; vp < 32; vp += 2) {
                    PEER_ULOAD(u1, s, vp + 1); PEER_UCOMP(u0, s, vp);
                    if (vp + 2 < 32) PEER_ULOAD(u0, s, vp + 2); else PEER_ULOAD(u0, sn, 0);
                    PEER_UCOMP(u1, s, vp + 1);
                }
                asm volatile("s_waitcnt vmcnt(8) lgkmcnt(0)\n\ts_barrier" ::: "memory");
            }
#pragma unroll
            for (int vp = 0; vp < 32; ++vp) { const unsigned en = *(LAS const unsigned*)(lds + L_SRT + (wave * 2048 + 64 * vp + lane) * 4); ((LAS int*)(lds + L_ZW))[en & 0x3fffu] = zreg[vp]; }
            asm volatile("s_waitcnt lgkmcnt(0)\n\ts_barrier" ::: "memory");
            {   u32x4 iv[4];
#pragma unroll
                for (int j = 0; j < 4; ++j) iv[j] = *(const u32x4*)(IDXb + (size_t)tl0 * 128 + 32 * lane + 8 * j);
#pragma unroll
                for (int j = 0; j < 4; ++j) *(LAS u32x4*)((LAS unsigned char*)idxl + 64 * lane + 16 * j) = iv[j]; }
        }
#undef PEER_ULOAD
#undef PEER_UCOMP
#undef PEER_XSTAGE
        }
        asm volatile("s_waitcnt lgkmcnt(0)" ::: "memory");
        for (int tk = 0; tk < TOK_PER_WAVE; ++tk) { const int t = T0 + tk; const float cs = tokf[tk * 2]; const float xsum_t = ((LAS const float*)(lds + L_XSUM))[tl0 + tk];
            float w[2];
#pragma unroll
            for (int hf = 0; hf < 2; ++hf) { const int k = lane + 64 * hf; const unsigned e = idxl[tk * 128 + k];
                const float z = (float)(zw[tk * 128 + k] - 128 * (int)USUM[e] - 8 * (int)xsum_t + 1048576) * (SU[e] * cs);
                w[hf] = GATE[(size_t)t * 128 + k] * gelu_erf(z) * SV[e]; }
            const float wm = wave_max(fmaxf(fabsf(w[0]), fabsf(w[1]))), winv = wm > 0.f ? 127.f / wm : 0.f;
            asm volatile("s_waitcnt lgkmcnt(0)" ::: "memory");
            LAS signed char* wpb = (LAS signed char*)(zw + tk * 128);
            wpb[lane] = (signed char)(int)rintf(w[0] * winv); wpb[64 + lane] = (signed char)(int)rintf(w[1] * winv);
            if (lane == 0) tokf[tk * 2 + 1] = wm * (1.f / 127.f); }
        asm volatile("s_waitcnt lgkmcnt(0)" ::: "memory");
        {   const int g = lane >> 3, i8 = lane & 7; const unsigned lo16 = (unsigned)i8 << 4;
#define PEER_DLOAD(QB, WP, qi) do { const int s_ = (qi) >> 6, tok_ = 8 * (((qi) >> 5) & 1) + g, q_ = (qi) & 31; \
            const u32x2 id_ = *(LAS const u32x2*)(idxl + tok_ * 128 + 4 * q_); WP = zw[tok_ * 128 + q_]; const unsigned char* Vs_ = V8 + (size_t)s_ * SLICE_BYTES; \
            QB[0] = *(const u32x4*)(Vs_ + (((id_.x << 7) & 0x7fff80u) | lo16)); QB[1] = *(const u32x4*)(Vs_ + (((id_.x >> 9) & 0x7fff80u) | lo16)); \
            QB[2] = *(const u32x4*)(Vs_ + (((id_.y << 7) & 0x7fff80u) | lo16)); QB[3] = *(const u32x4*)(Vs_ + (((id_.y >> 9) & 0x7fff80u) | lo16)); } while (0)
#define PEER_DACC(QB, WP) do { \
            _Pragma("unroll") for (int j = 0; j < 4; ++j) { const unsigned A_ = QB[0][j], B_ = QB[1][j], C_ = QB[2][j], D_ = QB[3][j]; \
                const unsigned t0 = __builtin_amdgcn_perm(B_, A_, 0x05010400u), t1 = __builtin_amdgcn_perm(B_, A_, 0x07030602u); \
                const unsigned u0 = __builtin_amdgcn_perm(D_, C_, 0x05010400u), u1 = __builtin_amdgcn_perm(D_, C_, 0x07030602u); \
                acc[4 * j + 0] = __builtin_amdgcn_sdot4((int)__builtin_amdgcn_perm(u0, t0, 0x05040100u), WP, acc[4 * j + 0], false); \
                acc[4 * j + 1] = __builtin_amdgcn_sdot4((int)__builtin_amdgcn_perm(u0, t0, 0x07060302u), WP, acc[4 * j + 1], false); \
                acc[4 * j + 2] = __builtin_amdgcn_sdot4((int)__builtin_amdgcn_perm(u1, t1, 0x05040100u), WP, acc[4 * j + 2], false); \
                acc[4 * j + 3] = __builtin_amdgcn_sdot4((int)__builtin_amdgcn_perm(u1, t1, 0x07060302u), WP, acc[4 * j + 3], false); } } while (0)
#define PEER_DX2(qi) do { const int s_ = (qi) >> 6, tok_ = 8 * (((qi) >> 5) & 1) + g; const bf16* xp_ = X2B + (size_t)(T0 + tok_) * D + 128 * s_ + 16 * i8; \
            x2a = *(const u32x4*)xp_; x2b = *(const u32x4*)(xp_ + 8); } while (0)
#define PEER_DFIN(qi) do { const int s_ = (qi) >> 6, tok_ = 8 * (((qi) >> 5) & 1) + g; const float wsc = tokf[tok_ * 2 + 1]; float ssq = 0.f; u32x4 oa, ob; \
            _Pragma("unroll") for (int j = 0; j < 4; ++j) { const unsigned w_ = x2a[j]; const float f0 = bf_lo(w_) + (float)acc[2 * j] * wsc, f1 = bf_hi(w_) + (float)acc[2 * j + 1] * wsc; ssq += f0 * f0 + f1 * f1; oa[j] = pk2(f0, f1); } \
            _Pragma("unroll") for (int j = 0; j < 4; ++j) { const unsigned w_ = x2b[j]; const float f0 = bf_lo(w_) + (float)acc[8 + 2 * j] * wsc, f1 = bf_hi(w_) + (float)acc[8 + 2 * j + 1] * wsc; ssq += f0 * f0 + f1 * f1; ob[j] = pk2(f0, f1); } \
            bf16* xp_ = X2B + (size_t)(T0 + tok_) * D + 128 * s_ + 16 * i8; *(u32x4*)xp_ = oa; *(u32x4*)(xp_ + 8) = ob; \
            __hip_atomic_fetch_add(ssl + tok_ * 8 + i8, ssq, __ATOMIC_RELAXED, __HIP_MEMORY_SCOPE_WORKGROUP); } while (0)
            u32x4 q0[4], q1[4], q2[4], q3[4], q4[4], q5[4], q6[4], q7[4], x2a, x2b; int w0, w1, w2, w3, w4, w5, w6, w7, acc[16];
            PEER_DLOAD(q0, w0, 0); PEER_DLOAD(q1, w1, 1); PEER_DLOAD(q2, w2, 2); PEER_DLOAD(q3, w3, 3); PEER_DLOAD(q4, w4, 4); PEER_DLOAD(q5, w5, 5); PEER_DLOAD(q6, w6, 6);
            for (int i = 0; i < 512 / 8 - 1; ++i) {
                const int qi = 8 * i;
                if ((i & 3) == 0) {
#pragma unroll
                    for (int c = 0; c < 16; ++c) acc[c] = 0; }
                if ((i & 3) == 3) PEER_DX2(qi);
                PEER_DLOAD(q7, w7, qi + 7); PEER_DACC(q0, w0); PEER_DLOAD(q0, w0, qi + 8); PEER_DACC(q1, w1); PEER_DLOAD(q1, w1, qi + 9); PEER_DACC(q2, w2); PEER_DLOAD(q2, w2, qi + 10); PEER_DACC(q3, w3); PEER_DLOAD(q3, w3, qi + 11); PEER_DACC(q4, w4); PEER_DLOAD(q4, w4, qi + 12); PEER_DACC(q5, w5); PEER_DLOAD(q5, w5, qi + 13); PEER_DACC(q6, w6); PEER_DLOAD(q6, w6, qi + 14); PEER_DACC(q7, w7);
                if ((i & 3) == 3) PEER_DFIN(qi);
            }
            PEER_DX2(504); PEER_DLOAD(q7, w7, 511); PEER_DACC(q0, w0); PEER_DACC(q1, w1); PEER_DACC(q2, w2); PEER_DACC(q3, w3); PEER_DACC(q4, w4); PEER_DACC(q5, w5); PEER_DACC(q6, w6); PEER_DACC(q7, w7); PEER_DFIN(504);
#undef PEER_DLOAD
#undef PEER_DACC
#undef PEER_DX2
#undef PEER_DFIN
#undef PEER_DSTEP
        }
        asm volatile("s_waitcnt vmcnt(0) lgkmcnt(0)" ::: "memory");
        {   f32x4 gg[4];
#pragma unroll
            for (int j = 0; j < 4; ++j) gg[j] = ((const f32x4*)g_final)[lane + 64 * j];
            for (int tk4 = 0; tk4 < TOK_PER_WAVE; tk4 += 4) { u32x2 xb[4][4];
#pragma unroll
                for (int u = 0; u < 4; ++u)
#pragma unroll
                    for (int j = 0; j < 4; ++j) xb[u][j] = *(const u32x2*)(X2B + (size_t)(T0 + tk4 + u) * D + 4 * (lane + 64 * j));
#pragma unroll
                for (int u = 0; u < 4; ++u) { const int tk = tk4 + u, t = T0 + tk;
                    float sq = ssl[tk * 8 + (lane & 7)]; sq += dpp_mov<0xB1>(sq); sq += dpp_mov<0x4E>(sq); sq += dpp_mov<0x141>(sq);
                    const float r3 = rsqrtf(sq * (1.f / D) + 1e-6f);
#pragma unroll
                    for (int j = 0; j < 4; ++j) { const u32x2 w_ = xb[u][j]; const f32x4 x3 = (f32x4){bf_lo(w_.x), bf_hi(w_.x), bf_lo(w_.y), bf_hi(w_.y)};
                        *((f32x4*)(out + (size_t)t * D) + lane + 64 * j) = x3 * gg[j] * r3; } } } }
    }
}
}
namespace topk {
typedef short bf16x8 __attribute__((ext_vector_type(8)));
typedef float f32x16 __attribute__((ext_vector_type(16)));
typedef unsigned u32x4 __attribute__((ext_vector_type(4)));
constexpr int SKROW = 272;
__device__ __forceinline__ float fmax_(float a, float b) { float t; asm("v_max_f32 %0, %1, %2" : "=v"(t) : "v"(a), "v"(b)); return t; }
__device__ __forceinline__ void cswap(float& a, float& b) { float t, u; asm("v_max_f32 %0, %1, %2" : "=v"(t) : "v"(a), "v"(b)); asm("v_min_f32 %0, %1, %2" : "=v"(u) : "v"(a), "v"(b)); a = t; b = u; }
__device__ __forceinline__ void merge16(float (&c)[16]) {
#pragma unroll
    for (int j = 8; j > 0; j >>= 1)
#pragma unroll
        for (int i = 0; i < 16; ++i) { const int l = i ^ j; if (l > i) cswap(c[i], c[l]); }
}
__device__ __forceinline__ void sort16(float (&v)[16]) {
    constexpr int SA[60] = {0,1,2,3,4,5,7,9, 0,1,2,3,6,8,10,11, 0,2,4,6,7,10,12,14, 0,1,4,5,6,8,12,13, 1,3,4,5,8,9,13, 1,2,5,7,9,11, 2,3,9,11, 3,6,7,10, 3,5,7,9,11, 6,8};
    constexpr int SB[60] = {13,12,15,14,8,6,11,10, 5,7,9,4,13,14,15,12, 1,3,5,8,9,11,13,15, 2,3,10,11,7,9,14,15, 2,12,6,7,10,11,14, 4,6,8,10,13,14, 4,6,12,13, 5,8,9,12, 4,6,8,10,12, 7,9};
#pragma unroll
    for (int i = 0; i < 60; ++i) cswap(v[SA[i]], v[SB[i]]);
}
__device__ __forceinline__ void topmerge(float (&a)[16], const float (&b)[16]) {
#pragma unroll
    for (int i = 0; i < 16; ++i) a[i] = fmax_(a[i], b[15 - i]);
    merge16(a);
}
__device__ __forceinline__ void insert16(float (&a)[16], float x) {
#pragma unroll
    for (int i = 0; i < 16; ++i) cswap(a[i], x);
}
__device__ __forceinline__ float cand(float a, float b, unsigned ca, unsigned cb) { return __builtin_bit_cast(float, (__builtin_bit_cast(unsigned, a + b) & ~0x3fffu) | ca | cb); }

__device__ __forceinline__ void qhalf_load(u32x4 (&q)[8], const bf16* QPw, int lane) {
#pragma unroll
    for (int j = 0; j < 8; ++j) q[j] = *(const u32x4*)(QPw + (size_t)(4 * j + (lane >> 4)) * NQ + (lane & 15) * 8);
}
__device__ __forceinline__ void qhalf_stage(const u32x4 (&q)[8], LAS unsigned char* qst, int lane) {
#pragma unroll
    for (int j = 0; j < 8; ++j) *(LAS u32x4*)(qst + (4 * j + (lane >> 4)) * SKROW + (lane & 15) * 16) = q[j];
}
__device__ __forceinline__ void half_top16(float (&e)[16], LAS const unsigned char* qst, LAS const unsigned char* sk, int ql, int hh) {
    unsigned qoff = (unsigned)(ql * SKROW + hh * 16);
    float m0[16], m1[16];
#pragma unroll
    for (int kt = 0; kt < 4; ++kt) { f32x16 acc = {}; float v[16];
        asm volatile("" : "+v"(qoff));
#pragma unroll
        for (int ks = 0; ks < 8; ++ks) { const bf16x8 af = *(LAS const bf16x8*)(sk + (32 * kt + ql) * SKROW + ks * 32 + hh * 16);
            const bf16x8 bfr = *(LAS const bf16x8*)(qst + qoff + ks * 32);
            acc = __builtin_amdgcn_mfma_f32_32x32x16_bf16(af, bfr, acc, 0, 0, 0); }
#pragma unroll
        for (int rr = 0; rr < 16; ++rr) { const unsigned key = (unsigned)(32 * kt + (rr & 3) + 8 * (rr >> 2)) + 4u * (unsigned)hh;
            const float fv = acc[rr];
            v[rr] = __builtin_bit_cast(float, (__builtin_bit_cast(unsigned, fv) & ~0x7fu) | key); }
        sort16(v);
        if (kt == 0) {
#pragma unroll
            for (int i = 0; i < 16; ++i) m0[i] = v[i]; }
        else if (kt == 1) topmerge(m0, v);
        else if (kt == 2) {
#pragma unroll
            for (int i = 0; i < 16; ++i) m1[i] = v[i]; }
        else topmerge(m1, v); }
    topmerge(m0, m1);
#pragma unroll
    for (int i = 0; i < 16; ++i) { const unsigned x = __builtin_bit_cast(unsigned, m0[15 - i]);
        const auto rr = __builtin_amdgcn_permlane32_swap(x, x, false, false);
        const unsigned lo_ = rr[0], hi_ = rr[1];
        e[i] = fmax_(m0[i], __builtin_bit_cast(float, hh ? lo_ : hi_)); }
    merge16(e);
}

__device__ __forceinline__ void topk_phase(const Args& a, LAS unsigned char* lds, int bx, int G, int tid) {
    unsigned char* ws = a.ws;
    const int lane = tid & 63, wave = __builtin_amdgcn_readfirstlane(tid >> 6);
    const bf16* QP = (const bf16*)(ws + WS_QP); const bf16* SK = (const bf16*)(ws + WS_SK);
    unsigned short* IDX = (unsigned short*)(ws + WS_IDX); float* GATE = (float*)(ws + WS_GATE);
    const float* pu = a.in[9]; const float* pv = a.in[10]; const float* g_ffn = a.in[6];
    unsigned char* U4 = ws + WS_U8; signed char* V8 = (signed char*)(ws + WS_V8); float* SU = (float*)(ws + WS_SU); float* SV = (float*)(ws + WS_SV); float* USUM = (float*)(ws + WS_USUM);
    pg8::StaticOrder So; So.init(M, NQ, G, bx); pg8::Unit un;
    int h_staged = -1;
    int nun = 0; while (So.next(nun, un)) ++nun;
    const int ne = (nun + 1) >> 1;
    LAS unsigned char* qst = lds + 256 * SKROW + wave * (32 * SKROW);
    u32x4 qa[8], qb[8];
    if (nun > 0) { So.next(0, un); qhalf_load(qa, QP + (size_t)(256 * un.pm + 32 * wave) * NQ + un.pn * 256, lane); }
    for (int uo = 0; uo < nun; ++uo) {
        const int ui = uo < ne ? 2 * uo : 2 * (uo - ne) + 1; So.next(ui, un);
        const int h = un.pn, tt = un.pm;
        int lane_ = lane; asm volatile("" : "+v"(lane_));
        const int ql = lane_ & 31, hh = lane_ >> 5, tid_ = wave * 64 + lane_;
        const int er0 = ((ui * G + bx) * 8 + wave) * 2;
        if (h != h_staged) {
            __syncthreads();
#pragma unroll
            for (int j = 0; j < 8; ++j) { const int id = tid_ + 512 * j, row = id >> 4, ch = id & 15;
                const u32x4 v = *(const u32x4*)(SK + ((size_t)h * 256 + row) * 128 + ch * 8); *(LAS u32x4*)(lds + row * SKROW + ch * 16) = v; }
            __syncthreads(); h_staged = h;
        }
        const int t = 256 * tt + 32 * wave + ql;
        const bf16* QPw = QP + (size_t)(256 * tt + 32 * wave) * NQ + h * 256;
        float A[16], B[16];
        f32x4 rw[4];
        qhalf_stage(qa, qst, lane_);
        qhalf_load(qb, QPw + 128, lane_);
        quant_row_load(pu + (size_t)er0 * D, rw, lane_);
        half_top16(A, qst, lds, ql, hh);
        quant_row_finish_u4(rw, g_ffn, U4 + (size_t)er0 * 128, SU + er0, USUM + er0, lane_);
        qhalf_stage(qb, qst, lane_);
        if (uo + 1 < nun) { const int un_ = uo + 1, ui2 = un_ < ne ? 2 * un_ : 2 * (un_ - ne) + 1; pg8::Unit u2; So.next(ui2, u2);
            qhalf_load(qa, QP + (size_t)(256 * u2.pm + 32 * wave) * NQ + u2.pn * 256, lane_); }
        quant_row_load(pv + (size_t)er0 * D, rw, lane_);
        half_top16(B, qst, lds + 128 * SKROW, ql, hh);
        quant_row_finish(rw, nullptr, V8 + (size_t)er0 * 128, SV + er0, lane_);
        f32x4 rw2[4];
        quant_row_load(pu + (size_t)(er0 + 1) * D, rw, lane_); quant_row_load(pv + (size_t)(er0 + 1) * D, rw2, lane_);
        unsigned ca[16], cb[16];
#pragma unroll
        for (int i = 0; i < 16; ++i) { ca[i] = (__builtin_bit_cast(unsigned, A[i]) & 0x7fu) << 7; cb[i] = __builtin_bit_cast(unsigned, B[i]) & 0x7fu; }
        float X0[16], X1[16], X2[16];
#pragma unroll
        for (int j = 0; j < 16; ++j) X0[j] = cand(A[0], B[j], ca[0], cb[j]);
#pragma unroll
        for (int j = 0; j < 8; ++j) X1[j] = cand(A[1], B[j], ca[1], cb[j]);
#pragma unroll
        for (int j = 0; j < 5; ++j) X1[8 + j] = cand(A[2], B[j], ca[2], cb[j]);
#pragma unroll
        for (int j = 0; j < 3; ++j) X1[13 + j] = cand(A[4], B[j], ca[4], cb[j]);
#pragma unroll
        for (int j = 0; j < 4; ++j) X2[j] = cand(A[3], B[j], ca[3], cb[j]);
#pragma unroll
        for (int i = 5; i < 8; ++i)
#pragma unroll
            for (int j = 0; j < 2; ++j) X2[4 + 2 * (i - 5) + j] = cand(A[i], B[j], ca[i], cb[j]);
#pragma unroll
        for (int i = 8; i < 14; ++i) X2[10 + (i - 8)] = cand(A[i], B[0], ca[i], cb[0]);
        const float x14 = cand(A[14], B[0], ca[14], cb[0]), x15 = cand(A[15], B[0], ca[15], cb[0]);
        sort16(X1); sort16(X2);
        topmerge(X1, X2); topmerge(X0, X1); insert16(X0, x14); insert16(X0, x15);
        float sc[16]; float den = 0.f;
#pragma unroll
        for (int i = 0; i < 16; ++i) { sc[i] = __builtin_bit_cast(float, __builtin_bit_cast(unsigned, X0[i]) & ~0x3fffu); }
        const float m0 = sc[0];
#pragma unroll
        for (int i = 0; i < 16; ++i) { sc[i] = __expf(sc[i] - m0); den += sc[i]; }
        const float rd = 1.f / den;
        if (hh == 0) { u32x4 w0, w1;
#pragma unroll
            for (int i = 0; i < 4; ++i) { w0[i] = (__builtin_bit_cast(unsigned, X0[2 * i]) & 0x3fffu) | ((__builtin_bit_cast(unsigned, X0[2 * i + 1]) & 0x3fffu) << 16);
                w1[i] = (__builtin_bit_cast(unsigned, X0[8 + 2 * i]) & 0x3fffu) | ((__builtin_bit_cast(unsigned, X0[8 + 2 * i + 1]) & 0x3fffu) << 16); }
            u32x4* ip = (u32x4*)(IDX + (size_t)t * 128 + h * 16); ip[0] = w0; ip[1] = w1;
        } else { f32x4* gp = (f32x4*)(GATE + (size_t)t * 128 + h * 16);
#pragma unroll
            for (int i = 0; i < 4; ++i) gp[i] = (f32x4){sc[4 * i] * rd, sc[4 * i + 1] * rd, sc[4 * i + 2] * rd, sc[4 * i + 3] * rd}; }
        quant_row_finish_u4(rw, g_ffn, U4 + (size_t)(er0 + 1) * 128, SU + er0 + 1, USUM + er0 + 1, lane_); quant_row_finish(rw2, nullptr, V8 + (size_t)(er0 + 1) * 128, SV + er0 + 1, lane_);
    }
    __syncthreads();
}
}
__global__ void __launch_bounds__(NWAVES * 64, 2) mega_fwd(Args a) {
    extern __shared__ __attribute__((aligned(16))) unsigned char lds_raw[];
    LAS unsigned char* lds = (LAS unsigned char*)lds_raw;
    volatile LAS unsigned* MISC = (volatile LAS unsigned*)(lds + MISC_OFF);
    const int wave = __builtin_amdgcn_readfirstlane((int)threadIdx.x >> 6);
#define TID_NOW (wave * 64 + lane_now())
    const int G = gridDim.x, bx = blockIdx.x, vcu = (G % 8 == 0) ? (bx % 8) * (G / 8) + bx / 8 : bx;
    unsigned char* ws = a.ws;
    if (threadIdx.x < 32) ((LAS unsigned*)(lds + LDSCTL_OFF))[threadIdx.x] = 0u;
    __syncthreads();
    XcdBarrier bar = xcd_barrier_post((unsigned*)(ws + WS_CTL) + CW_BAR + a.li * XCD_BAR_WORDS, MISC + 8);
    const int lo = a.ph_lo, hi = a.ph_hi;
#define IN(k) (lo <= (k) && (k) < hi)
#define BOTH(k) (IN(k) && IN((k) + 1))
    if (IN(0)) { p0_prologue(a, lds, vcu * NWAVES + wave, G * NWAVES, wave, lane_now()); if (BOTH(0)) xcd_barrier(bar, wave); }
    if (IN(1)) {
        pg8::Gemm g{(const bf16*)(ws + WS_XN), (const bf16*)(ws + WS_WIN), M, NPROJ, D / 2}; pg8::StaticOrder So; So.init(M, NPROJ, G, bx);
        pg8::EpiInProj E{(bf16*)(ws + WS_P), (bf16*)(ws + WS_Q), (size_t)(WS_K - WS_Q) / 2, (const float*)(ws + WS_SA), (const float*)(ws + WS_SWIN)};
        pg8::gemm_phase<pg8::EpiInProj, pg8::StaticOrder, true, true, true>(lds, g, So, E, wave);
        if (BOTH(1)) xcd_barrier(bar, wave);
    }
    if (IN(2)) { attn::attn_phase(ws, lds, vcu, G, TID_NOW); if (BOTH(2)) xcd_barrier(bar, wave); }
    if (IN(3)) { mixp::mix_phase(a, lds, vcu * NWAVES + wave, G * NWAVES, wave, lane_now()); if (BOTH(3)) xcd_barrier(bar, wave); }
    if (IN(4)) {
        pg8::Gemm g{(const bf16*)(ws + WS_MIXIN), (const bf16*)(ws + WS_WOUT), M, D, D}; pg8::StaticOrder So; So.init(M, D, G, bx);
        pg8::EpiOutProj E{a.in[0], (bf16*)(ws + WS_XN), (float*)(ws + WS_ROWSS)};
        pg8::gemm_phase<pg8::EpiOutProj, pg8::StaticOrder, true, true>(lds, g, So, E, wave);
        if (BOTH(4)) xcd_barrier(bar, wave);
    }
    if (IN(5)) {
        pg8::Gemm g{(const bf16*)(ws + WS_XN), (const bf16*)(ws + WS_WQ), M, NQ, D}; pg8::StaticOrder So; So.init(M, NQ, G, bx);
        pg8::EpiPeerQ E{(bf16*)(ws + WS_QP), (const float*)(ws + WS_ROWSS)};
        pg8::gemm_phase<pg8::EpiPeerQ, pg8::StaticOrder, true, true>(lds, g, So, E, wave);
    }
    if (IN(6)) { topk::topk_phase(a, lds, bx, G, TID_NOW); if (BOTH(6)) xcd_barrier(bar, wave); }
    if (IN(7)) { peer::gather_phase(a, lds, vcu, G, wave, lane_now()); }
#undef IN
#undef BOTH
#undef TID_NOW
}
extern "C" void kernel_launch(void* const* d_in, const int* in_sizes, int n_in, void* d_out, int out_size, void* d_ws, size_t ws_size, hipStream_t stream) {
    static int grid = 0;
    if (grid == 0) {
        if (n_in != 12 || in_sizes[0] != M * D || out_size != M * D || ws_size < WS_END) { fprintf(stderr, "kernel_launch: unexpected shapes (n_in %d, in0 %d, out %d, ws %zu)\n", n_in, n_in > 0 ? in_sizes[0] : -1, out_size, ws_size); grid = -1; return; }
        int dev = 0, cus = 0, per_cu = 0;
        if (hipGetDevice(&dev) != hipSuccess || hipDeviceGetAttribute(&cus, hipDeviceAttributeMultiprocessorCount, dev) != hipSuccess) { fprintf(stderr, "kernel_launch: device query failed\n"); grid = -1; return; }
        if (hipFuncSetAttribute((const void*)mega_fwd, hipFuncAttributeMaxDynamicSharedMemorySize, LDS_BYTES) != hipSuccess) { fprintf(stderr, "kernel_launch: hipFuncSetAttribute failed\n"); grid = -1; return; }
        if (hipOccupancyMaxActiveBlocksPerMultiprocessor(&per_cu, (const void*)mega_fwd, NWAVES * 64, LDS_BYTES) != hipSuccess || per_cu < 1) { fprintf(stderr, "kernel_launch: occupancy query says %d blocks per CU\n", per_cu); grid = -1; (void)hipGetLastError(); return; }
        grid = cus;
    }
    if (grid < 0) return;
    (void)hipMemsetAsync((char*)d_ws + WS_CTL + CW_BAR * 4, 0, (CW_END - CW_BAR) * 4, stream);
    Args a{};
    for (int i = 0; i < 12; ++i) a.in[i] = (const float*)d_in[i];
    a.out = (float*)d_out; a.ws = (unsigned char*)d_ws; a.ph_lo = 0; a.ph_hi = 8; a.li = 0;
    hipLaunchKernelGGL(mega_fwd, dim3(grid), dim3(NWAVES * 64), LDS_BYTES, stream, a);
#ifdef PROBE_LO
    a.ph_lo = PROBE_LO; a.ph_hi = PROBE_HI; a.li = 1;
    hipLaunchKernelGGL(mega_fwd, dim3(grid), dim3(NWAVES * 64), LDS_BYTES, stream, a);
#endif
}
```

```cpp
#include <hip/hip_runtime.h>
#include <cstdio>
#include <cstdint>
__device__ __forceinline__ int lane_now() { int l; asm volatile("v_mbcnt_lo_u32_b32 %0, -1, 0\n\tv_mbcnt_hi_u32_b32 %0, -1, %0" : "=v"(l)); return l; }
namespace pg8 {
#define PG8_LAS __attribute__((address_space(3)))
typedef unsigned short bf16_t;
typedef short bf16x8 __attribute__((ext_vector_type(8)));
typedef float f32x4 __attribute__((ext_vector_type(4)));
typedef unsigned u32x4 __attribute__((ext_vector_type(4)));
typedef int i32x4 __attribute__((ext_vector_type(4)));
constexpr int BM = 256, BK = 64, HALF = 128, HTB = HALF * BK * 2  , STAGE_BYTES = 8 * HTB, NXCD = 8, WGM = 8;

__host__ __device__ __forceinline__ int lds_byte(int r, int c) { const int st = (r >> 4) * 2 + (c >> 5), rr = r & 15, cc = c & 31, ob = rr * 64 + cc * 2; return st * 1024 + (ob ^ (((ob >> 9) & 1) << 5)); }
__host__ __device__ __forceinline__ void stage_rc(int b, int& R, int& C) { const int st = b / 1024, sb = b % 1024, swz = sb ^ (((sb >> 9) & 1) << 5); R = (st >> 1) * 16 + swz / 64; C = (st & 1) * 32 + (swz % 64) / 2; }
__host__ __device__ __forceinline__ int perm32(int rho) { const int n = rho >> 4, i = rho & 15; return 8 * (i >> 2) + 4 * n + (i & 3); }

struct Unit { int pm, pn; };
struct Gemm { const bf16_t* A; const bf16_t* Bt; int M, N, K; };

struct StaticOrder {
    int nM, nN, nwg, G, c;
    __host__ __device__ void init(int M, int N, int G_, int c_) { nM = M / BM; nN = N / BM; nwg = nM * nN; G = G_; c = c_; }
    __host__ __device__ bool next(int i, Unit& u) const {
        const long L = (long)i * G + c; if (L >= nwg) return false;
        int wgid = (int)L; { const int q = nwg / NXCD, r = nwg % NXCD, xcd = wgid % NXCD, off = wgid / NXCD; wgid = (xcd < r ? xcd * (q + 1) : r * (q + 1) + (xcd - r) * q) + off; }
        const int nig = WGM * nN, gid = wgid / nig, fm = gid * WGM, gsz = (nM - fm) < WGM ? (nM - fm) : WGM;
        u.pm = fm + ((wgid % nig) % gsz); u.pn = (wgid % nig) / gsz; return true;
    }
    __device__ __forceinline__ void a_ready(const Unit&) const {}
    __device__ __forceinline__ void done(const Unit&) const {}
};

__device__ __forceinline__ unsigned cvt_pk_bf16(float lo, float hi) { unsigned r; asm volatile("v_cvt_pk_bf16_f32 %0, %1, %2" : "=v"(r) : "v"(lo), "v"(hi)); return r; }
typedef unsigned u32x2 __attribute__((ext_vector_type(2)));
constexpr float C2Q = 0.125f * 1.4426950408889634f;
struct EpiInProj {
    static constexpr bool PERM = true, AFTER_DRAIN = false;
    bf16_t* P; bf16_t* QKV; size_t ty_stride; const float* sa; const float* sw;
    __device__ __forceinline__ void operator()(const f32x4 (&acc)[2][2][4][2], const Unit& u, int wr, int wc, int fr, int fq) const {
        const int row0 = u.pm * BM + wr * 64 + fr;
        f32x4 swv[2][2];
#pragma unroll
        for (int bj = 0; bj < 2; ++bj)
#pragma unroll
            for (int n = 0; n < 2; ++n) swv[bj][n] = *(const f32x4*)(sw + u.pn * BM + bj * HALF + wc * 32 + 8 * fq + 4 * n);
#define PG8_I2F(x) __builtin_convertvector(__builtin_bit_cast(i32x4, (x)), f32x4)
        if (u.pn == 0) {
#pragma unroll
            for (int ai = 0; ai < 2; ++ai)
#pragma unroll
                for (int m = 0; m < 4; ++m) { bf16_t* rowp = P + (size_t)(row0 + ai * HALF + m * 16) * 256 + wc * 32 + 8 * fq; const float sar = sa[row0 + ai * HALF + m * 16];
#pragma unroll
                    for (int bj = 0; bj < 2; ++bj) { const f32x4 v0 = PG8_I2F(acc[ai][bj][m][0]) * swv[bj][0] * sar, v1 = PG8_I2F(acc[ai][bj][m][1]) * swv[bj][1] * sar;
                        u32x4 w; w.x = cvt_pk_bf16(v0[0], v0[1]); w.y = cvt_pk_bf16(v0[2], v0[3]); w.z = cvt_pk_bf16(v1[0], v1[1]); w.w = cvt_pk_bf16(v1[2], v1[3]);
                        *(u32x4*)(rowp + bj * HALF) = w; } }
        } else {
            const int ty = (u.pn - 1) / 3, g = (u.pn - 1) % 3, sh = 2 * g;
            const float sc = (ty == 0) ? C2Q : 1.f;
            bf16_t* base = QKV + (size_t)ty * ty_stride;
#pragma unroll
            for (int ai = 0; ai < 2; ++ai)
#pragma unroll
                for (int m = 0; m < 4; ++m) { const int row = row0 + ai * HALF + m * 16, b = row >> 11, pos = row & 2047;
                    const int seqp = ((pos & ((1 << sh) - 1)) << (11 - sh)) | (pos >> sh); const float sar = sa[row] * sc;
#pragma unroll
                    for (int bj = 0; bj < 2; ++bj) { const int cl = bj * HALF + wc * 32 + 8 * fq, hd = 4 * g + (cl >> 6), c = cl & 63;
                        const f32x4 v0 = PG8_I2F(acc[ai][bj][m][0]) * swv[bj][0] * sar, v1 = PG8_I2F(acc[ai][bj][m][1]) * swv[bj][1] * sar;
                        u32x4 w; w.x = cvt_pk_bf16(v0[0], v0[1]); w.y = cvt_pk_bf16(v0[2], v0[3]); w.z = cvt_pk_bf16(v1[0], v1[1]); w.w = cvt_pk_bf16(v1[2], v1[3]);
                        *(u32x4*)(base + ((size_t)((b * 12 + hd) * 2048 + seqp)) * 64 + c) = w; } }
        }
#undef PG8_I2F
    }
};
struct EpiOutProj {
    static constexpr bool PERM = true, AFTER_DRAIN = false;
    const float* x; bf16_t* x2b; float* rowss;
    __device__ __forceinline__ void operator()(const f32x4 (&acc)[2][2][4][2], const Unit& u, int wr, int wc, int fr, int fq) const {
        const int col0 = u.pn * BM + wc * 32 + 8 * fq;
#pragma unroll
        for (int ai = 0; ai < 2; ++ai)
#pragma unroll
            for (int m = 0; m < 4; ++m) { const int row = u.pm * BM + ai * HALF + wr * 64 + m * 16 + fr; const size_t off = (size_t)row * 1024 + col0; float ss = 0.f;
#pragma unroll
                for (int bj = 0; bj < 2; ++bj) { const size_t o2 = off + bj * HALF;
                    const f32x4 o0 = *(const f32x4*)(x + o2) + acc[ai][bj][m][0], o1 = *(const f32x4*)(x + o2 + 4) + acc[ai][bj][m][1];
                    ss += ((o0[0] * o0[0] + o0[1] * o0[1]) + (o0[2] * o0[2] + o0[3] * o0[3])) + ((o1[0] * o1[0] + o1[1] * o1[1]) + (o1[2] * o1[2] + o1[3] * o1[3]));
                    u32x4 w; w.x = cvt_pk_bf16(o0[0], o0[1]); w.y = cvt_pk_bf16(o0[2], o0[3]); w.z = cvt_pk_bf16(o1[0], o1[1]); w.w = cvt_pk_bf16(o1[2], o1[3]);
                    *(u32x4*)(x2b + o2) = w; }
                ss += __shfl_xor(ss, 16); ss += __shfl_xor(ss, 32);
                if (fq == 0) atomicAdd(rowss + row, ss); }
    }
};
struct EpiPeerQ {
    static constexpr bool PERM = true, AFTER_DRAIN = false;
    bf16_t* O; const float* rowss;
    __device__ __forceinline__ void operator()(const f32x4 (&acc)[2][2][4][2], const Unit& u, int wr, int wc, int fr, int fq) const {
        const int row0 = u.pm * BM + wr * 64 + fr, col0 = u.pn * BM + wc * 32 + 8 * fq;
#pragma unroll
        for (int ai = 0; ai < 2; ++ai)
#pragma unroll
            for (int m = 0; m < 4; ++m) { const int row = row0 + ai * HALF + m * 16; const float rs = rsqrtf(rowss[row] * (1.f / 1024.f) + 1e-6f);
                bf16_t* rowp = O + (size_t)row * 2048 + col0;
#pragma unroll
                for (int bj = 0; bj < 2; ++bj) { const f32x4 v0 = acc[ai][bj][m][0] * rs, v1 = acc[ai][bj][m][1] * rs;
                    u32x4 w; w.x = cvt_pk_bf16(v0[0], v0[1]); w.y = cvt_pk_bf16(v0[2], v0[3]); w.z = cvt_pk_bf16(v1[0], v1[1]); w.w = cvt_pk_bf16(v1[2], v1[3]);
                    *(u32x4*)(rowp + bj * HALF) = w; } }
    }
};
template <class Epi, class Sched, bool ALIGN_EPI = false, bool SP2 = false, bool I8 = false>
__device__ __forceinline__ void gemm_phase(PG8_LAS unsigned char* lds, const Gemm g, const Sched& S, const Epi& E, int wid) {
    const int lane = lane_now(), tid = wid * 64 + lane, wr = wid >> 2, wc = wid & 3, fr = lane & 15, fq = lane >> 4;
    const int K = g.K, nt = K / BK;
    unsigned voffA[2], voffB[2];
#pragma unroll
    for (int i = 0; i < 2; ++i) { int R, C; stage_rc(tid * 16 + i * 8192, R, C); const int Rb = Epi::PERM ? ((R & ~31) + perm32(R & 31)) : R;
        voffA[i] = (unsigned)(R * K + C) * 2u; voffB[i] = (unsigned)(Rb * K + C) * 2u; }
    const size_t kstep = (size_t)(BK * 2);
    const size_t hstep = (size_t)HALF * K * 2;
    const size_t tstep = 2 * hstep;
    const unsigned ldsw = (unsigned)wid * 1024u;
    const int aoff = lds_byte(wr * 64 + fr, fq * 8), boff = lds_byte(wc * 32 + fr, fq * 8);
#define PG8_SA(b, h) (((b) * 2 + (h)) * HTB)
#define PG8_SB(b, h) ((4 + (b) * 2 + (h)) * HTB)
#define PG8_STAGE(bufoff, gbase, voff) do { _Pragma("unroll") for (int _i = 0; _i < 2; ++_i) \
        __builtin_amdgcn_global_load_lds((const unsigned*)((const char*)(gbase) + (voff)[_i]), (PG8_LAS unsigned*)(lds + (bufoff) + ldsw + _i * 8192), 16, 0, 0); } while (0)
#define PG8_LDA(dst, b, h) do { _Pragma("unroll") for (int m = 0; m < 4; ++m) _Pragma("unroll") for (int k = 0; k < 2; ++k) dst[m][k] = *(const PG8_LAS bf16x8*)(lds + PG8_SA(b, h) + aoff + m * 2048 + k * 1024); } while (0)
#define PG8_LDB(dst, b, h) do { _Pragma("unroll") for (int n = 0; n < 2; ++n) _Pragma("unroll") for (int k = 0; k < 2; ++k) dst[n][k] = *(const PG8_LAS bf16x8*)(lds + PG8_SB(b, h) + boff + n * 2048 + k * 1024); } while (0)
#define PG8_MMA(ai, bj, At, Bt) do { __builtin_amdgcn_s_setprio(1); _Pragma("unroll") for (int m = 0; m < 4; ++m) _Pragma("unroll") for (int n = 0; n < 2; ++n) _Pragma("unroll") for (int k = 0; k < 2; ++k) \
        { if constexpr (I8) acc[ai][bj][m][n] = __builtin_bit_cast(f32x4, __builtin_amdgcn_mfma_i32_16x16x64_i8(__builtin_bit_cast(i32x4, Bt[n][k]), __builtin_bit_cast(i32x4, At[m][k]), __builtin_bit_cast(i32x4, acc[ai][bj][m][n]), 0, 0, 0)); \
          else acc[ai][bj][m][n] = __builtin_amdgcn_mfma_f32_16x16x32_bf16(Bt[n][k], At[m][k], acc[ai][bj][m][n], 0, 0, 0); } __builtin_amdgcn_s_setprio(0); } while (0)
#define PG8_WAIT_V(n) asm volatile("s_waitcnt vmcnt(" #n ")" ::: "memory")
#define PG8_WAIT_L(n) asm volatile("s_waitcnt lgkmcnt(" #n ")" ::: "memory")
#define PG8_BAR __builtin_amdgcn_s_barrier()
#define PG8_SCHED __builtin_amdgcn_sched_barrier(0)
    Unit cur, nxt; int ui = 0;
    if (!S.next(0, cur)) return;
    f32x4 acc[2][2][4][2];
#pragma unroll
    for (int a = 0; a < 2; ++a)
#pragma unroll
        for (int b = 0; b < 2; ++b)
#pragma unroll
            for (int m = 0; m < 4; ++m)
#pragma unroll
                for (int n = 0; n < 2; ++n) acc[a][b][m][n] = (f32x4){0.f, 0.f, 0.f, 0.f};
    bf16x8 At[4][2], B0[2][2], B1[2][2];
    const char* cA = (const char*)g.A + (size_t)cur.pm * tstep; const char* cB = (const char*)g.Bt + (size_t)cur.pn * tstep;
    S.a_ready(cur);
    if constexpr (SP2) {
        PG8_STAGE(PG8_SB(0, 0), cB, voffB); PG8_STAGE(PG8_SB(0, 1), cB + hstep, voffB); PG8_STAGE(PG8_SA(0, 0), cA, voffA); PG8_STAGE(PG8_SA(0, 1), cA + hstep, voffA);
        if (wr == 1) PG8_BAR;
        PG8_WAIT_V(2); PG8_BAR;
        PG8_STAGE(PG8_SB(1, 0), cB + kstep, voffB); PG8_STAGE(PG8_SA(1, 0), cA + kstep, voffA); PG8_STAGE(PG8_SB(1, 1), cB + hstep + kstep, voffB);
        PG8_WAIT_V(6); PG8_BAR;
    } else {
        PG8_STAGE(PG8_SB(0, 0), cB, voffB); PG8_STAGE(PG8_SA(0, 0), cA, voffA); PG8_STAGE(PG8_SB(0, 1), cB + hstep, voffB); PG8_STAGE(PG8_SA(0, 1), cA + hstep, voffA);
        if (wr == 1) PG8_BAR;
        PG8_WAIT_V(4); PG8_BAR;
        PG8_STAGE(PG8_SB(1, 0), cB + kstep, voffB); PG8_STAGE(PG8_SA(1, 0), cA + kstep, voffA); PG8_STAGE(PG8_SB(1, 1), cB + hstep + kstep, voffB);
        PG8_WAIT_V(6); PG8_BAR;
    }
    for (;;) {
        const bool has_next = S.next(ui + 1, nxt);
        const char* nA = has_next ? (const char*)g.A + (size_t)nxt.pm * tstep : cA; const char* nB = has_next ? (const char*)g.Bt + (size_t)nxt.pn * tstep : cB;
        for (int t = 0; t < nt; t += 2) {
            const bool last = (t == nt - 2);
            const char* a1 = cA + (size_t)(t + 1) * kstep;
            const char* a2 = last ? nA : cA + (size_t)(t + 2) * kstep; const char* b2 = last ? nB : cB + (size_t)(t + 2) * kstep;
            const char* a3 = a2 + kstep; const char* b3 = b2 + kstep;
            if (last && has_next) S.a_ready(nxt);
            if constexpr (SP2) {
            PG8_LDB(B0, 0, 0); PG8_LDB(B1, 0, 1); PG8_SCHED; PG8_LDA(At, 0, 0); PG8_STAGE(PG8_SA(1, 1), a1 + hstep, voffA);
            PG8_WAIT_V(8); PG8_WAIT_L(0); PG8_BAR; PG8_MMA(0, 0, At, B0); PG8_MMA(0, 1, At, B1); PG8_BAR; PG8_SCHED;
            PG8_LDA(At, 0, 1); PG8_STAGE(PG8_SB(0, 0), b2, voffB); PG8_STAGE(PG8_SB(0, 1), b2 + hstep, voffB); PG8_STAGE(PG8_SA(0, 0), a2, voffA);
            PG8_WAIT_V(8); PG8_WAIT_L(0); PG8_BAR; PG8_MMA(1, 0, At, B0); PG8_MMA(1, 1, At, B1); PG8_BAR; PG8_SCHED;
            PG8_LDB(B0, 1, 0); PG8_LDB(B1, 1, 1); PG8_SCHED; PG8_LDA(At, 1, 0); PG8_STAGE(PG8_SA(0, 1), a2 + hstep, voffA);
            PG8_WAIT_V(8); PG8_WAIT_L(0); PG8_BAR; PG8_MMA(0, 0, At, B0); PG8_MMA(0, 1, At, B1); PG8_BAR; PG8_SCHED;
            PG8_LDA(At, 1, 1); PG8_STAGE(PG8_SB(1, 0), b3, voffB); PG8_STAGE(PG8_SB(1, 1), b3 + hstep, voffB); PG8_STAGE(PG8_SA(1, 0), a3, voffA);
            PG8_WAIT_V(8); PG8_WAIT_L(0); PG8_BAR; PG8_MMA(1, 0, At, B0); PG8_MMA(1, 1, At, B1); PG8_BAR; PG8_SCHED;
            } else {
            PG8_LDB(B0, 0, 0); PG8_SCHED; PG8_LDA(At, 0, 0); PG8_STAGE(PG8_SA(1, 1), a1 + hstep, voffA);
            PG8_WAIT_L(8); PG8_BAR; PG8_WAIT_L(0); PG8_MMA(0, 0, At, B0); PG8_BAR; PG8_SCHED;
            PG8_LDB(B1, 0, 1); PG8_STAGE(PG8_SB(0, 0), b2, voffB);
            PG8_BAR; PG8_WAIT_L(0); PG8_MMA(0, 1, At, B1); PG8_BAR;
            PG8_LDA(At, 0, 1); PG8_STAGE(PG8_SA(0, 0), a2, voffA);
            PG8_BAR; PG8_WAIT_L(0); PG8_MMA(1, 0, At, B0); PG8_BAR; PG8_SCHED;
            PG8_STAGE(PG8_SB(0, 1), b2 + hstep, voffB);
            PG8_WAIT_V(6); PG8_BAR; PG8_MMA(1, 1, At, B1); PG8_BAR;
            PG8_LDB(B0, 1, 0); PG8_SCHED; PG8_LDA(At, 1, 0); PG8_STAGE(PG8_SA(0, 1), a2 + hstep, voffA);
            PG8_WAIT_L(8); PG8_BAR; PG8_WAIT_L(0); PG8_MMA(0, 0, At, B0); PG8_BAR; PG8_SCHED;
            PG8_LDB(B1, 1, 1); PG8_STAGE(PG8_SB(1, 0), b3, voffB);
            PG8_BAR; PG8_WAIT_L(0); PG8_MMA(0, 1, At, B1); PG8_BAR;
            PG8_LDA(At, 1, 1); PG8_STAGE(PG8_SA(1, 0), a3, voffA);
            PG8_BAR; PG8_WAIT_L(0); PG8_MMA(1, 0, At, B0); PG8_BAR; PG8_SCHED;
            PG8_STAGE(PG8_SB(1, 1), b3 + hstep, voffB);
            PG8_WAIT_V(6); PG8_BAR; PG8_MMA(1, 1, At, B1); PG8_BAR;
            }
        }
        if constexpr (ALIGN_EPI) { if (wr == 0) PG8_BAR; }
        if constexpr (!Epi::AFTER_DRAIN) { E(acc, cur, wr, wc, fr, fq); S.done(cur); }
        if (!has_next) break;
#pragma unroll
        for (int a = 0; a < 2; ++a)
#pragma unroll
            for (int b = 0; b < 2; ++b)
#pragma unroll
                for (int m = 0; m < 4; ++m)
#pragma unroll
                    for (int n = 0; n < 2; ++n) acc[a][b][m][n] = (f32x4){0.f, 0.f, 0.f, 0.f};
        cur = nxt; cA = nA; cB = nB; ++ui;
        if constexpr (ALIGN_EPI) { if (wr == 1) PG8_BAR; }
    }
    PG8_WAIT_V(0);
    if constexpr (!ALIGN_EPI) { if (wr == 0) PG8_BAR; }
    PG8_BAR;
    if constexpr (Epi::AFTER_DRAIN) { E.fused(acc, cur, wr, wc, fr, fq, lds, wid, lane); S.done(cur); }
#undef PG8_SA
#undef PG8_SB
#undef PG8_STAGE
#undef PG8_LDA
#undef PG8_LDB
#undef PG8_MMA
#undef PG8_WAIT_V
#undef PG8_WAIT_L
#undef PG8_BAR
#undef PG8_SCHED
}
}
constexpr int M = 32768, D = 1024, S = 2048;
constexpr int NPROJ = 2560, NQ = 2048, NEXP = 16384;
typedef unsigned short bf16;
constexpr size_t MiB = 1u << 20;
constexpr size_t WS_CTL = 0, CTL_ZERO_BYTES = 1 * MiB;
constexpr size_t WS_WIN = 2 * MiB, WS_WOUT = 8 * MiB, WS_WQ = 10 * MiB;
constexpr size_t WS_SK = 14 * MiB, WS_WPT = 14 * MiB + 512 * 1024;
constexpr size_t WS_SA = 15 * MiB + 640 * 1024, WS_SWIN = 15 * MiB + 768 * 1024;
constexpr size_t WS_SU = 15 * MiB, WS_SV = 15 * MiB + 64 * 1024, WS_USUM = 15 * MiB + 128 * 1024, WS_ROWSS = 15 * MiB + 512 * 1024;
constexpr size_t WS_U8 = 16 * MiB, WS_V8 = 32 * MiB;
constexpr size_t WS_XN = 48 * MiB;
constexpr size_t WS_P = 112 * MiB;
constexpr size_t WS_Q = 128 * MiB, WS_K = 176 * MiB, WS_V = 224 * MiB;
constexpr size_t WS_ORAW = 272 * MiB, WS_LSE = 320 * MiB, WS_MIXIN = 322 * MiB, WS_END = 386 * MiB;
constexpr size_t WS_QP = 128 * MiB, WS_IDX = 256 * MiB, WS_GATE = 264 * MiB, WS_X8 = 280 * MiB;
constexpr size_t WS_PROJ = 386 * MiB;
constexpr int CW_BAR = 4096;
constexpr int CW_CMAX = CW_BAR + 2 * 3456, CW_CCNT = CW_CMAX + NPROJ, CW_END = CW_CCNT + NPROJ / 32;

constexpr int RING_BYTES = 147456;
constexpr int LDSCTL_OFF = RING_BYTES, MISC_OFF = LDSCTL_OFF;
constexpr int LDS_BYTES = RING_BYTES + 128;
constexpr int NWAVES = 8;

#define GAS __attribute__((address_space(1)))
#define LAS __attribute__((address_space(3)))
typedef unsigned v4u __attribute__((ext_vector_type(4)));
typedef float f32x4 __attribute__((ext_vector_type(4)));
typedef GAS unsigned gu32;
#define LDS_WAIT() asm volatile("s_waitcnt lgkmcnt(0)" ::: "memory")
#define VM_WAIT() asm volatile("s_waitcnt vmcnt(0)" ::: "memory")
__device__ __forceinline__ unsigned f2bf(float f) { unsigned u = __builtin_bit_cast(unsigned, f); return (u + 0x7fffu + ((u >> 16) & 1u)) >> 16; }
__device__ __forceinline__ unsigned pk2(float lo, float hi) { return f2bf(lo) | (f2bf(hi) << 16); }
__device__ __forceinline__ float bf2f(unsigned short b) { return __builtin_bit_cast(float, (unsigned)b << 16); }
template <int CTRL> __device__ __forceinline__ float dpp_mov(float v) { return __builtin_bit_cast(float, __builtin_amdgcn_mov_dpp(__builtin_bit_cast(int, v), CTRL, 0xF, 0xF, true)); }
__device__ __forceinline__ float lane_val(float v, int l) { return __builtin_bit_cast(float, __builtin_amdgcn_readlane(__builtin_bit_cast(int, v), l)); }
__device__ __forceinline__ float wave_sum(float v) {
    v += dpp_mov<0xB1>(v); v += dpp_mov<0x4E>(v); v += dpp_mov<0x141>(v); v += dpp_mov<0x140>(v);
    return (lane_val(v, 0) + lane_val(v, 16)) + (lane_val(v, 32) + lane_val(v, 48));
}
__device__ __forceinline__ float wave_max(float v) {
    v = fmaxf(v, dpp_mov<0xB1>(v)); v = fmaxf(v, dpp_mov<0x4E>(v)); v = fmaxf(v, dpp_mov<0x141>(v)); v = fmaxf(v, dpp_mov<0x140>(v));
    return fmaxf(fmaxf(lane_val(v, 0), lane_val(v, 16)), fmaxf(lane_val(v, 32), lane_val(v, 48)));
}
#define XB_TMO      128
#define XB_XCNT(j)  (256  + 64 * (j))
#define XB_XSUB(j)  (1280 + 64 * (j))
#define XB_XGEN(j)  (2304 + 64 * (j))
#define XB_TOP      3328
#define XB_TOPGEN   3392
#define XCD_BAR_WORDS 3456
#define XB_SPIN_CAP (1u << 18)

__device__ __forceinline__ unsigned xb_ld(unsigned* p)              { return __hip_atomic_load(p, __ATOMIC_RELAXED, __HIP_MEMORY_SCOPE_AGENT); }
__device__ __forceinline__ unsigned xb_add(unsigned* p, unsigned v) { return __hip_atomic_fetch_add(p, v, __ATOMIC_RELAXED, __HIP_MEMORY_SCOPE_AGENT); }
__device__ __forceinline__ unsigned xb_xcc_id() { return (unsigned)__builtin_amdgcn_s_getreg((3 << 11) | 20) & 0xFu; }
#define XB_SPIN(cond, bar) do { unsigned _sp = 0; while (cond) { __builtin_amdgcn_s_sleep(1); \
    if ((++_sp & 255u) == 0u) { if (xb_ld(&(bar)[XB_TMO])) break; if (_sp > XB_SPIN_CAP) { atomicAdd(&(bar)[XB_TMO], 1u); break; } } } } while (0)

struct XcdBarrier {
    unsigned* bar; unsigned x;
    volatile LAS unsigned* st;
};

__device__ __forceinline__ XcdBarrier xcd_barrier_post(unsigned* bar, volatile LAS unsigned* st) {
    XcdBarrier b; b.bar = bar; b.x = xb_xcc_id(); b.st = st;
    if (threadIdx.x == 0) (void)xb_add(&bar[XB_XCNT(b.x)], 1u);
    return b;
}
__device__ __forceinline__ void xcd_barrier_complete(unsigned* bar, unsigned x, unsigned& nloc, unsigned& nx) {
    const unsigned G = gridDim.x * gridDim.y * gridDim.z;
    unsigned sum, cnt, mine, sp = 0u;
    for (;;) {
        sum = 0u; cnt = 0u; mine = 0u;
#pragma unroll
        for (unsigned j = 0; j < 16; ++j) { const unsigned c = xb_ld(&bar[XB_XCNT(j)]); sum += c; cnt += (c > 0u) ? 1u : 0u; mine = (j == x) ? c : mine; }
        if (sum == G) break;
        __builtin_amdgcn_s_sleep(1);
        if ((++sp & 255u) == 0u) { if (xb_ld(&bar[XB_TMO])) break; if (sp > XB_SPIN_CAP) { atomicAdd(&bar[XB_TMO], 1u); break; } }
    }
    nloc = mine > 0u ? mine : 1u; nx = cnt > 0u ? cnt : 1u;
}

__device__ __forceinline__ void xcd_barrier(const XcdBarrier& b, int wave_) {
    asm volatile("s_waitcnt vmcnt(0)" ::: "memory");
    __syncthreads();
    if (wave_ == 0 && lane_now() == 0) {
        unsigned* bar = b.bar;
        __builtin_amdgcn_s_waitcnt(0);
        unsigned nloc = b.st[0], nx = b.st[1];
        if (nloc == 0u) { xcd_barrier_complete(bar, b.x, nloc, nx); b.st[0] = nloc; b.st[1] = nx; }
        const unsigned old = xb_add(&bar[XB_XSUB(b.x)], 1u);
        const unsigned gen = old / nloc;
        if (old + 1u == (gen + 1u) * nloc) {
            __builtin_amdgcn_fence(__ATOMIC_RELEASE, "agent");
            asm volatile("s_waitcnt vmcnt(0)" ::: "memory");
            const unsigned og = xb_add(&bar[XB_TOP], 1u);
            const unsigned tg = og / nx;
            if (og + 1u == (tg + 1u) * nx) xb_add(&bar[XB_TOPGEN], 1u);
            else XB_SPIN(xb_ld(&bar[XB_TOPGEN]) == tg, bar);
            __builtin_amdgcn_fence(__ATOMIC_ACQUIRE, "agent");
            xb_add(&bar[XB_XGEN(b.x)], 1u);
            asm volatile("s_waitcnt vmcnt(0)" ::: "memory");
        } else {
            XB_SPIN(xb_ld(&bar[XB_XGEN(b.x)]) == gen, bar);
            __builtin_amdgcn_fence(__ATOMIC_ACQUIRE, "agent");
            asm volatile("s_waitcnt vmcnt(0)" ::: "memory");
        }
    }
    __syncthreads();
}
struct Args { const float* in[12]; float* out; unsigned char* ws; int ph_lo, ph_hi, li, pad; };

__device__ __forceinline__ void p0_transpose_item(const float* W, int K, int N, bf16* WT, const float* kscale, LAS float* scr, int item, int lane) {
    const int nblk = N / 32, kb = item / nblk, nb = item % nblk, k0 = 64 * kb, n0 = 32 * nb;
#pragma unroll 8
    for (int i = 0; i < 32; ++i) { const int kk = 2 * i + (lane >> 5); float w = W[(size_t)(k0 + kk) * N + n0 + (lane & 31)]; if (kscale) w *= kscale[k0 + kk]; scr[kk * 33 + (lane & 31)] = w; }
    LDS_WAIT(); asm volatile("" ::: "memory");
    const int c = lane & 7;
#pragma unroll
    for (int j = 0; j < 4; ++j) { const int n = (lane >> 3) + 8 * j; const LAS float* s = scr + (8 * c) * 33 + n;
        v4u o; o.x = pk2(s[0 * 33], s[1 * 33]); o.y = pk2(s[2 * 33], s[3 * 33]); o.z = pk2(s[4 * 33], s[5 * 33]); o.w = pk2(s[6 * 33], s[7 * 33]);
        *(GAS v4u*)(WT + (size_t)(n0 + n) * K + k0 + 8 * c) = o; }
    LDS_WAIT(); asm volatile("" ::: "memory");
}
__device__ __forceinline__ void p0_quant_publish(const float* W, int N, unsigned* cmax, unsigned* ccnt, LAS float* scr, int item, int lane) {
    const int nblk = N / 32, kb = item / nblk, nb = item % nblk, k0 = 64 * kb, n0 = 32 * nb;
    float mx = 0.f;
#pragma unroll 8
    for (int i = 0; i < 32; ++i) { const int kk = 2 * i + (lane >> 5); const float w = W[(size_t)(k0 + kk) * N + n0 + (lane & 31)]; scr[kk * 33 + (lane & 31)] = w; mx = fmaxf(mx, fabsf(w)); }
    { const auto rr = __builtin_amdgcn_permlane32_swap(__builtin_bit_cast(unsigned, mx), __builtin_bit_cast(unsigned, mx), false, false);
      mx = fmaxf(__builtin_bit_cast(float, (unsigned)rr[0]), __builtin_bit_cast(float, (unsigned)rr[1])); }
    if (lane < 32) __hip_atomic_fetch_max(cmax + n0 + lane, __builtin_bit_cast(unsigned, mx), __ATOMIC_RELAXED, __HIP_MEMORY_SCOPE_AGENT);
    asm volatile("s_waitcnt vmcnt(0)" ::: "memory");
    if (lane == 0) __hip_atomic_fetch_add(ccnt + nb, 1u, __ATOMIC_RELAXED, __HIP_MEMORY_SCOPE_AGENT);
}
__device__ __forceinline__ void p0_quant_finish(int N, signed char* W8, float* sw, unsigned* cmax, unsigned* ccnt, LAS float* scr, int item, int lane) {
    const int nblk = N / 32, kb = item / nblk, nb = item % nblk, k0 = 64 * kb, n0 = 32 * nb;
    if (lane == 0) { unsigned sp = 0; while (__hip_atomic_load(ccnt + nb, __ATOMIC_RELAXED, __HIP_MEMORY_SCOPE_AGENT) < 16u) { __builtin_amdgcn_s_sleep(1); if (++sp > (1u << 22)) break; } }
    asm volatile("s_waitcnt vmcnt(0) lgkmcnt(0)" ::: "memory");
    __builtin_amdgcn_wave_barrier();
#pragma unroll
    for (int j = 0; j < 2; ++j) { const int n = 16 * j + (lane >> 2), ck = lane & 3;
        const float cm = __builtin_bit_cast(float, __hip_atomic_load(cmax + n0 + n, __ATOMIC_RELAXED, __HIP_MEMORY_SCOPE_AGENT));
        const float inv = cm > 0.f ? 127.f / cm : 0.f;
        if (kb == 0 && ck == 0) sw[n0 + n] = cm > 0.f ? cm * (1.f / 127.f) : 1.f;
        v4u o;
#pragma unroll
        for (int q = 0; q < 4; ++q) { const LAS float* sp_ = scr + (16 * ck + 4 * q) * 33 + n;
            const int a = (int)rintf(sp_[0] * inv), b = (int)rintf(sp_[33] * inv), c = (int)rintf(sp_[66] * inv), d = (int)rintf(sp_[99] * inv);
            o[q] = (unsigned)(a & 0xff) | ((unsigned)(b & 0xff) << 8) | ((unsigned)(c & 0xff) << 16) | ((unsigned)(d & 0xff) << 24); }
        *(GAS v4u*)(W8 + (size_t)(n0 + n) * 1024 + k0 + 16 * ck) = o; }
    LDS_WAIT(); asm volatile("" ::: "memory");
}
__device__ __forceinline__ void p0_quant_item(const float* W, int N, signed char* W8, float* sw, unsigned* cmax, unsigned* ccnt, LAS float* scr, int item, int lane) {
    p0_quant_publish(W, N, cmax, ccnt, scr, item, lane); p0_quant_finish(N, W8, sw, cmax, ccnt, scr, item, lane);
}
__device__ __forceinline__ void rms_row_to_bf16(const float* xrow, const float* g, bf16* orow, int lane) {
    const GAS f32x4* xr = (const GAS f32x4*)xrow + lane;
    f32x4 v[4]; float s = 0.f;
#pragma unroll
    for (int j = 0; j < 4; ++j) { v[j] = xr[64 * j]; s += (v[j].x * v[j].x + v[j].y * v[j].y) + (v[j].z * v[j].z + v[j].w * v[j].w); }
    const float r = rsqrtf(wave_sum(s) * (1.f / D) + 1e-6f);
    GAS unsigned long long* o8 = (GAS unsigned long long*)orow + lane;
#pragma unroll
    for (int j = 0; j < 4; ++j) { const f32x4 gg = ((const GAS f32x4*)g)[lane + 64 * j];
        o8[64 * j] = (unsigned long long)pk2(v[j].x * r * gg.x, v[j].y * r * gg.y) | ((unsigned long long)pk2(v[j].z * r * gg.z, v[j].w * r * gg.w) << 32); }
}
__device__ __forceinline__ void quant_row_i8(const float* src, const float* gsc, signed char* dst, float* scale_out, int lane) {
    const GAS f32x4* p = (const GAS f32x4*)src + 4 * lane;
    f32x4 v[4]; float amax = 0.f;
#pragma unroll
    for (int j = 0; j < 4; ++j) { v[j] = p[j]; if (gsc) v[j] = v[j] * ((const GAS f32x4*)gsc)[4 * lane + j];
        amax = fmaxf(amax, fmaxf(fmaxf(fabsf(v[j].x), fabsf(v[j].y)), fmaxf(fabsf(v[j].z), fabsf(v[j].w)))); }
    amax = wave_max(amax);
    const float inv = amax > 0.f ? 127.f / amax : 0.f;
    v4u w;
#pragma unroll
    for (int j = 0; j < 4; ++j) { const int a = (int)rintf(v[j].x * inv), b = (int)rintf(v[j].y * inv), c = (int)rintf(v[j].z * inv), d = (int)rintf(v[j].w * inv);
        w[j] = (unsigned)(a & 0xff) | ((unsigned)(b & 0xff) << 8) | ((unsigned)(c & 0xff) << 16) | ((unsigned)(d & 0xff) << 24); }
    *(GAS v4u*)(dst + (size_t)(lane >> 3) * ((size_t)NEXP * 128) + 16 * (lane & 7)) = w;
    if (lane == 0) *scale_out = amax > 0.f ? amax * (1.f / 127.f) : 1.f;
}
__device__ __forceinline__ void quant_row_load(const float* src, f32x4 (&v)[4], int lane) {
    const GAS f32x4* p = (const GAS f32x4*)src + 4 * lane;
#pragma unroll
    for (int j = 0; j < 4; ++j) v[j] = p[j];
}
__device__ __forceinline__ void quant_row_finish(f32x4 (&v)[4], const float* gsc, signed char* dst, float* scale_out, int lane) {
    float amax = 0.f;
#pragma unroll
    for (int j = 0; j < 4; ++j) { if (gsc) v[j] = v[j] * ((const GAS f32x4*)gsc)[4 * lane + j];
        amax = fmaxf(amax, fmaxf(fmaxf(fabsf(v[j].x), fabsf(v[j].y)), fmaxf(fabsf(v[j].z), fabsf(v[j].w)))); }
    amax = wave_max(amax);
    const float inv = amax > 0.f ? 127.f / amax : 0.f;
    v4u w;
#pragma unroll
    for (int j = 0; j < 4; ++j) { const int a = (int)rintf(v[j].x * inv), b = (int)rintf(v[j].y * inv), c = (int)rintf(v[j].z * inv), d = (int)rintf(v[j].w * inv);
        w[j] = (unsigned)(a & 0xff) | ((unsigned)(b & 0xff) << 8) | ((unsigned)(c & 0xff) << 16) | ((unsigned)(d & 0xff) << 24); }
    *(GAS v4u*)(dst + (size_t)(lane >> 3) * ((size_t)NEXP * 128) + 16 * (lane & 7)) = w;
    if (lane == 0) *scale_out = amax > 0.f ? amax * (1.f / 127.f) : 1.f;
}
__device__ __forceinline__ void quant_row_finish_u4(f32x4 (&v)[4], const float* gsc, unsigned char* dst, float* scale_out, float* usum_out, int lane) {
    float amax = 0.f, ssq = 0.f;
#pragma unroll
    for (int j = 0; j < 4; ++j) { v[j] = v[j] * ((const GAS f32x4*)gsc)[4 * lane + j];
        amax = fmaxf(amax, fmaxf(fmaxf(fabsf(v[j].x), fabsf(v[j].y)), fmaxf(fabsf(v[j].z), fabsf(v[j].w))));
        ssq += (v[j].x * v[j].x + v[j].y * v[j].y) + (v[j].z * v[j].z + v[j].w * v[j].w); }
    amax = wave_max(amax); ssq = wave_sum(ssq);
    const float clipv = fminf(amax, 2.7f * sqrtf(ssq * (1.f / D)));
    const float inv = clipv > 0.f ? 7.f / clipv : 0.f;
    unsigned w[2] = {0u, 0u}; float cs_ = 0.f;
#pragma unroll
    for (int j = 0; j < 4; ++j) { const float f_[4] = {v[j].x, v[j].y, v[j].z, v[j].w};
#pragma unroll
        for (int c = 0; c < 4; ++c) { const float q = fminf(fmaxf(rintf(f_[c] * inv), -7.f), 7.f) + 8.f; cs_ += q; w[j >> 1] |= (unsigned)(int)q << (4 * (4 * (j & 1) + c)); } }
    typedef unsigned v2u_ __attribute__((ext_vector_type(2)));
    *(GAS v2u_*)(dst + (size_t)(lane >> 4) * ((size_t)NEXP * 128) + 8 * (lane & 15)) = (v2u_){w[0], w[1]};
    cs_ = wave_sum(cs_);
    if (lane == 0) { *scale_out = clipv > 0.f ? clipv * (1.f / 7.f) : 1.f; *usum_out = cs_; }
}
__device__ __forceinline__ void p0_prologue(const Args& a, LAS unsigned char* lds, int gw, int NGW, int wave, int lane) {
    unsigned char* ws = a.ws;
    LAS float* scr = (LAS float*)(lds + wave * 17408);
    LAS float* scr2 = scr + 64 * 33;
    const float* w_in = a.in[2]; const float* w_pool = a.in[3]; const float* w_out = a.in[5]; const float* g_ffn = a.in[6]; const float* w_q = a.in[7];
    constexpr int I_IN = (D / 64) * (NPROJ / 32), I_OUT = (D / 64) * (D / 32), I_Q = (D / 64) * (NQ / 32), I_P = 4 * 2;
    constexpr int NITEMS = I_IN + I_OUT + I_Q + I_P;
    unsigned* cmax_ = (unsigned*)(ws + WS_CTL) + CW_CMAX; unsigned* ccnt_ = (unsigned*)(ws + WS_CTL) + CW_CCNT;
    const bool defer = gw < I_IN;
    if (defer) p0_quant_publish(w_in, NPROJ, cmax_, ccnt_, scr, gw, lane);
    for (int it = defer ? gw + NGW : gw; it < NITEMS; it += NGW) {
        int r = it;
        if (r < I_IN) { p0_quant_item(w_in, NPROJ, (signed char*)(ws + WS_WIN), (float*)(ws + WS_SWIN), cmax_, ccnt_, scr2, r, lane); continue; } r -= I_IN;
        if (r < I_OUT) { p0_transpose_item(w_out, D, D, (bf16*)(ws + WS_WOUT), nullptr, scr2, r, lane); continue; } r -= I_OUT;
        if (r < I_Q) { p0_transpose_item(w_q, D, NQ, (bf16*)(ws + WS_WQ), g_ffn, scr2, r, lane); continue; } r -= I_Q;
        p0_transpose_item(w_pool + (r >> 1) * 4096, 64, 64, (bf16*)(ws + WS_WPT) + (r >> 1) * 4096, nullptr, scr2, r & 1, lane);
    }
    constexpr int R_X = M, R_SK = 256, R_Z = 32, NROWS = R_X + R_SK + R_Z;
    for (int c4 = gw; c4 < R_X / 4; c4 += NGW) {
        const GAS f32x4* xr = (const GAS f32x4*)(a.in[0] + (size_t)c4 * 4 * D) + lane;
        f32x4 v[4][4]; float ssq[4];
#pragma unroll
        for (int rr = 0; rr < 4; ++rr)
#pragma unroll
            for (int j = 0; j < 4; ++j) v[rr][j] = xr[rr * (D / 4) + 64 * j];
#pragma unroll
        for (int rr = 0; rr < 4; ++rr) { float s_ = 0.f;
#pragma unroll
            for (int j = 0; j < 4; ++j) s_ += (v[rr][j].x * v[rr][j].x + v[rr][j].y * v[rr][j].y) + (v[rr][j].z * v[rr][j].z + v[rr][j].w * v[rr][j].w);
            ssq[rr] = s_; }
#pragma unroll
        for (int rr = 0; rr < 4; ++rr) ssq[rr] = wave_sum(ssq[rr]);
#pragma unroll
        for (int rr = 0; rr < 4; ++rr) { const float rs = rsqrtf(ssq[rr] * (1.f / D) + 1e-6f);
            GAS unsigned* o4 = (GAS unsigned*)((signed char*)(ws + WS_XN) + ((size_t)c4 * 4 + rr) * D) + lane;
            f32x4 y[4]; float am = 0.f;
#pragma unroll
            for (int j = 0; j < 4; ++j) { const f32x4 gg = ((const GAS f32x4*)a.in[1])[lane + 64 * j]; y[j] = v[rr][j] * gg * rs;
                am = fmaxf(am, fmaxf(fmaxf(fabsf(y[j].x), fabsf(y[j].y)), fmaxf(fabsf(y[j].z), fabsf(y[j].w)))); }
            am = wave_max(am); const float qi = am > 0.f ? 127.f / am : 0.f;
#pragma unroll
            for (int j = 0; j < 4; ++j) { const int q0 = (int)rintf(y[j].x * qi), q1 = (int)rintf(y[j].y * qi), q2 = (int)rintf(y[j].z * qi), q3 = (int)rintf(y[j].w * qi);
                o4[64 * j] = (unsigned)(q0 & 0xff) | ((unsigned)(q1 & 0xff) << 8) | ((unsigned)(q2 & 0xff) << 16) | ((unsigned)q3 << 24); }
            if (lane == 0) ((float*)(ws + WS_SA))[(size_t)c4 * 4 + rr] = am > 0.f ? am * (1.f / 127.f) : 1.f; }
    }
    for (int it = R_X + gw; it < NROWS; it += NGW) {
        int r = it - R_X;
        if (r < R_SK) { const GAS f32x4* p = (const GAS f32x4*)(a.in[8] + (size_t)r * 1024) + lane; GAS unsigned long long* o8 = (GAS unsigned long long*)((bf16*)(ws + WS_SK) + (size_t)r * 1024) + lane;
#pragma unroll
            for (int j = 0; j < 4; ++j) { const f32x4 v = p[64 * j]; o8[64 * j] = (unsigned long long)pk2(v.x, v.y) | ((unsigned long long)pk2(v.z, v.w) << 32); }
            continue; } r -= R_SK;
        { GAS f32x4* z = (GAS f32x4*)((float*)(ws + WS_ROWSS) + (size_t)r * 1024) + lane;
#pragma unroll
          for (int j = 0; j < 4; ++j) z[64 * j] = (f32x4){0.f, 0.f, 0.f, 0.f}; }
    }
    if (defer) p0_quant_finish(NPROJ, (signed char*)(ws + WS_WIN), (float*)(ws + WS_SWIN), cmax_, ccnt_, scr, gw, lane);
}
namespace attn {
typedef short bf16x8 __attribute__((ext_vector_type(8)));
typedef short s16x4 __attribute__((ext_vector_type(4)));
typedef float f32x16 __attribute__((ext_vector_type(16)));
typedef float f32x2_t __attribute__((ext_vector_type(2)));
typedef __bf16 bf16x2_t __attribute__((ext_vector_type(2)));
typedef unsigned u32x4 __attribute__((ext_vector_type(4)));
typedef unsigned u32x2 __attribute__((ext_vector_type(2)));
constexpr int KROW = 144;
constexpr int SLOT = 2 * 256 * KROW;
__device__ __forceinline__ unsigned cvtpk(float lo, float hi) { f32x2_t v = {lo, hi}; bf16x2_t b = __builtin_convertvector(v, bf16x2_t); return __builtin_bit_cast(unsigned, b); }
__device__ __forceinline__ s16x4 vtr(LAS const unsigned char* p) { return __builtin_bit_cast(s16x4, __builtin_amdgcn_ds_read_tr16_b64_v4i16((LAS s16x4*)p)); }

__device__ __forceinline__ void attn_phase(unsigned char* ws, LAS unsigned char* lds, int vcu, int G, int tid) {
    const int lane = tid & 63, wv = __builtin_amdgcn_readfirstlane(tid >> 6), grp = wv >> 2, w = wv & 3, tl = tid & 255;
    const int ql = lane & 31, h = lane >> 5;
    LAS unsigned char* Ks = lds + grp * SLOT; LAS unsigned char* Vs = Ks + 256 * KROW;
    const bf16* Qd = (const bf16*)(ws + WS_Q); const bf16* Kd = (const bf16*)(ws + WS_K); const bf16* Vd = (const bf16*)(ws + WS_V);
    bf16* ORAW = (bf16*)(ws + WS_ORAW); float* LSE = (float*)(ws + WS_LSE);
#define ATT_UNIT(pi_) const int uid = 2 * (pi_) + grp, bh = uid >> 4, cu = uid & 15, hd = bh % 12, b = bh / 12, sh = 2 * (hd >> 2), L = 2048 >> sh; \
        const int r = cu >> (4 - sh), n = cu & ((16 >> sh) - 1), q0 = 128 * n; const size_t pbase = ((size_t)bh * 2048 + (size_t)r * L) * 64;
#define ATT_LOAD(pi_) do { ATT_UNIT(pi_) (void)b; (void)hd; const bf16* Kp = Kd + pbase; const bf16* Vp = Vd + pbase; const bf16* Qp = Qd + pbase; \
        _Pragma("unroll") for (int j = 0; j < 8; ++j) { const int id = tl + 256 * j, row = id >> 3, ch = id & 7; int kr = q0 - 64 + row; kr = kr < 0 ? 0 : (kr > L - 1 ? L - 1 : kr); \
            kreg[j] = *(const u32x4*)(Kp + (size_t)kr * 64 + ch * 8); vreg[j] = *(const u32x4*)(Vp + (size_t)kr * 64 + ch * 8); } \
        _Pragma("unroll") for (int ks = 0; ks < 4; ++ks) qn[ks] = *(const bf16x8*)(Qp + (size_t)(q0 + 32 * w + ql) * 64 + 16 * ks + 8 * h); } while (0)
    u32x4 kreg[8], vreg[8]; bf16x8 qn[4];
    if (vcu < 1536) ATT_LOAD(vcu);
    for (int pi = vcu; pi < 1536; pi += G) {
        ATT_UNIT(pi)
        __syncthreads();
        int hh = h, qll = ql; asm volatile("" : "+v"(hh), "+v"(qll));
#pragma unroll
        for (int j = 0; j < 8; ++j) { const int id = tl + 256 * j, row = id >> 3, ch = id & 7; *(LAS u32x4*)(Ks + row * KROW + ch * 16) = kreg[j]; *(LAS u32x4*)(Vs + row * KROW + ch * 16) = vreg[j]; }
        bf16x8 qf[4];
#pragma unroll
        for (int ks = 0; ks < 4; ++ks) qf[ks] = qn[ks];
        __syncthreads();
        if (pi + G < 1536) ATT_LOAD(pi + G);
        const float slope2 = exp2f(-8.f * (float)(hd + 1) / 12.f) * (float)(1 << sh) * 1.4426950408889634f;
        const int nb = qll - 4 * hh;
        const float sbp = -slope2 * (float)nb;
        bool tv[5];
#pragma unroll
        for (int kt = 0; kt < 5; ++kt) { const int klo = q0 + 32 * w + 32 * kt - 64; tv[kt] = (klo >= 0) && (klo + 32 <= L); }
        f32x16 sT[5]; float mx = -1e30f;
#pragma unroll
        for (int kt = 0; kt < 5; ++kt) {
            if (tv[kt]) {
                const float c0 = kt < 2 ? sbp : (kt == 2 ? 0.f : -sbp);
                f32x16 acc;
#pragma unroll
                for (int rr = 0; rr < 16; ++rr) acc[rr] = c0;
#pragma unroll
                for (int ks = 0; ks < 4; ++ks) { const bf16x8 af = *(LAS const bf16x8*)(Ks + (32 * w + 32 * kt + ql) * KROW + ks * 32 + h * 16);
                    acc = __builtin_amdgcn_mfma_f32_32x32x16_bf16(af, qf[ks], acc, 0, 0, 0); }
#pragma unroll
                for (int rr = 0; rr < 16; ++rr) { const int c = (rr & 3) + 8 * (rr >> 2); float sv = acc[rr];
                    if (kt < 2) sv = fmaf(slope2, (float)(32 * kt - 64 + c), sv);
                    else if (kt > 2) sv = fmaf(-slope2, (float)(32 * kt - 64 + c), sv);
                    else sv = fmaf(-slope2, fabsf((float)c - (float)nb), sv);
                    if (kt == 0) sv = (c >= nb) ? sv : -1e30f;
                    if (kt == 4) sv = (c <= nb) ? sv : -1e30f;
                    acc[rr] = sv; mx = fmaxf(mx, sv); }
                sT[kt] = acc; } }
        { const auto rr_ = __builtin_amdgcn_permlane32_swap(__builtin_bit_cast(unsigned, mx), __builtin_bit_cast(unsigned, mx), false, false); mx = fmaxf(__builtin_bit_cast(float, (unsigned)rr_[0]), __builtin_bit_cast(float, (unsigned)rr_[1])); }
        float den = 0.f;
#pragma unroll
        for (int kt = 0; kt < 5; ++kt)
            if (tv[kt]) {
#pragma unroll
                for (int rr = 0; rr < 16; ++rr) { const float p = __builtin_amdgcn_exp2f(sT[kt][rr] - mx); sT[kt][rr] = p; den += p; } }
        { const auto rr_ = __builtin_amdgcn_permlane32_swap(__builtin_bit_cast(unsigned, den), __builtin_bit_cast(unsigned, den), false, false); den = __builtin_bit_cast(float, (unsigned)rr_[0]) + __builtin_bit_cast(float, (unsigned)rr_[1]); }
        f32x16 o[2]; o[0] = f32x16{}; o[1] = f32x16{};
        const int g4 = lane >> 4, i16 = lane & 15, qq = i16 >> 2, pp = i16 & 3;
        LAS const unsigned char* vb = Vs + (32 * w + 4 * h + qq) * KROW + (16 * (g4 & 1) + 4 * pp) * 2;
#pragma unroll
        for (int s2 = 0; s2 < 10; ++s2) { const int kt = s2 >> 1, rb = 8 * (s2 & 1);
            if (tv[kt]) {
            u32x4 pw; pw.x = cvtpk(sT[kt][rb + 0], sT[kt][rb + 1]); pw.y = cvtpk(sT[kt][rb + 2], sT[kt][rb + 3]); pw.z = cvtpk(sT[kt][rb + 4], sT[kt][rb + 5]); pw.w = cvtpk(sT[kt][rb + 6], sT[kt][rb + 7]);
            const bf16x8 pf = __builtin_bit_cast(bf16x8, pw);
#pragma unroll
            for (int ct = 0; ct < 2; ++ct) { const s16x4 lo = vtr(vb + (16 * s2) * KROW + ct * 64), hi4 = vtr(vb + (16 * s2 + 8) * KROW + ct * 64);
                const bf16x8 af = (bf16x8){lo[0], lo[1], lo[2], lo[3], hi4[0], hi4[1], hi4[2], hi4[3]};
                o[ct] = __builtin_amdgcn_mfma_f32_32x32x16_bf16(af, pf, o[ct], 0, 0, 0); } } }
        const float inv = 1.f / den;
        __syncthreads();
        LAS unsigned char* ost = Ks + w * (32 * KROW);
#pragma unroll
        for (int ct = 0; ct < 2; ++ct)
#pragma unroll
            for (int a4 = 0; a4 < 4; ++a4) { u32x2 wv2; wv2.x = cvtpk(o[ct][4 * a4] * inv, o[ct][4 * a4 + 1] * inv); wv2.y = cvtpk(o[ct][4 * a4 + 2] * inv, o[ct][4 * a4 + 3] * inv);
                *(LAS u32x2*)(ost + ql * KROW + (32 * ct + 8 * a4 + 4 * h) * 2) = wv2; }
        {   const int pos = ((q0 + 32 * w + ql) << sh) + r; const size_t t = (size_t)b * 2048 + pos;
            if (h == 0) LSE[t * 12 + hd] = 0.6931471805599453f * (mx + __builtin_amdgcn_logf(den)); }
        asm volatile("s_waitcnt lgkmcnt(0)" ::: "memory");
#pragma unroll
        for (int i = 0; i < 4; ++i) { const int qr = 8 * i + (lane >> 3), ch = lane & 7;
            const u32x4 v = *(LAS const u32x4*)(ost + qr * KROW + ch * 16);
            const size_t t = (size_t)b * 2048 + (((q0 + 32 * w + qr) << sh) + r);
            *(u32x4*)(ORAW + t * 768 + hd * 64 + ch * 8) = v; }
    }
    __syncthreads();
#undef ATT_UNIT
#undef ATT_LOAD
}
}
namespace mixp {
typedef short bf16x8 __attribute__((ext_vector_type(8)));
typedef unsigned u32x4 __attribute__((ext_vector_type(4)));
__device__ __forceinline__ void unpack8(const u32x4 v, float (&f)[8]) {
#pragma unroll
    for (int i = 0; i < 4; ++i) { f[2 * i] = __builtin_bit_cast(float, v[i] << 16); f[2 * i + 1] = __builtin_bit_cast(float, v[i] & 0xffff0000u); }
}
__device__ __forceinline__ void mix_phase(const Args& a, LAS unsigned char* lds, int gw, int NGW, int wave, int lane) {
    unsigned char* ws = a.ws;
    LAS float* al = (LAS float*)(lds + wave * 1024);
    constexpr int PROW = 528;
    LAS unsigned char* pst = lds + 8192 + wave * (32 * PROW);
    const bf16* P = (const bf16*)(ws + WS_P); const bf16* ORAW = (const bf16*)(ws + WS_ORAW); const float* LSE = (const float*)(ws + WS_LSE);
    bf16* MIXIN = (bf16*)(ws + WS_MIXIN); const bf16* WpT = (const bf16*)(ws + WS_WPT); const float* pool_scale = a.in[4];
    for (int u = gw; u < M / 16; u += NGW) {
        const int t0 = 16 * u;
#pragma unroll
        for (int j = 0; j < 3; ++j) { const int id = lane + 64 * j, tk = id / 12, hd = id % 12, s = hd & 3, g = hd >> 2;
            const float* lp = LSE + (size_t)(t0 + tk) * 12 + s; const float l0 = lp[0], l1 = lp[4], l2 = lp[8];
            const float mx = fmaxf(l0, fmaxf(l1, l2)); const float e0 = __expf(l0 - mx), e1 = __expf(l1 - mx), e2 = __expf(l2 - mx);
            al[id] = (g == 0 ? e0 : (g == 1 ? e1 : e2)) / (e0 + e1 + e2); }
        asm volatile("s_waitcnt lgkmcnt(0)" ::: "memory");
#pragma unroll 12
        for (int it = 0; it < 24; ++it) { const int id = lane + 64 * it, tk = id / 96, ch = id % 96, hd = ch >> 3;
            const u32x4 v = *(const u32x4*)(ORAW + (size_t)(t0 + tk) * 768 + ch * 8); const float alpha = al[tk * 12 + hd];
            float f[8]; unpack8(v, f); u32x4 o;
#pragma unroll
            for (int i = 0; i < 4; ++i) o[i] = pk2(f[2 * i] * alpha, f[2 * i + 1] * alpha);
            *(u32x4*)(MIXIN + (size_t)(t0 + tk) * D + 256 + ch * 8) = o; }
        asm volatile("s_waitcnt lgkmcnt(0)" ::: "memory");
        const int ti = lane & 15, kq = lane >> 4, pos = (t0 + ti) & 2047, b0 = t0 - (t0 & 2047);
#pragma unroll
        for (int j = 0; j < 16; ++j) { const int rr = 2 * j + (lane >> 5), ch = lane & 31; int tr = t0 - 8 + rr; tr = tr < b0 ? b0 : (tr > b0 + 2047 ? b0 + 2047 : tr);
            const u32x4 v = *(const u32x4*)(P + (size_t)tr * 256 + ch * 8); *(LAS u32x4*)(pst + rr * PROW + ch * 16) = v; }
        asm volatile("s_waitcnt lgkmcnt(0)" ::: "memory");
        f32x4 acc[4][4];
#pragma unroll
        for (int gi = 0; gi < 4; ++gi) { const int hw = 1 << gi;
#pragma unroll
            for (int dt = 0; dt < 4; ++dt) acc[gi][dt] = (f32x4){0.f, 0.f, 0.f, 0.f};
#pragma unroll
            for (int kk = 0; kk < 2; ++kk) { const int cg = 64 * gi + 32 * kk + 8 * kq;
                float sum[8]; int cnt = 0;
#pragma unroll
                for (int i = 0; i < 8; ++i) sum[i] = 0.f;
#pragma unroll
                for (int dj = -hw; dj < hw; ++dj) { const int p2 = pos + dj; const bool ok = (p2 >= 0) && (p2 < 2048);
                    const u32x4 v = *(LAS const u32x4*)(pst + (ti + 8 + dj) * PROW + cg * 2); float f[8]; unpack8(v, f);
                    if (ok) {
#pragma unroll
                        for (int i = 0; i < 8; ++i) sum[i] += f[i];
                        ++cnt; } }
                const u32x4 ov = *(LAS const u32x4*)(pst + (ti + 8) * PROW + cg * 2); float own[8]; unpack8(ov, own);
                const float rc = 1.f / (float)cnt; u32x4 aw;
#pragma unroll
                for (int i = 0; i < 4; ++i) aw[i] = pk2(sum[2 * i] * rc - own[2 * i], sum[2 * i + 1] * rc - own[2 * i + 1]);
                const bf16x8 af = __builtin_bit_cast(bf16x8, aw);
#pragma unroll
                for (int dt = 0; dt < 4; ++dt) { const bf16x8 bfr = *(const bf16x8*)(WpT + gi * 4096 + (16 * dt + ti) * 64 + 32 * kk + 8 * kq);
                    acc[gi][dt] = __builtin_amdgcn_mfma_f32_16x16x32_bf16(af, bfr, acc[gi][dt], 0, 0, 0); } } }
        asm volatile("s_waitcnt lgkmcnt(0)" ::: "memory");
#pragma unroll
        for (int gi = 0; gi < 4; ++gi)
#pragma unroll
            for (int dt = 0; dt < 4; ++dt) { const int d = 64 * gi + 16 * dt + ti; const float sc = pool_scale[d];
#pragma unroll
                for (int rg = 0; rg < 4; ++rg) { const float fv = acc[gi][dt][rg]; *(LAS unsigned short*)(pst + (4 * kq + rg) * PROW + d * 2) = (unsigned short)f2bf(fv * sc); } }
        asm volatile("s_waitcnt lgkmcnt(0)" ::: "memory");
#pragma unroll
        for (int j = 0; j < 8; ++j) { const int rr = 2 * j + (lane >> 5), ch = lane & 31;
            const u32x4 v = *(LAS const u32x4*)(pst + rr * PROW + ch * 16); *(u32x4*)(MIXIN + (size_t)(t0 + rr) * D + ch * 8) = v; }
        asm volatile("s_waitcnt lgkmcnt(0)" ::: "memory");
    }
}
}
namespace peer {
typedef unsigned u32x4 __attribute__((ext_vector_type(4)));
typedef unsigned u32x2 __attribute__((ext_vector_type(2)));
typedef int i32x4 __attribute__((ext_vector_type(4)));
constexpr int TOK_PER_BLK = 128, TOK_PER_WAVE = 16;
constexpr int L_SRT = 0, L_IDX = 0, L_ZW = 65536, L_XS = 65536, L_TOK = 131072, L_SS = 132096, L_TMP = 136192, L_XSUM = 136256;
constexpr size_t SLICE_BYTES = (size_t)NEXP * 128;
__device__ __forceinline__ float gelu_erf(float v) { return 0.5f * v * (1.f + erff(v * 0.70710678118654752f)); }
__device__ __forceinline__ int lane_xor1(int v) { return __builtin_amdgcn_mov_dpp(v, 0xB1, 0xF, 0xF, true); }
__device__ __forceinline__ int lane_xor2(int v) { return __builtin_amdgcn_mov_dpp(v, 0x4E, 0xF, 0xF, true); }
__device__ __forceinline__ int lane_hmirror(int v) { return __builtin_amdgcn_mov_dpp(v, 0x141, 0xF, 0xF, true); }
__device__ __forceinline__ float bf_lo(unsigned w) { return __builtin_bit_cast(float, w << 16); }
__device__ __forceinline__ float bf_hi(unsigned w) { return __builtin_bit_cast(float, w & 0xffff0000u); }

__device__ __forceinline__ void gather_phase(const Args& a, LAS unsigned char* lds, int vcu, int G, int wave, int lane) {
    unsigned char* ws = a.ws; float* out = a.out;
    const unsigned char* U8 = ws + WS_U8; const unsigned char* V8 = ws + WS_V8;
    const float* SU = (const float*)(ws + WS_SU); const float* SV = (const float*)(ws + WS_SV); const float* USUM = (const float*)(ws + WS_USUM);
    const unsigned short* IDX = (const unsigned short*)(ws + WS_IDX); const float* GATE = (const float*)(ws + WS_GATE);
    unsigned char* X8 = ws + WS_X8; const float* g_final = a.in[11];
    bf16* X2B = (bf16*)(ws + WS_XN);
    for (int tb = vcu; tb < M / TOK_PER_BLK; tb += G) {
        __syncthreads();
        const int T0 = tb * TOK_PER_BLK + wave * TOK_PER_WAVE, tl0 = wave * TOK_PER_WAVE;
        LAS unsigned short* idxl = (LAS unsigned short*)(lds + L_IDX) + tl0 * 128;
        LAS int* zw = (LAS int*)(lds + L_ZW) + tl0 * 128;
        LAS float* tokf = (LAS float*)(lds + L_TOK) + tl0 * 2;
        LAS float* ssl = (LAS float*)(lds + L_SS) + tl0 * 8;
        for (int tk4 = 0; tk4 < TOK_PER_WAVE; tk4 += 4) {
          u32x4 xbA[4], xbB[4];
#pragma unroll
          for (int u = 0; u < 4; ++u) { const int t = T0 + tk4 + u; xbA[u] = *(const u32x4*)(X2B + (size_t)t * D + 16 * lane); xbB[u] = *(const u32x4*)(X2B + (size_t)t * D + 16 * lane + 8); }
#pragma unroll
          for (int u = 0; u < 4; ++u) { const int tk = tk4 + u, t = T0 + tk;
            f32x4 x2[4]; float ss = 0.f, amax = 0.f;
            const u32x4 xb0 = xbA[u], xb1 = xbB[u];
#pragma unroll
            for (int j = 0; j < 4; ++j) { const unsigned w0 = (j < 2 ? xb0 : xb1)[2 * (j & 1)], w1 = (j < 2 ? xb0 : xb1)[2 * (j & 1) + 1];
                x2[j] = (f32x4){bf_lo(w0), bf_hi(w0), bf_lo(w1), bf_hi(w1)};
                ss += (x2[j].x * x2[j].x + x2[j].y * x2[j].y) + (x2[j].z * x2[j].z + x2[j].w * x2[j].w);
                amax = fmaxf(amax, fmaxf(fmaxf(fabsf(x2[j].x), fabsf(x2[j].y)), fmaxf(fabsf(x2[j].z), fabsf(x2[j].w)))); }
            ss = wave_sum(ss); amax = wave_max(amax);
            const float rstd = rsqrtf(ss * (1.f / D) + 1e-6f), inv = amax > 0.f ? 127.f / amax : 0.f, sx = amax * (1.f / 127.f);
            unsigned wh[2] = {0u, 0u}, wl[2] = {0u, 0u}; float xs_ = 0.f;
#pragma unroll
            for (int j = 0; j < 4; ++j) { const float f_[4] = {x2[j].x, x2[j].y, x2[j].z, x2[j].w};
#pragma unroll
                for (int c = 0; c < 4; ++c) { const float qf = rintf(f_[c] * inv) + 128.f; xs_ += qf; const unsigned q_ = (unsigned)(int)qf; const int sh = 4 * (4 * (j & 1) + c);
                    wh[j >> 1] |= (q_ >> 4) << sh; wl[j >> 1] |= (q_ & 15u) << sh; } }
            xs_ = wave_sum(xs_);
            { unsigned char* xp_ = X8 + (size_t)t * D + 256 * (lane >> 4) + 8 * (lane & 15);
              *(u32x2*)xp_ = (u32x2){wh[0], wh[1]}; *(u32x2*)(xp_ + 128) = (u32x2){wl[0], wl[1]}; }
            if (lane == 0) ((LAS float*)(lds + L_XSUM))[tl0 + tk] = xs_;
            if (lane < 8) ssl[tk * 8 + lane] = 0.f;
            if (lane == 0) { tokf[tk * 2] = sx * rstd; tokf[tk * 2 + 1] = 0.f; } } }
        asm volatile("s_waitcnt vmcnt(0) lgkmcnt(0)" ::: "memory");
        const int tid = wave * 64 + lane;
        const unsigned rot = (unsigned)(vcu & 31) * 64u + (unsigned)(vcu >> 5) * 8u;
        LAS unsigned* cnt = (LAS unsigned*)(lds + L_ZW);
        LAS unsigned* srt = (LAS unsigned*)(lds + L_SRT);
        const unsigned short* IDXb = IDX + (size_t)tb * TOK_PER_BLK * 128;
        const unsigned char* X8b = X8 + (size_t)tb * TOK_PER_BLK * D;
        {   u32x4 iv[4];
#pragma unroll
            for (int j = 0; j < 4; ++j) iv[j] = *(const u32x4*)(IDXb + 32 * tid + 8 * j);
#pragma unroll
            for (int j = 0; j < 4; ++j) *(LAS u32x4*)(lds + L_ZW + 8192 * j + 16 * tid) = (u32x4){0u, 0u, 0u, 0u};
            __syncthreads();
            unsigned er[32];
#pragma unroll
            for (int j = 0; j < 32; ++j) { const unsigned w_ = iv[j >> 3][(j >> 1) & 3]; const unsigned e = (j & 1) ? (w_ >> 16) : (w_ & 0xffffu); const unsigned ek = (e + rot) & 0x3fffu, sh = (ek & 1u) << 4;
                const unsigned old = __hip_atomic_fetch_add(cnt + (ek >> 1), 1u << sh, __ATOMIC_RELAXED, __HIP_MEMORY_SCOPE_WORKGROUP);
                er[j] = e | (((old >> sh) & 0xffffu) << 14); }
            __syncthreads();
            u32x4 cw[4]; unsigned tot = 0;
#pragma unroll
            for (int j = 0; j < 4; ++j) { cw[j] = *(LAS const u32x4*)(lds + L_ZW + 64 * tid + 16 * j);
#pragma unroll
                for (int i = 0; i < 4; ++i) tot += (cw[j][i] & 0xffffu) + (cw[j][i] >> 16); }
            unsigned inc = tot;
#pragma unroll
            for (int d = 1; d < 64; d <<= 1) { const unsigned t_ = (unsigned)__shfl_up((int)inc, d, 64); if (lane >= d) inc += t_; }
            LAS unsigned* tmp = (LAS unsigned*)(lds + L_TMP);
            if (lane == 63) tmp[wave] = inc;
            __syncthreads();
            unsigned run = inc - tot;
#pragma unroll
            for (int w_ = 0; w_ < 8; ++w_) { const unsigned t_ = tmp[w_]; if (w_ < wave) run += t_; }
#pragma unroll
            for (int j = 0; j < 4; ++j) {
#pragma unroll
                for (int i = 0; i < 4; ++i) { const unsigned w_ = cw[j][i]; const unsigned lo_ = run; run += w_ & 0xffffu; const unsigned hi_ = run; run += w_ >> 16; cw[j][i] = lo_ | (hi_ << 16); }
                *(LAS u32x4*)(lds + L_ZW + 64 * tid + 16 * j) = cw[j]; }
            __syncthreads();
#pragma unroll
            for (int j = 0; j < 32; ++j) { const unsigned e = er[j] & 0x3fffu, rank = er[j] >> 14, ek = (e + rot) & 0x3fffu; const unsigned w_ = cnt[ek >> 1]; const unsigned off = (w_ >> ((ek & 1u) << 4)) & 0xffffu;
                srt[off + rank] = (e << 14) | (unsigned)(32 * tid + j); }
            __syncthreads();
        }
        { const int g = lane >> 3, i8 = lane & 7;
#define PEER_ULOAD(buf, s, ea_, eb_) do { const unsigned char* Us_ = U8 + (size_t)(s) * SLICE_BYTES;     \
            _Pragma("unroll") for (int it = 0; it < 8; ++it) { const unsigned en_ = it < 4 ? ea_[it] : eb_[it - 4]; buf[it] = *(const u32x4*)(Us_ + (((en_ >> 7) & 0x1fff80u) | lo16u)); } } while (0)
#define PEER_SLOT(BL, sl, vl, BC, sc, vc) do { const u32x4 ean_ = *(LAS const u32x4*)(srt_g + (vl) * 256), ebn_ = *(LAS const u32x4*)(srt_g + (vl) * 256 + 16); \
            LAS const unsigned char* xs_ = lds + L_XS + ((sc) & 1) * 32768 + lo16u; u32x4 xh[8], xl[8]; int d_[8], a_[4], b_[2]; \
            _Pragma("unroll") for (int it = 0; it < 8; ++it) { const unsigned en_ = it < 4 ? eac[it] : ebc[it - 4]; const unsigned xo_ = (en_ << 1) & 0x7f00u; \
                xh[it] = *(LAS const u32x4*)(xs_ + xo_); xl[it] = *(LAS const u32x4*)(xs_ + xo_ + 128); } \
            PEER_ULOAD(BL, sl, ean_, ebn_); \
            _Pragma("unroll") for (int it = 0; it < 8; ++it) { \
                unsigned ah = __builtin_amdgcn_udot8(BC[it].x, xh[it].x, 0u, false), al = __builtin_amdgcn_udot8(BC[it].x, xl[it].x, 0u, false); \
                ah = __builtin_amdgcn_udot8(BC[it].y, xh[it].y, ah, false); al = __builtin_amdgcn_udot8(BC[it].y, xl[it].y, al, false); \
                ah = __builtin_amdgcn_udot8(BC[it].z, xh[it].z, ah, false); al = __builtin_amdgcn_udot8(BC[it].z, xl[it].z, al, false); \
                ah = __builtin_amdgcn_udot8(BC[it].w, xh[it].w, ah, false); al = __builtin_amdgcn_udot8(BC[it].w, xl[it].w, al, false); \
                d_[it] = (int)((ah << 4) + al); } \
              \
              \
            _Pragma("unroll") for (int p = 0; p < 4; ++p) { const int keep = q2 ? d_[4 + p] : d_[p], send = q2 ? d_[p] : d_[4 + p]; a_[p] = keep + lane_hmirror(send); } \
            _Pragma("unroll") for (int p = 0; p < 2; ++p) { const int keep = q0 ? a_[2 * p + 1] : a_[2 * p], send = q0 ? a_[2 * p] : a_[2 * p + 1]; b_[p] = keep + lane_xor1(send); } \
            { const int keep = q1 ? b_[1] : b_[0], send = q1 ? b_[0] : b_[1]; zreg[vc] += keep + lane_xor2(send); } \
            eac = ean_; ebc = ebn_; } while (0)
        {   const bool q0 = lane & 1, q1 = lane & 2, q2 = lane & 4; const unsigned lo16u = (unsigned)i8 << 4;
            LAS const unsigned char* srt_g = lds + L_SRT + (wave * 2048 + 8 * g) * 4;
            const unsigned char* xsrc = X8b + (size_t)(tl0 + (lane >> 4)) * D + 16 * (lane & 15);
#define PEER_XSTAGE(s, b) do { _Pragma("unroll") for (int i_ = 0; i_ < 4; ++i_) \
                __builtin_amdgcn_global_load_lds((const GAS unsigned*)(xsrc + (size_t)(4 * i_) * D + 256 * (s)), (LAS unsigned*)(lds + L_XS + (b) * 32768 + (tl0 + 4 * i_) * 256), 16, 0, 0); } while (0)
            PEER_XSTAGE(0, 0);
            int zreg[32];
#pragma unroll
            for (int vp = 0; vp < 32; ++vp) zreg[vp] = 0;
            u32x4 u0[8], u1[8];
            u32x4 eac = *(LAS const u32x4*)srt_g, ebc = *(LAS const u32x4*)(srt_g + 16);
            PEER_ULOAD(u0, 0, eac, ebc);
            asm volatile("s_waitcnt vmcnt(0) lgkmcnt(0)\n\ts_barrier" ::: "memory");
            for (int s = 0; s < 4; ++s) {
                const int sn = s + 1 < 4 ? s + 1 : 3;
                PEER_XSTAGE(sn, (s + 1) & 1);
#pragma unroll
                for (int vp = 0; vp < 32; vp += 2) {
                    PEER_SLOT(u1, s, vp + 1, u0, s, vp);
                    if (vp + 2 < 32) PEER_SLOT(u0, s, vp + 2, u1, s, vp + 1); else PEER_SLOT(u0, sn, 0, u1, s, vp + 1);
                }
                asm volatile("s_waitcnt vmcnt(8) lgkmcnt(0)\n\ts_barrier" ::: "memory");
            }
#pragma unroll
            for (int vp = 0; vp < 32; ++vp) { const unsigned en = *(LAS const unsigned*)(lds + L_SRT + (wave * 2048 + 64 * vp + lane) * 4); ((LAS int*)(lds + L_ZW))[en & 0x3fffu] = zreg[vp]; }
            asm volatile("s_waitcnt lgkmcnt(0)\n\ts_barrier" ::: "memory");
            {   u32x4 iv[4];
#pragma unroll
                for (int j = 0; j < 4; ++j) iv[j] = *(const u32x4*)(IDXb + (size_t)tl0 * 128 + 32 * lane + 8 * j);
#pragma unroll
                for (int j = 0; j < 4; ++j) *(LAS u32x4*)((LAS unsigned char*)idxl + 64 * lane + 16 * j) = iv[j]; }
        }
#undef PEER_ULOAD
#undef PEER_SLOT
#undef PEER_XSTAGE
        }
        asm volatile("s_waitcnt lgkmcnt(0)" ::: "memory");
        for (int tk = 0; tk < TOK_PER_WAVE; ++tk) { const int t = T0 + tk; const float cs = tokf[tk * 2]; const float xsum_t = ((LAS const float*)(lds + L_XSUM))[tl0 + tk];
            float w[2];
#pragma unroll
            for (int hf = 0; hf < 2; ++hf) { const int k = lane + 64 * hf; const unsigned e = idxl[tk * 128 + k];
                const float z = (float)(zw[tk * 128 + k] - 128 * (int)USUM[e] - 8 * (int)xsum_t + 1048576) * (SU[e] * cs);
                w[hf] = GATE[(size_t)t * 128 + k] * gelu_erf(z) * SV[e]; }
            const float wm = wave_max(fmaxf(fabsf(w[0]), fabsf(w[1]))), winv = wm > 0.f ? 127.f / wm : 0.f;
            asm volatile("s_waitcnt lgkmcnt(0)" ::: "memory");
            LAS signed char* wpb = (LAS signed char*)(zw + tk * 128);
            wpb[lane] = (signed char)(int)rintf(w[0] * winv); wpb[64 + lane] = (signed char)(int)rintf(w[1] * winv);
            if (lane == 0) tokf[tk * 2 + 1] = wm * (1.f / 127.f); }
        asm volatile("s_waitcnt lgkmcnt(0)" ::: "memory");
        {   const int g = lane >> 3, i8 = lane & 7; const unsigned lo16 = (unsigned)i8 << 4;
#define PEER_DLOAD(QB, WP, qi) do { const int s_ = (qi) >> 6, tok_ = 8 * (((qi) >> 5) & 1) + g, q_ = (qi) & 31; \
            const u32x2 id_ = *(LAS const u32x2*)(idxl + tok_ * 128 + 4 * q_); WP = zw[tok_ * 128 + q_]; const unsigned char* Vs_ = V8 + (size_t)s_ * SLICE_BYTES; \
            QB[0] = *(const u32x4*)(Vs_ + (((id_.x << 7) & 0x7fff80u) | lo16)); QB[1] = *(const u32x4*)(Vs_ + (((id_.x >> 9) & 0x7fff80u) | lo16)); \
            QB[2] = *(const u32x4*)(Vs_ + (((id_.y << 7) & 0x7fff80u) | lo16)); QB[3] = *(const u32x4*)(Vs_ + (((id_.y >> 9) & 0x7fff80u) | lo16)); } while (0)
#define PEER_DACC(QB, WP) do { \
            _Pragma("unroll") for (int j = 0; j < 4; ++j) { const unsigned A_ = QB[0][j], B_ = QB[1][j], C_ = QB[2][j], D_ = QB[3][j]; \
                const unsigned t0 = __builtin_amdgcn_perm(B_, A_, 0x05010400u), t1 = __builtin_amdgcn_perm(B_, A_, 0x07030602u); \
                const unsigned u0 = __builtin_amdgcn_perm(D_, C_, 0x05010400u), u1 = __builtin_amdgcn_perm(D_, C_, 0x07030602u); \
                acc[4 * j + 0] = __builtin_amdgcn_sdot4((int)__builtin_amdgcn_perm(u0, t0, 0x05040100u), WP, acc[4 * j + 0], false); \
                acc[4 * j + 1] = __builtin_amdgcn_sdot4((int)__builtin_amdgcn_perm(u0, t0, 0x07060302u), WP, acc[4 * j + 1], false); \
                acc[4 * j + 2] = __builtin_amdgcn_sdot4((int)__builtin_amdgcn_perm(u1, t1, 0x05040100u), WP, acc[4 * j + 2], false); \
                acc[4 * j + 3] = __builtin_amdgcn_sdot4((int)__builtin_amdgcn_perm(u1, t1, 0x07060302u), WP, acc[4 * j + 3], false); } } while (0)
#define PEER_DX2(qi) do { const int s_ = (qi) >> 6, tok_ = 8 * (((qi) >> 5) & 1) + g; const bf16* xp_ = X2B + (size_t)(T0 + tok_) * D + 128 * s_ + 16 * i8; \
            x2a = *(const u32x4*)xp_; x2b = *(const u32x4*)(xp_ + 8); } while (0)
#define PEER_DFIN(qi) do { const int s_ = (qi) >> 6, tok_ = 8 * (((qi) >> 5) & 1) + g; const float wsc = tokf[tok_ * 2 + 1]; float ssq = 0.f; u32x4 oa, ob; \
            _Pragma("unroll") for (int j = 0; j < 4; ++j) { const unsigned w_ = x2a[j]; const float f0 = bf_lo(w_) + (float)acc[2 * j] * wsc, f1 = bf_hi(w_) + (float)acc[2 * j + 1] * wsc; ssq += f0 * f0 + f1 * f1; oa[j] = pk2(f0, f1); } \
            _Pragma("unroll") for (int j = 0; j < 4; ++j) { const unsigned w_ = x2b[j]; const float f0 = bf_lo(w_) + (float)acc[8 + 2 * j] * wsc, f1 = bf_hi(w_) + (float)acc[8 + 2 * j + 1] * wsc; ssq += f0 * f0 + f1 * f1; ob[j] = pk2(f0, f1); } \
            bf16* xp_ = X2B + (size_t)(T0 + tok_) * D + 128 * s_ + 16 * i8; *(u32x4*)xp_ = oa; *(u32x4*)(xp_ + 8) = ob; \
            __hip_atomic_fetch_add(ssl + tok_ * 8 + i8, ssq, __ATOMIC_RELAXED, __HIP_MEMORY_SCOPE_WORKGROUP); } while (0)
            u32x4 q0[4], q1[4], q2[4], q3[4], q4[4], q5[4], q6[4], q7[4], x2a, x2b; int w0, w1, w2, w3, w4, w5, w6, w7, acc[16];
            PEER_DLOAD(q0, w0, 0); PEER_DLOAD(q1, w1, 1); PEER_DLOAD(q2, w2, 2); PEER_DLOAD(q3, w3, 3); PEER_DLOAD(q4, w4, 4); PEER_DLOAD(q5, w5, 5); PEER_DLOAD(q6, w6, 6);
            for (int i = 0; i < 512 / 8 - 1; ++i) {
                const int qi = 8 * i;
                if ((i & 3) == 0) {
#pragma unroll
                    for (int c = 0; c < 16; ++c) acc[c] = 0; }
                if ((i & 3) == 3) PEER_DX2(qi);
                PEER_DLOAD(q7, w7, qi + 7); PEER_DACC(q0, w0); PEER_DLOAD(q0, w0, qi + 8); PEER_DACC(q1, w1); PEER_DLOAD(q1, w1, qi + 9); PEER_DACC(q2, w2); PEER_DLOAD(q2, w2, qi + 10); PEER_DACC(q3, w3); PEER_DLOAD(q3, w3, qi + 11); PEER_DACC(q4, w4); PEER_DLOAD(q4, w4, qi + 12); PEER_DACC(q5, w5); PEER_DLOAD(q5, w5, qi + 13); PEER_DACC(q6, w6); PEER_DLOAD(q6, w6, qi + 14); PEER_DACC(q7, w7);
                if ((i & 3) == 3) PEER_DFIN(qi);
            }
            PEER_DX2(504); PEER_DLOAD(q7, w7, 511); PEER_DACC(q0, w0); PEER_DACC(q1, w1); PEER_DACC(q2, w2); PEER_DACC(q3, w3); PEER_DACC(q4, w4); PEER_DACC(q5, w5); PEER_DACC(q6, w6); PEER_DACC(q7, w7); PEER_DFIN(504);
#undef PEER_DLOAD
#undef PEER_DACC
#undef PEER_DX2
#undef PEER_DFIN
#undef PEER_DSTEP
        }
        asm volatile("s_waitcnt vmcnt(0) lgkmcnt(0)" ::: "memory");
        {   f32x4 gg[4];
#pragma unroll
            for (int j = 0; j < 4; ++j) gg[j] = ((const f32x4*)g_final)[lane + 64 * j];
            for (int tk4 = 0; tk4 < TOK_PER_WAVE; tk4 += 4) { u32x2 xb[4][4];
#pragma unroll
                for (int u = 0; u < 4; ++u)
#pragma unroll
                    for (int j = 0; j < 4; ++j) xb[u][j] = *(const u32x2*)(X2B + (size_t)(T0 + tk4 + u) * D + 4 * (lane + 64 * j));
#pragma unroll
                for (int u = 0; u < 4; ++u) { const int tk = tk4 + u, t = T0 + tk;
                    float sq = ssl[tk * 8 + (lane & 7)]; sq += dpp_mov<0xB1>(sq); sq += dpp_mov<0x4E>(sq); sq += dpp_mov<0x141>(sq);
                    const float r3 = rsqrtf(sq * (1.f / D) + 1e-6f);
#pragma unroll
                    for (int j = 0; j < 4; ++j) { const u32x2 w_ = xb[u][j]; const f32x4 x3 = (f32x4){bf_lo(w_.x), bf_hi(w_.x), bf_lo(w_.y), bf_hi(w_.y)};
                        *((f32x4*)(out + (size_t)t * D) + lane + 64 * j) = x3 * gg[j] * r3; } } } }
    }
}
}
namespace topk {
typedef short bf16x8 __attribute__((ext_vector_type(8)));
typedef float f32x16 __attribute__((ext_vector_type(16)));
typedef unsigned u32x4 __attribute__((ext_vector_type(4)));
constexpr int SKROW = 272;
__device__ __forceinline__ float fmax_(float a, float b) { float t; asm("v_max_f32 %0, %1, %2" : "=v"(t) : "v"(a), "v"(b)); return t; }
__device__ __forceinline__ void cswap(float& a, float& b) { float t, u; asm("v_max_f32 %0, %1, %2" : "=v"(t) : "v"(a), "v"(b)); asm("v_min_f32 %0, %1, %2" : "=v"(u) : "v"(a), "v"(b)); a = t; b = u; }
__device__ __forceinline__ void merge16(float (&c)[16]) {
#pragma unroll
    for (int j = 8; j > 0; j >>= 1)
#pragma unroll
        for (int i = 0; i < 16; ++i) { const int l = i ^ j; if (l > i) cswap(c[i], c[l]); }
}
__device__ __forceinline__ void sort16(float (&v)[16]) {
    constexpr int SA[60] = {0,1,2,3,4,5,7,9, 0,1,2,3,6,8,10,11, 0,2,4,6,7,10,12,14, 0,1,4,5,6,8,12,13, 1,3,4,5,8,9,13, 1,2,5,7,9,11, 2,3,9,11, 3,6,7,10, 3,5,7,9,11, 6,8};
    constexpr int SB[60] = {13,12,15,14,8,6,11,10, 5,7,9,4,13,14,15,12, 1,3,5,8,9,11,13,15, 2,3,10,11,7,9,14,15, 2,12,6,7,10,11,14, 4,6,8,10,13,14, 4,6,12,13, 5,8,9,12, 4,6,8,10,12, 7,9};
#pragma unroll
    for (int i = 0; i < 60; ++i) cswap(v[SA[i]], v[SB[i]]);
}
__device__ __forceinline__ void topmerge(float (&a)[16], const float (&b)[16]) {
#pragma unroll
    for (int i = 0; i < 16; ++i) a[i] = fmax_(a[i], b[15 - i]);
    merge16(a);
}
__device__ __forceinline__ void insert16(float (&a)[16], float x) {
#pragma unroll
    for (int i = 0; i < 16; ++i) cswap(a[i], x);
}
__device__ __forceinline__ float cand(float a, float b, unsigned ca, unsigned cb) { return __builtin_bit_cast(float, (__builtin_bit_cast(unsigned, a + b) & ~0x3fffu) | ca | cb); }

__device__ __forceinline__ void qhalf_load(u32x4 (&q)[8], const bf16* QPw, int lane) {
#pragma unroll
    for (int j = 0; j < 8; ++j) q[j] = *(const u32x4*)(QPw + (size_t)(4 * j + (lane >> 4)) * NQ + (lane & 15) * 8);
}
__device__ __forceinline__ void qhalf_stage(const u32x4 (&q)[8], LAS unsigned char* qst, int lane) {
#pragma unroll
    for (int j = 0; j < 8; ++j) *(LAS u32x4*)(qst + (4 * j + (lane >> 4)) * SKROW + (lane & 15) * 16) = q[j];
}
__device__ __forceinline__ void half_top16(float (&e)[16], LAS const unsigned char* qst, LAS const unsigned char* sk, int ql, int hh) {
    unsigned qoff = (unsigned)(ql * SKROW + hh * 16);
    float m0[16], m1[16];
#pragma unroll
    for (int kt = 0; kt < 4; ++kt) { f32x16 acc = {}; float v[16];
        asm volatile("" : "+v"(qoff));
#pragma unroll
        for (int ks = 0; ks < 8; ++ks) { const bf16x8 af = *(LAS const bf16x8*)(sk + (32 * kt + ql) * SKROW + ks * 32 + hh * 16);
            const bf16x8 bfr = *(LAS const bf16x8*)(qst + qoff + ks * 32);
            acc = __builtin_amdgcn_mfma_f32_32x32x16_bf16(af, bfr, acc, 0, 0, 0); }
#pragma unroll
        for (int rr = 0; rr < 16; ++rr) { const unsigned key = (unsigned)(32 * kt + (rr & 3) + 8 * (rr >> 2)) + 4u * (unsigned)hh;
            const float fv = acc[rr];
            v[rr] = __builtin_bit_cast(float, (__builtin_bit_cast(unsigned, fv) & ~0x7fu) | key); }
        sort16(v);
        if (kt == 0) {
#pragma unroll
            for (int i = 0; i < 16; ++i) m0[i] = v[i]; }
        else if (kt == 1) topmerge(m0, v);
        else if (kt == 2) {
#pragma unroll
            for (int i = 0; i < 16; ++i) m1[i] = v[i]; }
        else topmerge(m1, v); }
    topmerge(m0, m1);
#pragma unroll
    for (int i = 0; i < 16; ++i) { const unsigned x = __builtin_bit_cast(unsigned, m0[15 - i]);
        const auto rr = __builtin_amdgcn_permlane32_swap(x, x, false, false);
        const unsigned lo_ = rr[0], hi_ = rr[1];
        e[i] = fmax_(m0[i], __builtin_bit_cast(float, hh ? lo_ : hi_)); }
    merge16(e);
}

__device__ __forceinline__ void topk_phase(const Args& a, LAS unsigned char* lds, int bx, int G, int tid) {
    unsigned char* ws = a.ws;
    const int lane = tid & 63, wave = __builtin_amdgcn_readfirstlane(tid >> 6);
    const bf16* QP = (const bf16*)(ws + WS_QP); const bf16* SK = (const bf16*)(ws + WS_SK);
    unsigned short* IDX = (unsigned short*)(ws + WS_IDX); float* GATE = (float*)(ws + WS_GATE);
    const float* pu = a.in[9]; const float* pv = a.in[10]; const float* g_ffn = a.in[6];
    unsigned char* U4 = ws + WS_U8; signed char* V8 = (signed char*)(ws + WS_V8); float* SU = (float*)(ws + WS_SU); float* SV = (float*)(ws + WS_SV); float* USUM = (float*)(ws + WS_USUM);
    pg8::StaticOrder So; So.init(M, NQ, G, bx); pg8::Unit un;
    int h_staged = -1;
    int nun = 0; while (So.next(nun, un)) ++nun;
    const int ne = (nun + 1) >> 1;
    LAS unsigned char* qst = lds + 256 * SKROW + wave * (32 * SKROW);
    u32x4 qa[8], qb[8];
    if (nun > 0) { So.next(0, un); qhalf_load(qa, QP + (size_t)(256 * un.pm + 32 * wave) * NQ + un.pn * 256, lane); }
    for (int uo = 0; uo < nun; ++uo) {
        const int ui = uo < ne ? 2 * uo : 2 * (uo - ne) + 1; So.next(ui, un);
        const int h = un.pn, tt = un.pm;
        int lane_ = lane; asm volatile("" : "+v"(lane_));
        const int ql = lane_ & 31, hh = lane_ >> 5, tid_ = wave * 64 + lane_;
        const int er0 = ((ui * G + bx) * 8 + wave) * 2;
        if (h != h_staged) {
            __syncthreads();
#pragma unroll
            for (int j = 0; j < 8; ++j) { const int id = tid_ + 512 * j, row = id >> 4, ch = id & 15;
                const u32x4 v = *(const u32x4*)(SK + ((size_t)h * 256 + row) * 128 + ch * 8); *(LAS u32x4*)(lds + row * SKROW + ch * 16) = v; }
            __syncthreads(); h_staged = h;
        }
        const int t = 256 * tt + 32 * wave + ql;
        const bf16* QPw = QP + (size_t)(256 * tt + 32 * wave) * NQ + h * 256;
        float A[16], B[16];
        f32x4 rw[4];
        qhalf_stage(qa, qst, lane_);
        qhalf_load(qb, QPw + 128, lane_);
        quant_row_load(pu + (size_t)er0 * D, rw, lane_);
        half_top16(A, qst, lds, ql, hh);
        quant_row_finish_u4(rw, g_ffn, U4 + (size_t)er0 * 128, SU + er0, USUM + er0, lane_);
        qhalf_stage(qb, qst, lane_);
        if (uo + 1 < nun) { const int un_ = uo + 1, ui2 = un_ < ne ? 2 * un_ : 2 * (un_ - ne) + 1; pg8::Unit u2; So.next(ui2, u2);
            qhalf_load(qa, QP + (size_t)(256 * u2.pm + 32 * wave) * NQ + u2.pn * 256, lane_); }
        quant_row_load(pv + (size_t)er0 * D, rw, lane_);
        half_top16(B, qst, lds + 128 * SKROW, ql, hh);
        quant_row_finish(rw, nullptr, V8 + (size_t)er0 * 128, SV + er0, lane_);
        f32x4 rw2[4];
        quant_row_load(pu + (size_t)(er0 + 1) * D, rw, lane_); quant_row_load(pv + (size_t)(er0 + 1) * D, rw2, lane_);
        unsigned ca[16], cb[16];
#pragma unroll
        for (int i = 0; i < 16; ++i) { ca[i] = (__builtin_bit_cast(unsigned, A[i]) & 0x7fu) << 7; cb[i] = __builtin_bit_cast(unsigned, B[i]) & 0x7fu; }
        float X0[16], X1[16], X2[16];
#pragma unroll
        for (int j = 0; j < 16; ++j) X0[j] = cand(A[0], B[j], ca[0], cb[j]);
#pragma unroll
        for (int j = 0; j < 8; ++j) X1[j] = cand(A[1], B[j], ca[1], cb[j]);
#pragma unroll
        for (int j = 0; j < 5; ++j) X1[8 + j] = cand(A[2], B[j], ca[2], cb[j]);
#pragma unroll
        for (int j = 0; j < 3; ++j) X1[13 + j] = cand(A[4], B[j], ca[4], cb[j]);
#pragma unroll
        for (int j = 0; j < 4; ++j) X2[j] = cand(A[3], B[j], ca[3], cb[j]);
#pragma unroll
        for (int i = 5; i < 8; ++i)
#pragma unroll
            for (int j = 0; j < 2; ++j) X2[4 + 2 * (i - 5) + j] = cand(A[i], B[j], ca[i], cb[j]);
#pragma unroll
        for (int i = 8; i < 14; ++i) X2[10 + (i - 8)] = cand(A[i], B[0], ca[i], cb[0]);
        const float x14 = cand(A[14], B[0], ca[14], cb[0]), x15 = cand(A[15], B[0], ca[15], cb[0]);
        sort16(X1); sort16(X2);
        topmerge(X1, X2); topmerge(X0, X1); insert16(X0, x14); insert16(X0, x15);
        float sc[16]; float den = 0.f;
#pragma unroll
        for (int i = 0; i < 16; ++i) { sc[i] = __builtin_bit_cast(float, __builtin_bit_cast(unsigned, X0[i]) & ~0x3fffu); }
        const float m0 = sc[0];
#pragma unroll
        for (int i = 0; i < 16; ++i) { sc[i] = __expf(sc[i] - m0); den += sc[i]; }
        const float rd = 1.f / den;
        if (hh == 0) { u32x4 w0, w1;
#pragma unroll
            for (int i = 0; i < 4; ++i) { w0[i] = (__builtin_bit_cast(unsigned, X0[2 * i]) & 0x3fffu) | ((__builtin_bit_cast(unsigned, X0[2 * i + 1]) & 0x3fffu) << 16);
                w1[i] = (__builtin_bit_cast(unsigned, X0[8 + 2 * i]) & 0x3fffu) | ((__builtin_bit_cast(unsigned, X0[8 + 2 * i + 1]) & 0x3fffu) << 16); }
            u32x4* ip = (u32x4*)(IDX + (size_t)t * 128 + h * 16); ip[0] = w0; ip[1] = w1;
        } else { f32x4* gp = (f32x4*)(GATE + (size_t)t * 128 + h * 16);
#pragma unroll
            for (int i = 0; i < 4; ++i) gp[i] = (f32x4){sc[4 * i] * rd, sc[4 * i + 1] * rd, sc[4 * i + 2] * rd, sc[4 * i + 3] * rd}; }
        quant_row_finish_u4(rw, g_ffn, U4 + (size_t)(er0 + 1) * 128, SU + er0 + 1, USUM + er0 + 1, lane_); quant_row_finish(rw2, nullptr, V8 + (size_t)(er0 + 1) * 128, SV + er0 + 1, lane_);
    }
    __syncthreads();
}
}
__global__ void __launch_bounds__(NWAVES * 64, 2) mega_fwd(Args a) {
    extern __shared__ __attribute__((aligned(16))) unsigned char lds_raw[];
    LAS unsigned char* lds = (LAS unsigned char*)lds_raw;
    volatile LAS unsigned* MISC = (volatile LAS unsigned*)(lds + MISC_OFF);
    const int wave = __builtin_amdgcn_readfirstlane((int)threadIdx.x >> 6);
#define TID_NOW (wave * 64 + lane_now())
    const int G = gridDim.x, bx = blockIdx.x, vcu = (G % 8 == 0) ? (bx % 8) * (G / 8) + bx / 8 : bx;
    unsigned char* ws = a.ws;
    if (threadIdx.x < 32) ((LAS unsigned*)(lds + LDSCTL_OFF))[threadIdx.x] = 0u;
    __syncthreads();
    XcdBarrier bar = xcd_barrier_post((unsigned*)(ws + WS_CTL) + CW_BAR + a.li * XCD_BAR_WORDS, MISC + 8);
    const int lo = a.ph_lo, hi = a.ph_hi;
#define IN(k) (lo <= (k) && (k) < hi)
#define BOTH(k) (IN(k) && IN((k) + 1))
    if (IN(0)) { p0_prologue(a, lds, vcu * NWAVES + wave, G * NWAVES, wave, lane_now()); if (BOTH(0)) xcd_barrier(bar, wave); }
    if (IN(1)) {
        pg8::Gemm g{(const bf16*)(ws + WS_XN), (const bf16*)(ws + WS_WIN), M, NPROJ, D / 2}; pg8::StaticOrder So; So.init(M, NPROJ, G, bx);
        pg8::EpiInProj E{(bf16*)(ws + WS_P), (bf16*)(ws + WS_Q), (size_t)(WS_K - WS_Q) / 2, (const float*)(ws + WS_SA), (const float*)(ws + WS_SWIN)};
        pg8::gemm_phase<pg8::EpiInProj, pg8::StaticOrder, true, true, true>(lds, g, So, E, wave);
        if (BOTH(1)) xcd_barrier(bar, wave);
    }
    if (IN(2)) { attn::attn_phase(ws, lds, vcu, G, TID_NOW); if (BOTH(2)) xcd_barrier(bar, wave); }
    if (IN(3)) { mixp::mix_phase(a, lds, vcu * NWAVES + wave, G * NWAVES, wave, lane_now()); if (BOTH(3)) xcd_barrier(bar, wave); }
    if (IN(4)) {
        pg8::Gemm g{(const bf16*)(ws + WS_MIXIN), (const bf16*)(ws + WS_WOUT), M, D, D}; pg8::StaticOrder So; So.init(M, D, G, bx);
        pg8::EpiOutProj E{a.in[0], (bf16*)(ws + WS_XN), (float*)(ws + WS_ROWSS)};
        pg8::gemm_phase<pg8::EpiOutProj, pg8::StaticOrder, true, true>(lds, g, So, E, wave);
        if (BOTH(4)) xcd_barrier(bar, wave);
    }
    if (IN(5)) {
        pg8::Gemm g{(const bf16*)(ws + WS_XN), (const bf16*)(ws + WS_WQ), M, NQ, D}; pg8::StaticOrder So; So.init(M, NQ, G, bx);
        pg8::EpiPeerQ E{(bf16*)(ws + WS_QP), (const float*)(ws + WS_ROWSS)};
        pg8::gemm_phase<pg8::EpiPeerQ, pg8::StaticOrder, true, true>(lds, g, So, E, wave);
    }
    if (IN(6)) { topk::topk_phase(a, lds, bx, G, TID_NOW); if (BOTH(6)) xcd_barrier(bar, wave); }
    if (IN(7)) { peer::gather_phase(a, lds, vcu, G, wave, lane_now()); }
#undef IN
#undef BOTH
#undef TID_NOW
}
extern "C" void kernel_launch(void* const* d_in, const int* in_sizes, int n_in, void* d_out, int out_size, void* d_ws, size_t ws_size, hipStream_t stream) {
    static int grid = 0;
    if (grid == 0) {
        if (n_in != 12 || in_sizes[0] != M * D || out_size != M * D || ws_size < WS_END) { fprintf(stderr, "kernel_launch: unexpected shapes (n_in %d, in0 %d, out %d, ws %zu)\n", n_in, n_in > 0 ? in_sizes[0] : -1, out_size, ws_size); grid = -1; return; }
        int dev = 0, cus = 0, per_cu = 0;
        if (hipGetDevice(&dev) != hipSuccess || hipDeviceGetAttribute(&cus, hipDeviceAttributeMultiprocessorCount, dev) != hipSuccess) { fprintf(stderr, "kernel_launch: device query failed\n"); grid = -1; return; }
        if (hipFuncSetAttribute((const void*)mega_fwd, hipFuncAttributeMaxDynamicSharedMemorySize, LDS_BYTES) != hipSuccess) { fprintf(stderr, "kernel_launch: hipFuncSetAttribute failed\n"); grid = -1; return; }
        if (hipOccupancyMaxActiveBlocksPerMultiprocessor(&per_cu, (const void*)mega_fwd, NWAVES * 64, LDS_BYTES) != hipSuccess || per_cu < 1) { fprintf(stderr, "kernel_launch: occupancy query says %d blocks per CU\n", per_cu); grid = -1; (void)hipGetLastError(); return; }
        grid = cus;
    }
    if (grid < 0) return;
    (void)hipMemsetAsync((char*)d_ws + WS_CTL + CW_BAR * 4, 0, (CW_END - CW_BAR) * 4, stream);
    Args a{};
    for (int i = 0; i < 12; ++i) a.in[i] = (const float*)d_in[i];
    a.out = (float*)d_out; a.ws = (unsigned char*)d_ws; a.ph_lo = 0; a.ph_hi = 8; a.li = 0;
    hipLaunchKernelGGL(mega_fwd, dim3(grid), dim3(NWAVES * 64), LDS_BYTES, stream, a);
#ifdef PROBE_LO
    a.ph_lo = PROBE_LO; a.ph_hi = PROBE_HI; a.li = 1;
    hipLaunchKernelGGL(mega_fwd, dim3(grid), dim3(NWAVES * 64), LDS_BYTES, stream, a);
#endif
}
```

```cpp
#include <hip/hip_runtime.h>
#include <cstdio>
#include <cstdint>
__device__ __forceinline__ int lane_now() { int l; asm volatile("v_mbcnt_lo_u32_b32 %0, -1, 0\n\tv_mbcnt_hi_u32_b32 %0, -1, %0" : "=v"(l)); return l; }
namespace pg8 {
#define PG8_LAS __attribute__((address_space(3)))
typedef unsigned short bf16_t;
typedef short bf16x8 __attribute__((ext_vector_type(8)));
typedef float f32x4 __attribute__((ext_vector_type(4)));
typedef unsigned u32x4 __attribute__((ext_vector_type(4)));
typedef int i32x4 __attribute__((ext_vector_type(4)));
constexpr int BM = 256, BK = 64, HALF = 128, HTB = HALF * BK * 2  , STAGE_BYTES = 8 * HTB, NXCD = 8, WGM = 8;

__host__ __device__ __forceinline__ int lds_byte(int r, int c) { const int st = (r >> 4) * 2 + (c >> 5), rr = r & 15, cc = c & 31, ob = rr * 64 + cc * 2; return st * 1024 + (ob ^ (((ob >> 9) & 1) << 5)); }
__host__ __device__ __forceinline__ void stage_rc(int b, int& R, int& C) { const int st = b / 1024, sb = b % 1024, swz = sb ^ (((sb >> 9) & 1) << 5); R = (st >> 1) * 16 + swz / 64; C = (st & 1) * 32 + (swz % 64) / 2; }
__host__ __device__ __forceinline__ int perm32(int rho) { const int n = rho >> 4, i = rho & 15; return 8 * (i >> 2) + 4 * n + (i & 3); }

struct Unit { int pm, pn; };
struct Gemm { const bf16_t* A; const bf16_t* Bt; int M, N, K; };

struct StaticOrder {
    int nM, nN, nwg, G, c;
    __host__ __device__ void init(int M, int N, int G_, int c_) { nM = M / BM; nN = N / BM; nwg = nM * nN; G = G_; c = c_; }
    __host__ __device__ bool next(int i, Unit& u) const {
        const long L = (long)i * G + c; if (L >= nwg) return false;
        int wgid = (int)L; { const int q = nwg / NXCD, r = nwg % NXCD, xcd = wgid % NXCD, off = wgid / NXCD; wgid = (xcd < r ? xcd * (q + 1) : r * (q + 1) + (xcd - r) * q) + off; }
        const int nig = WGM * nN, gid = wgid / nig, fm = gid * WGM, gsz = (nM - fm) < WGM ? (nM - fm) : WGM;
        u.pm = fm + ((wgid % nig) % gsz); u.pn = (wgid % nig) / gsz; return true;
    }
    __device__ __forceinline__ void a_ready(const Unit&) const {}
    __device__ __forceinline__ void done(const Unit&) const {}
};

__device__ __forceinline__ unsigned cvt_pk_bf16(float lo, float hi) { unsigned r; asm volatile("v_cvt_pk_bf16_f32 %0, %1, %2" : "=v"(r) : "v"(lo), "v"(hi)); return r; }
typedef unsigned u32x2 __attribute__((ext_vector_type(2)));
constexpr float C2Q = 0.125f * 1.4426950408889634f;
struct EpiInProj {
    static constexpr bool PERM = true, AFTER_DRAIN = false;
    bf16_t* P; bf16_t* QKV; size_t ty_stride; const float* sa; const float* sw;
    __device__ __forceinline__ void operator()(const f32x4 (&acc)[2][2][4][2], const Unit& u, int wr, int wc, int fr, int fq) const {
        const int row0 = u.pm * BM + wr * 64 + fr;
        f32x4 swv[2][2];
#pragma unroll
        for (int bj = 0; bj < 2; ++bj)
#pragma unroll
            for (int n = 0; n < 2; ++n) swv[bj][n] = *(const f32x4*)(sw + u.pn * BM + bj * HALF + wc * 32 + 8 * fq + 4 * n);
#define PG8_I2F(x) __builtin_convertvector(__builtin_bit_cast(i32x4, (x)), f32x4)
        if (u.pn == 0) {
#pragma unroll
            for (int ai = 0; ai < 2; ++ai)
#pragma unroll
                for (int m = 0; m < 4; ++m) { bf16_t* rowp = P + (size_t)(row0 + ai * HALF + m * 16) * 256 + wc * 32 + 8 * fq; const float sar = sa[row0 + ai * HALF + m * 16];
#pragma unroll
                    for (int bj = 0; bj < 2; ++bj) { const f32x4 v0 = PG8_I2F(acc[ai][bj][m][0]) * swv[bj][0] * sar, v1 = PG8_I2F(acc[ai][bj][m][1]) * swv[bj][1] * sar;
                        u32x4 w; w.x = cvt_pk_bf16(v0[0], v0[1]); w.y = cvt_pk_bf16(v0[2], v0[3]); w.z = cvt_pk_bf16(v1[0], v1[1]); w.w = cvt_pk_bf16(v1[2], v1[3]);
                        *(u32x4*)(rowp + bj * HALF) = w; } }
        } else {
            const int ty = (u.pn - 1) / 3, g = (u.pn - 1) % 3, sh = 2 * g;
            const float sc = (ty == 0) ? C2Q : 1.f;
            bf16_t* base = QKV + (size_t)ty * ty_stride;
#pragma unroll
            for (int ai = 0; ai < 2; ++ai)
#pragma unroll
                for (int m = 0; m < 4; ++m) { const int row = row0 + ai * HALF + m * 16, b = row >> 11, pos = row & 2047;
                    const int seqp = ((pos & ((1 << sh) - 1)) << (11 - sh)) | (pos >> sh); const float sar = sa[row] * sc;
#pragma unroll
                    for (int bj = 0; bj < 2; ++bj) { const int cl = bj * HALF + wc * 32 + 8 * fq, hd = 4 * g + (cl >> 6), c = cl & 63;
                        const f32x4 v0 = PG8_I2F(acc[ai][bj][m][0]) * swv[bj][0] * sar, v1 = PG8_I2F(acc[ai][bj][m][1]) * swv[bj][1] * sar;
                        u32x4 w; w.x = cvt_pk_bf16(v0[0], v0[1]); w.y = cvt_pk_bf16(v0[2], v0[3]); w.z = cvt_pk_bf16(v1[0], v1[1]); w.w = cvt_pk_bf16(v1[2], v1[3]);
                        *(u32x4*)(base + ((size_t)((b * 12 + hd) * 2048 + seqp)) * 64 + c) = w; } }
        }
#undef PG8_I2F
    }
};
struct EpiOutProj {
    static constexpr bool PERM = true, AFTER_DRAIN = false;
    const signed char* xn8; const float* xs; bf16_t* x2b; float* rowss;
    __device__ __forceinline__ void operator()(const f32x4 (&acc)[2][2][4][2], const Unit& u, int wr, int wc, int fr, int fq) const {
        const int col0 = u.pn * BM + wc * 32 + 8 * fq;
#pragma unroll
        for (int ai = 0; ai < 2; ++ai)
#pragma unroll
            for (int m = 0; m < 4; ++m) { const int row = u.pm * BM + ai * HALF + wr * 64 + m * 16 + fr; const size_t off = (size_t)row * 1024 + col0; float ss = 0.f;
                const float xsr = xs[row], c0 = -128.f * xsr;
#pragma unroll
                for (int bj = 0; bj < 2; ++bj) { const size_t o2 = off + bj * HALF;
                    typedef unsigned u32x2_ __attribute__((ext_vector_type(2)));
                    const u32x2_ xb = *(const u32x2_*)(xn8 + o2); const unsigned b0 = xb.x ^ 0x80808080u, b1 = xb.y ^ 0x80808080u;
                    f32x4 o0 = acc[ai][bj][m][0] + c0, o1 = acc[ai][bj][m][1] + c0;
#pragma unroll
                    for (int i = 0; i < 4; ++i) { o0[i] = fmaf((float)((b0 >> (8 * i)) & 0xffu), xsr, o0[i]); o1[i] = fmaf((float)((b1 >> (8 * i)) & 0xffu), xsr, o1[i]); }
                    ss += ((o0[0] * o0[0] + o0[1] * o0[1]) + (o0[2] * o0[2] + o0[3] * o0[3])) + ((o1[0] * o1[0] + o1[1] * o1[1]) + (o1[2] * o1[2] + o1[3] * o1[3]));
                    u32x4 w; w.x = cvt_pk_bf16(o0[0], o0[1]); w.y = cvt_pk_bf16(o0[2], o0[3]); w.z = cvt_pk_bf16(o1[0], o1[1]); w.w = cvt_pk_bf16(o1[2], o1[3]);
                    *(u32x4*)(x2b + o2) = w; }
                ss += __shfl_xor(ss, 16); ss += __shfl_xor(ss, 32);
                if (fq == 0) atomicAdd(rowss + row, ss); }
    }
};
struct EpiPeerQ {
    static constexpr bool PERM = true, AFTER_DRAIN = false;
    bf16_t* O; const float* rowss;
    __device__ __forceinline__ void operator()(const f32x4 (&acc)[2][2][4][2], const Unit& u, int wr, int wc, int fr, int fq) const {
        const int row0 = u.pm * BM + wr * 64 + fr, col0 = u.pn * BM + wc * 32 + 8 * fq;
#pragma unroll
        for (int ai = 0; ai < 2; ++ai)
#pragma unroll
            for (int m = 0; m < 4; ++m) { const int row = row0 + ai * HALF + m * 16; const float rs = rsqrtf(rowss[row] * (1.f / 1024.f) + 1e-6f);
                bf16_t* rowp = O + (size_t)row * 2048 + col0;
#pragma unroll
                for (int bj = 0; bj < 2; ++bj) { const f32x4 v0 = acc[ai][bj][m][0] * rs, v1 = acc[ai][bj][m][1] * rs;
                    u32x4 w; w.x = cvt_pk_bf16(v0[0], v0[1]); w.y = cvt_pk_bf16(v0[2], v0[3]); w.z = cvt_pk_bf16(v1[0], v1[1]); w.w = cvt_pk_bf16(v1[2], v1[3]);
                    *(u32x4*)(rowp + bj * HALF) = w; } }
    }
};
template <class Epi, class Sched, bool ALIGN_EPI = false, bool SP2 = false, bool I8 = false>
__device__ __forceinline__ void gemm_phase(PG8_LAS unsigned char* lds, const Gemm g, const Sched& S, const Epi& E, int wid) {
    const int lane = lane_now(), tid = wid * 64 + lane, wr = wid >> 2, wc = wid & 3, fr = lane & 15, fq = lane >> 4;
    const int K = g.K, nt = K / BK;
    unsigned voffA[2], voffB[2];
#pragma unroll
    for (int i = 0; i < 2; ++i) { int R, C; stage_rc(tid * 16 + i * 8192, R, C); const int Rb = Epi::PERM ? ((R & ~31) + perm32(R & 31)) : R;
        voffA[i] = (unsigned)(R * K + C) * 2u; voffB[i] = (unsigned)(Rb * K + C) * 2u; }
    const size_t kstep = (size_t)(BK * 2);
    const size_t hstep = (size_t)HALF * K * 2;
    const size_t tstep = 2 * hstep;
    const unsigned ldsw = (unsigned)wid * 1024u;
    const int aoff = lds_byte(wr * 64 + fr, fq * 8), boff = lds_byte(wc * 32 + fr, fq * 8);
#define PG8_SA(b, h) (((b) * 2 + (h)) * HTB)
#define PG8_SB(b, h) ((4 + (b) * 2 + (h)) * HTB)
#define PG8_STAGE(bufoff, gbase, voff) do { _Pragma("unroll") for (int _i = 0; _i < 2; ++_i) \
        __builtin_amdgcn_global_load_lds((const unsigned*)((const char*)(gbase) + (voff)[_i]), (PG8_LAS unsigned*)(lds + (bufoff) + ldsw + _i * 8192), 16, 0, 0); } while (0)
#define PG8_LDA(dst, b, h) do { _Pragma("unroll") for (int m = 0; m < 4; ++m) _Pragma("unroll") for (int k = 0; k < 2; ++k) dst[m][k] = *(const PG8_LAS bf16x8*)(lds + PG8_SA(b, h) + aoff + m * 2048 + k * 1024); } while (0)
#define PG8_LDB(dst, b, h) do { _Pragma("unroll") for (int n = 0; n < 2; ++n) _Pragma("unroll") for (int k = 0; k < 2; ++k) dst[n][k] = *(const PG8_LAS bf16x8*)(lds + PG8_SB(b, h) + boff + n * 2048 + k * 1024); } while (0)
#define PG8_MMA(ai, bj, At, Bt) do { __builtin_amdgcn_s_setprio(1); _Pragma("unroll") for (int m = 0; m < 4; ++m) _Pragma("unroll") for (int n = 0; n < 2; ++n) _Pragma("unroll") for (int k = 0; k < 2; ++k) \
        { if constexpr (I8) acc[ai][bj][m][n] = __builtin_bit_cast(f32x4, __builtin_amdgcn_mfma_i32_16x16x64_i8(__builtin_bit_cast(i32x4, Bt[n][k]), __builtin_bit_cast(i32x4, At[m][k]), __builtin_bit_cast(i32x4, acc[ai][bj][m][n]), 0, 0, 0)); \
          else acc[ai][bj][m][n] = __builtin_amdgcn_mfma_f32_16x16x32_bf16(Bt[n][k], At[m][k], acc[ai][bj][m][n], 0, 0, 0); } __builtin_amdgcn_s_setprio(0); } while (0)
#define PG8_WAIT_V(n) asm volatile("s_waitcnt vmcnt(" #n ")" ::: "memory")
#define PG8_WAIT_L(n) asm volatile("s_waitcnt lgkmcnt(" #n ")" ::: "memory")
#define PG8_BAR __builtin_amdgcn_s_barrier()
#define PG8_SCHED __builtin_amdgcn_sched_barrier(0)
    Unit cur, nxt; int ui = 0;
    if (!S.next(0, cur)) return;
    f32x4 acc[2][2][4][2];
#pragma unroll
    for (int a = 0; a < 2; ++a)
#pragma unroll
        for (int b = 0; b < 2; ++b)
#pragma unroll
            for (int m = 0; m < 4; ++m)
#pragma unroll
                for (int n = 0; n < 2; ++n) acc[a][b][m][n] = (f32x4){0.f, 0.f, 0.f, 0.f};
    bf16x8 At[4][2], B0[2][2], B1[2][2];
    const char* cA = (const char*)g.A + (size_t)cur.pm * tstep; const char* cB = (const char*)g.Bt + (size_t)cur.pn * tstep;
    S.a_ready(cur);
    if constexpr (SP2) {
        PG8_STAGE(PG8_SB(0, 0), cB, voffB); PG8_STAGE(PG8_SB(0, 1), cB + hstep, voffB); PG8_STAGE(PG8_SA(0, 0), cA, voffA); PG8_STAGE(PG8_SA(0, 1), cA + hstep, voffA);
        if (wr == 1) PG8_BAR;
        PG8_WAIT_V(2); PG8_BAR;
        PG8_STAGE(PG8_SB(1, 0), cB + kstep, voffB); PG8_STAGE(PG8_SA(1, 0), cA + kstep, voffA); PG8_STAGE(PG8_SB(1, 1), cB + hstep + kstep, voffB);
        PG8_WAIT_V(6); PG8_BAR;
    } else {
        PG8_STAGE(PG8_SB(0, 0), cB, voffB); PG8_STAGE(PG8_SA(0, 0), cA, voffA); PG8_STAGE(PG8_SB(0, 1), cB + hstep, voffB); PG8_STAGE(PG8_SA(0, 1), cA + hstep, voffA);
        if (wr == 1) PG8_BAR;
        PG8_WAIT_V(4); PG8_BAR;
        PG8_STAGE(PG8_SB(1, 0), cB + kstep, voffB); PG8_STAGE(PG8_SA(1, 0), cA + kstep, voffA); PG8_STAGE(PG8_SB(1, 1), cB + hstep + kstep, voffB);
        PG8_WAIT_V(6); PG8_BAR;
    }
    for (;;) {
        const bool has_next = S.next(ui + 1, nxt);
        const char* nA = has_next ? (const char*)g.A + (size_t)nxt.pm * tstep : cA; const char* nB = has_next ? (const char*)g.Bt + (size_t)nxt.pn * tstep : cB;
        for (int t = 0; t < nt; t += 2) {
            const bool last = (t == nt - 2);
            const char* a1 = cA + (size_t)(t + 1) * kstep;
            const char* a2 = last ? nA : cA + (size_t)(t + 2) * kstep; const char* b2 = last ? nB : cB + (size_t)(t + 2) * kstep;
            const char* a3 = a2 + kstep; const char* b3 = b2 + kstep;
            if (last && has_next) S.a_ready(nxt);
            if constexpr (SP2) {
            PG8_LDB(B0, 0, 0); PG8_LDB(B1, 0, 1); PG8_SCHED; PG8_LDA(At, 0, 0); PG8_STAGE(PG8_SA(1, 1), a1 + hstep, voffA);
            PG8_WAIT_V(8); PG8_WAIT_L(0); PG8_BAR; PG8_MMA(0, 0, At, B0); PG8_MMA(0, 1, At, B1); PG8_BAR; PG8_SCHED;
            PG8_LDA(At, 0, 1); PG8_STAGE(PG8_SB(0, 0), b2, voffB); PG8_STAGE(PG8_SB(0, 1), b2 + hstep, voffB); PG8_STAGE(PG8_SA(0, 0), a2, voffA);
            PG8_WAIT_V(8); PG8_WAIT_L(0); PG8_BAR; PG8_MMA(1, 0, At, B0); PG8_MMA(1, 1, At, B1); PG8_BAR; PG8_SCHED;
            PG8_LDB(B0, 1, 0); PG8_LDB(B1, 1, 1); PG8_SCHED; PG8_LDA(At, 1, 0); PG8_STAGE(PG8_SA(0, 1), a2 + hstep, voffA);
            PG8_WAIT_V(8); PG8_WAIT_L(0); PG8_BAR; PG8_MMA(0, 0, At, B0); PG8_MMA(0, 1, At, B1); PG8_BAR; PG8_SCHED;
            PG8_LDA(At, 1, 1); PG8_STAGE(PG8_SB(1, 0), b3, voffB); PG8_STAGE(PG8_SB(1, 1), b3 + hstep, voffB); PG8_STAGE(PG8_SA(1, 0), a3, voffA);
            PG8_WAIT_V(8); PG8_WAIT_L(0); PG8_BAR; PG8_MMA(1, 0, At, B0); PG8_MMA(1, 1, At, B1); PG8_BAR; PG8_SCHED;
            } else {
            PG8_LDB(B0, 0, 0); PG8_SCHED; PG8_LDA(At, 0, 0); PG8_STAGE(PG8_SA(1, 1), a1 + hstep, voffA);
            PG8_WAIT_L(8); PG8_BAR; PG8_WAIT_L(0); PG8_MMA(0, 0, At, B0); PG8_BAR; PG8_SCHED;
            PG8_LDB(B1, 0, 1); PG8_STAGE(PG8_SB(0, 0), b2, voffB);
            PG8_BAR; PG8_WAIT_L(0); PG8_MMA(0, 1, At, B1); PG8_BAR;
            PG8_LDA(At, 0, 1); PG8_STAGE(PG8_SA(0, 0), a2, voffA);
            PG8_BAR; PG8_WAIT_L(0); PG8_MMA(1, 0, At, B0); PG8_BAR; PG8_SCHED;
            PG8_STAGE(PG8_SB(0, 1), b2 + hstep, voffB);
            PG8_WAIT_V(6); PG8_BAR; PG8_MMA(1, 1, At, B1); PG8_BAR;
            PG8_LDB(B0, 1, 0); PG8_SCHED; PG8_LDA(At, 1, 0); PG8_STAGE(PG8_SA(0, 1), a2 + hstep, voffA);
            PG8_WAIT_L(8); PG8_BAR; PG8_WAIT_L(0); PG8_MMA(0, 0, At, B0); PG8_BAR; PG8_SCHED;
            PG8_LDB(B1, 1, 1); PG8_STAGE(PG8_SB(1, 0), b3, voffB);
            PG8_BAR; PG8_WAIT_L(0); PG8_MMA(0, 1, At, B1); PG8_BAR;
            PG8_LDA(At, 1, 1); PG8_STAGE(PG8_SA(1, 0), a3, voffA);
            PG8_BAR; PG8_WAIT_L(0); PG8_MMA(1, 0, At, B0); PG8_BAR; PG8_SCHED;
            PG8_STAGE(PG8_SB(1, 1), b3 + hstep, voffB);
            PG8_WAIT_V(6); PG8_BAR; PG8_MMA(1, 1, At, B1); PG8_BAR;
            }
        }
        if constexpr (ALIGN_EPI) { if (wr == 0) PG8_BAR; }
        if constexpr (!Epi::AFTER_DRAIN) { E(acc, cur, wr, wc, fr, fq); S.done(cur); }
        if (!has_next) break;
#pragma unroll
        for (int a = 0; a < 2; ++a)
#pragma unroll
            for (int b = 0; b < 2; ++b)
#pragma unroll
                for (int m = 0; m < 4; ++m)
#pragma unroll
                    for (int n = 0; n < 2; ++n) acc[a][b][m][n] = (f32x4){0.f, 0.f, 0.f, 0.f};
        cur = nxt; cA = nA; cB = nB; ++ui;
        if constexpr (ALIGN_EPI) { if (wr == 1) PG8_BAR; }
    }
    PG8_WAIT_V(0);
    if constexpr (!ALIGN_EPI) { if (wr == 0) PG8_BAR; }
    PG8_BAR;
    if constexpr (Epi::AFTER_DRAIN) { E.fused(acc, cur, wr, wc, fr, fq, lds, wid, lane); S.done(cur); }
#undef PG8_SA
#undef PG8_SB
#undef PG8_STAGE
#undef PG8_LDA
#undef PG8_LDB
#undef PG8_MMA
#undef PG8_WAIT_V
#undef PG8_WAIT_L
#undef PG8_BAR
#undef PG8_SCHED
}
}
constexpr int M = 32768, D = 1024, S = 2048;
constexpr int NPROJ = 2560, NQ = 2048, NEXP = 16384;
typedef unsigned short bf16;
constexpr size_t MiB = 1u << 20;
constexpr size_t WS_CTL = 0, CTL_ZERO_BYTES = 1 * MiB;
constexpr size_t WS_WIN = 2 * MiB, WS_WOUT = 8 * MiB, WS_WQ = 10 * MiB;
constexpr size_t WS_SK = 14 * MiB, WS_WPT = 14 * MiB + 512 * 1024;
constexpr size_t WS_SA = 15 * MiB + 640 * 1024, WS_SWIN = 15 * MiB + 768 * 1024;
constexpr size_t WS_SU = 15 * MiB, WS_SV = 15 * MiB + 64 * 1024, WS_USUM = 15 * MiB + 128 * 1024, WS_ROWSS = 15 * MiB + 512 * 1024;
constexpr size_t WS_U8 = 16 * MiB, WS_V8 = 32 * MiB;
constexpr size_t WS_XN = 48 * MiB;
constexpr size_t WS_XN8 = 386 * MiB, WS_XS = 15 * MiB + 896 * 1024;
constexpr size_t WS_P = 112 * MiB;
constexpr size_t WS_Q = 128 * MiB, WS_K = 176 * MiB, WS_V = 224 * MiB;
constexpr size_t WS_ORAW = 272 * MiB, WS_LSE = 320 * MiB, WS_MIXIN = 322 * MiB, WS_END = 418 * MiB;
constexpr size_t WS_QP = 128 * MiB, WS_IDX = 256 * MiB, WS_GATE = 264 * MiB, WS_X8 = 280 * MiB;
constexpr size_t WS_PROJ = 386 * MiB;
constexpr int CW_BAR = 4096;
constexpr int CW_CMAX = CW_BAR + 2 * 3456, CW_CCNT = CW_CMAX + NPROJ, CW_END = CW_CCNT + NPROJ / 32;

constexpr int RING_BYTES = 147456;
constexpr int LDSCTL_OFF = RING_BYTES, MISC_OFF = LDSCTL_OFF;
constexpr int LDS_BYTES = RING_BYTES + 128;
constexpr int NWAVES = 8;

#define GAS __attribute__((address_space(1)))
#define LAS __attribute__((address_space(3)))
typedef unsigned v4u __attribute__((ext_vector_type(4)));
typedef float f32x4 __attribute__((ext_vector_type(4)));
typedef GAS unsigned gu32;
#define LDS_WAIT() asm volatile("s_waitcnt lgkmcnt(0)" ::: "memory")
#define VM_WAIT() asm volatile("s_waitcnt vmcnt(0)" ::: "memory")
__device__ __forceinline__ unsigned f2bf(float f) { unsigned u = __builtin_bit_cast(unsigned, f); return (u + 0x7fffu + ((u >> 16) & 1u)) >> 16; }
__device__ __forceinline__ unsigned pk2(float lo, float hi) { return f2bf(lo) | (f2bf(hi) << 16); }
__device__ __forceinline__ float bf2f(unsigned short b) { return __builtin_bit_cast(float, (unsigned)b << 16); }
template <int CTRL> __device__ __forceinline__ float dpp_mov(float v) { return __builtin_bit_cast(float, __builtin_amdgcn_mov_dpp(__builtin_bit_cast(int, v), CTRL, 0xF, 0xF, true)); }
__device__ __forceinline__ float lane_val(float v, int l) { return __builtin_bit_cast(float, __builtin_amdgcn_readlane(__builtin_bit_cast(int, v), l)); }
__device__ __forceinline__ float wave_sum(float v) {
    v += dpp_mov<0xB1>(v); v += dpp_mov<0x4E>(v); v += dpp_mov<0x141>(v); v += dpp_mov<0x140>(v);
    return (lane_val(v, 0) + lane_val(v, 16)) + (lane_val(v, 32) + lane_val(v, 48));
}
__device__ __forceinline__ float wave_max(float v) {
    v = fmaxf(v, dpp_mov<0xB1>(v)); v = fmaxf(v, dpp_mov<0x4E>(v)); v = fmaxf(v, dpp_mov<0x141>(v)); v = fmaxf(v, dpp_mov<0x140>(v));
    return fmaxf(fmaxf(lane_val(v, 0), lane_val(v, 16)), fmaxf(lane_val(v, 32), lane_val(v, 48)));
}
#define XB_TMO      128
#define XB_XCNT(j)  (256  + 64 * (j))
#define XB_XSUB(j)  (1280 + 64 * (j))
#define XB_XGEN(j)  (2304 + 64 * (j))
#define XB_TOP      3328
#define XB_TOPGEN   3392
#define XCD_BAR_WORDS 3456
#define XB_SPIN_CAP (1u << 18)

__device__ __forceinline__ unsigned xb_ld(unsigned* p)              { return __hip_atomic_load(p, __ATOMIC_RELAXED, __HIP_MEMORY_SCOPE_AGENT); }
__device__ __forceinline__ unsigned xb_add(unsigned* p, unsigned v) { return __hip_atomic_fetch_add(p, v, __ATOMIC_RELAXED, __HIP_MEMORY_SCOPE_AGENT); }
__device__ __forceinline__ unsigned xb_xcc_id() { return (unsigned)__builtin_amdgcn_s_getreg((3 << 11) | 20) & 0xFu; }
#define XB_SPIN(cond, bar) do { unsigned _sp = 0; while (cond) { __builtin_amdgcn_s_sleep(1); \
    if ((++_sp & 255u) == 0u) { if (xb_ld(&(bar)[XB_TMO])) break; if (_sp > XB_SPIN_CAP) { atomicAdd(&(bar)[XB_TMO], 1u); break; } } } } while (0)

struct XcdBarrier {
    unsigned* bar; unsigned x;
    volatile LAS unsigned* st;
};

__device__ __forceinline__ XcdBarrier xcd_barrier_post(unsigned* bar, volatile LAS unsigned* st) {
    XcdBarrier b; b.bar = bar; b.x = xb_xcc_id(); b.st = st;
    if (threadIdx.x == 0) (void)xb_add(&bar[XB_XCNT(b.x)], 1u);
    return b;
}
__device__ __forceinline__ void xcd_barrier_complete(unsigned* bar, unsigned x, unsigned& nloc, unsigned& nx) {
    const unsigned G = gridDim.x * gridDim.y * gridDim.z;
    unsigned sum, cnt, mine, sp = 0u;
    for (;;) {
        sum = 0u; cnt = 0u; mine = 0u;
#pragma unroll
        for (unsigned j = 0; j < 16; ++j) { const unsigned c = xb_ld(&bar[XB_XCNT(j)]); sum += c; cnt += (c > 0u) ? 1u : 0u; mine = (j == x) ? c : mine; }
        if (sum == G) break;
        __builtin_amdgcn_s_sleep(1);
        if ((++sp & 255u) == 0u) { if (xb_ld(&bar[XB_TMO])) break; if (sp > XB_SPIN_CAP) { atomicAdd(&bar[XB_TMO], 1u); break; } }
    }
    nloc = mine > 0u ? mine : 1u; nx = cnt > 0u ? cnt : 1u;
}

__device__ __forceinline__ void xcd_barrier(const XcdBarrier& b, int wave_) {
    asm volatile("s_waitcnt vmcnt(0)" ::: "memory");
    __syncthreads();
    if (wave_ == 0 && lane_now() == 0) {
        unsigned* bar = b.bar;
        __builtin_amdgcn_s_waitcnt(0);
        unsigned nloc = b.st[0], nx = b.st[1];
        if (nloc == 0u) { xcd_barrier_complete(bar, b.x, nloc, nx); b.st[0] = nloc; b.st[1] = nx; }
        const unsigned old = xb_add(&bar[XB_XSUB(b.x)], 1u);
        const unsigned gen = old / nloc;
        if (old + 1u == (gen + 1u) * nloc) {
            __builtin_amdgcn_fence(__ATOMIC_RELEASE, "agent");
            asm volatile("s_waitcnt vmcnt(0)" ::: "memory");
            const unsigned og = xb_add(&bar[XB_TOP], 1u);
            const unsigned tg = og / nx;
            if (og + 1u == (tg + 1u) * nx) xb_add(&bar[XB_TOPGEN], 1u);
            else XB_SPIN(xb_ld(&bar[XB_TOPGEN]) == tg, bar);
            __builtin_amdgcn_fence(__ATOMIC_ACQUIRE, "agent");
            xb_add(&bar[XB_XGEN(b.x)], 1u);
            asm volatile("s_waitcnt vmcnt(0)" ::: "memory");
        } else {
            XB_SPIN(xb_ld(&bar[XB_XGEN(b.x)]) == gen, bar);
            __builtin_amdgcn_fence(__ATOMIC_ACQUIRE, "agent");
            asm volatile("s_waitcnt vmcnt(0)" ::: "memory");
        }
    }
    __syncthreads();
}
struct Args { const float* in[12]; float* out; unsigned char* ws; int ph_lo, ph_hi, li, pad; };

__device__ __forceinline__ void p0_transpose_item(const float* W, int K, int N, bf16* WT, const float* kscale, LAS float* scr, int item, int lane) {
    const int nblk = N / 32, kb = item / nblk, nb = item % nblk, k0 = 64 * kb, n0 = 32 * nb;
#pragma unroll 8
    for (int i = 0; i < 32; ++i) { const int kk = 2 * i + (lane >> 5); float w = W[(size_t)(k0 + kk) * N + n0 + (lane & 31)]; if (kscale) w *= kscale[k0 + kk]; scr[kk * 33 + (lane & 31)] = w; }
    LDS_WAIT(); asm volatile("" ::: "memory");
    const int c = lane & 7;
#pragma unroll
    for (int j = 0; j < 4; ++j) { const int n = (lane >> 3) + 8 * j; const LAS float* s = scr + (8 * c) * 33 + n;
        v4u o; o.x = pk2(s[0 * 33], s[1 * 33]); o.y = pk2(s[2 * 33], s[3 * 33]); o.z = pk2(s[4 * 33], s[5 * 33]); o.w = pk2(s[6 * 33], s[7 * 33]);
        *(GAS v4u*)(WT + (size_t)(n0 + n) * K + k0 + 8 * c) = o; }
    LDS_WAIT(); asm volatile("" ::: "memory");
}
__device__ __forceinline__ void p0_quant_publish(const float* W, const float* kscale, int N, unsigned* cmax, unsigned* ccnt, LAS float* scr, int item, int lane) {
    const int nblk = N / 32, kb = item / nblk, nb = item % nblk, k0 = 64 * kb, n0 = 32 * nb;
    float mx = 0.f;
#pragma unroll 8
    for (int i = 0; i < 32; ++i) { const int kk = 2 * i + (lane >> 5); const float w = W[(size_t)(k0 + kk) * N + n0 + (lane & 31)] * kscale[k0 + kk]; scr[kk * 33 + (lane & 31)] = w; mx = fmaxf(mx, fabsf(w)); }
    { const auto rr = __builtin_amdgcn_permlane32_swap(__builtin_bit_cast(unsigned, mx), __builtin_bit_cast(unsigned, mx), false, false);
      mx = fmaxf(__builtin_bit_cast(float, (unsigned)rr[0]), __builtin_bit_cast(float, (unsigned)rr[1])); }
    if (lane < 32) __hip_atomic_fetch_max(cmax + n0 + lane, __builtin_bit_cast(unsigned, mx), __ATOMIC_RELAXED, __HIP_MEMORY_SCOPE_AGENT);
    asm volatile("s_waitcnt vmcnt(0)" ::: "memory");
    if (lane == 0) __hip_atomic_fetch_add(ccnt + nb, 1u, __ATOMIC_RELAXED, __HIP_MEMORY_SCOPE_AGENT);
}
__device__ __forceinline__ void p0_quant_finish(int N, signed char* W8, float* sw, unsigned* cmax, unsigned* ccnt, LAS float* scr, int item, int lane) {
    const int nblk = N / 32, kb = item / nblk, nb = item % nblk, k0 = 64 * kb, n0 = 32 * nb;
    if (lane == 0) { unsigned sp = 0; while (__hip_atomic_load(ccnt + nb, __ATOMIC_RELAXED, __HIP_MEMORY_SCOPE_AGENT) < 16u) { __builtin_amdgcn_s_sleep(1); if (++sp > (1u << 22)) break; } }
    asm volatile("s_waitcnt vmcnt(0) lgkmcnt(0)" ::: "memory");
    __builtin_amdgcn_wave_barrier();
#pragma unroll
    for (int j = 0; j < 2; ++j) { const int n = 16 * j + (lane >> 2), ck = lane & 3;
        const float cm = __builtin_bit_cast(float, __hip_atomic_load(cmax + n0 + n, __ATOMIC_RELAXED, __HIP_MEMORY_SCOPE_AGENT));
        const float inv = cm > 0.f ? 127.f / cm : 0.f;
        if (kb == 0 && ck == 0) sw[n0 + n] = cm > 0.f ? cm * (1.f / 127.f) : 1.f;
        v4u o;
#pragma unroll
        for (int q = 0; q < 4; ++q) { const LAS float* sp_ = scr + (16 * ck + 4 * q) * 33 + n;
            const int a = (int)rintf(sp_[0] * inv), b = (int)rintf(sp_[33] * inv), c = (int)rintf(sp_[66] * inv), d = (int)rintf(sp_[99] * inv);
            o[q] = (unsigned)(a & 0xff) | ((unsigned)(b & 0xff) << 8) | ((unsigned)(c & 0xff) << 16) | ((unsigned)(d & 0xff) << 24); }
        *(GAS v4u*)(W8 + (size_t)(n0 + n) * 1024 + k0 + 16 * ck) = o; }
    LDS_WAIT(); asm volatile("" ::: "memory");
}
__device__ __forceinline__ void p0_quant_item(const float* W, const float* kscale, int N, signed char* W8, float* sw, unsigned* cmax, unsigned* ccnt, LAS float* scr, int item, int lane) {
    p0_quant_publish(W, kscale, N, cmax, ccnt, scr, item, lane); p0_quant_finish(N, W8, sw, cmax, ccnt, scr, item, lane);
}
__device__ __forceinline__ void rms_row_to_bf16(const float* xrow, const float* g, bf16* orow, int lane) {
    const GAS f32x4* xr = (const GAS f32x4*)xrow + lane;
    f32x4 v[4]; float s = 0.f;
#pragma unroll
    for (int j = 0; j < 4; ++j) { v[j] = xr[64 * j]; s += (v[j].x * v[j].x + v[j].y * v[j].y) + (v[j].z * v[j].z + v[j].w * v[j].w); }
    const float r = rsqrtf(wave_sum(s) * (1.f / D) + 1e-6f);
    GAS unsigned long long* o8 = (GAS unsigned long long*)orow + lane;
#pragma unroll
    for (int j = 0; j < 4; ++j) { const f32x4 gg = ((const GAS f32x4*)g)[lane + 64 * j];
        o8[64 * j] = (unsigned long long)pk2(v[j].x * r * gg.x, v[j].y * r * gg.y) | ((unsigned long long)pk2(v[j].z * r * gg.z, v[j].w * r * gg.w) << 32); }
}
__device__ __forceinline__ void quant_row_i8(const float* src, const float* gsc, signed char* dst, float* scale_out, int lane) {
    const GAS f32x4* p = (const GAS f32x4*)src + 4 * lane;
    f32x4 v[4]; float amax = 0.f;
#pragma unroll
    for (int j = 0; j < 4; ++j) { v[j] = p[j]; if (gsc) v[j] = v[j] * ((const GAS f32x4*)gsc)[4 * lane + j];
        amax = fmaxf(amax, fmaxf(fmaxf(fabsf(v[j].x), fabsf(v[j].y)), fmaxf(fabsf(v[j].z), fabsf(v[j].w)))); }
    amax = wave_max(amax);
    const float inv = amax > 0.f ? 127.f / amax : 0.f;
    v4u w;
#pragma unroll
    for (int j = 0; j < 4; ++j) { const int a = (int)rintf(v[j].x * inv), b = (int)rintf(v[j].y * inv), c = (int)rintf(v[j].z * inv), d = (int)rintf(v[j].w * inv);
        w[j] = (unsigned)(a & 0xff) | ((unsigned)(b & 0xff) << 8) | ((unsigned)(c & 0xff) << 16) | ((unsigned)(d & 0xff) << 24); }
    *(GAS v4u*)(dst + (size_t)(lane >> 3) * ((size_t)NEXP * 128) + 16 * (lane & 7)) = w;
    if (lane == 0) *scale_out = amax > 0.f ? amax * (1.f / 127.f) : 1.f;
}
__device__ __forceinline__ void quant_row_load(const float* src, f32x4 (&v)[4], int lane) {
    const GAS f32x4* p = (const GAS f32x4*)src + 4 * lane;
#pragma unroll
    for (int j = 0; j < 4; ++j) v[j] = p[j];
}
__device__ __forceinline__ void quant_row_finish(f32x4 (&v)[4], const float* gsc, signed char* dst, float* scale_out, int lane) {
    float amax = 0.f;
#pragma unroll
    for (int j = 0; j < 4; ++j) { if (gsc) v[j] = v[j] * ((const GAS f32x4*)gsc)[4 * lane + j];
        amax = fmaxf(amax, fmaxf(fmaxf(fabsf(v[j].x), fabsf(v[j].y)), fmaxf(fabsf(v[j].z), fabsf(v[j].w)))); }
    amax = wave_max(amax);
    const float inv = amax > 0.f ? 127.f / amax : 0.f;
    v4u w;
#pragma unroll
    for (int j = 0; j < 4; ++j) { const int a = (int)rintf(v[j].x * inv), b = (int)rintf(v[j].y * inv), c = (int)rintf(v[j].z * inv), d = (int)rintf(v[j].w * inv);
        w[j] = (unsigned)(a & 0xff) | ((unsigned)(b & 0xff) << 8) | ((unsigned)(c & 0xff) << 16) | ((unsigned)(d & 0xff) << 24); }
    *(GAS v4u*)(dst + (size_t)(lane >> 3) * ((size_t)NEXP * 128) + 16 * (lane & 7)) = w;
    if (lane == 0) *scale_out = amax > 0.f ? amax * (1.f / 127.f) : 1.f;
}
__device__ __forceinline__ void quant_row_finish_u4(f32x4 (&v)[4], const float* gsc, unsigned char* dst, float* scale_out, float* usum_out, int lane) {
    float amax = 0.f, ssq = 0.f;
#pragma unroll
    for (int j = 0; j < 4; ++j) { v[j] = v[j] * ((const GAS f32x4*)gsc)[4 * lane + j];
        amax = fmaxf(amax, fmaxf(fmaxf(fabsf(v[j].x), fabsf(v[j].y)), fmaxf(fabsf(v[j].z), fabsf(v[j].w))));
        ssq += (v[j].x * v[j].x + v[j].y * v[j].y) + (v[j].z * v[j].z + v[j].w * v[j].w); }
    amax = wave_max(amax); ssq = wave_sum(ssq);
    const float clipv = fminf(amax, 2.7f * sqrtf(ssq * (1.f / D)));
    const float inv = clipv > 0.f ? 7.f / clipv : 0.f;
    unsigned w[2] = {0u, 0u}; float cs_ = 0.f;
#pragma unroll
    for (int j = 0; j < 4; ++j) { const float f_[4] = {v[j].x, v[j].y, v[j].z, v[j].w};
#pragma unroll
        for (int c = 0; c < 4; ++c) { const float t = __builtin_amdgcn_fmed3f(fmaf(f_[c], inv, 12582912.f), 12582912.f - 7.f, 12582912.f + 7.f);
            w[j >> 1] |= (__builtin_bit_cast(unsigned, t) & 15u) << (4 * (4 * (j & 1) + c)); } }
    typedef unsigned v2u_ __attribute__((ext_vector_type(2)));
    *(GAS v2u_*)(dst + (size_t)(lane >> 4) * ((size_t)NEXP * 128) + 8 * (lane & 15)) = (v2u_){w[0], w[1]};
    (void)cs_; (void)usum_out;
    if (lane == 0) { const unsigned sb_ = __builtin_bit_cast(unsigned, clipv > 0.f ? clipv * (1.f / 7.f) : 1.f);
        ((unsigned short*)scale_out)[1] = (unsigned short)((sb_ + 0x7fffu + ((sb_ >> 16) & 1u)) >> 16); }
}
__device__ __forceinline__ void quant_row_finish_v4(f32x4 (&v)[4], unsigned char* dst, float* scale_out, int lane) {
    float amax = 0.f, ssq = 0.f;
#pragma unroll
    for (int j = 0; j < 4; ++j) { amax = fmaxf(amax, fmaxf(fmaxf(fabsf(v[j].x), fabsf(v[j].y)), fmaxf(fabsf(v[j].z), fabsf(v[j].w))));
        ssq += (v[j].x * v[j].x + v[j].y * v[j].y) + (v[j].z * v[j].z + v[j].w * v[j].w); }
    amax = wave_max(amax); ssq = wave_sum(ssq);
    const float clipv = fminf(amax, 2.7f * sqrtf(ssq * (1.f / D)));
    const float inv = clipv > 0.f ? 7.f / clipv : 0.f;
    unsigned w[2] = {0u, 0u};
#pragma unroll
    for (int j = 0; j < 4; ++j) { const float f_[4] = {v[j].x, v[j].y, v[j].z, v[j].w};
#pragma unroll
        for (int c = 0; c < 4; ++c) { const float mg = (c & 1) ? 12582912.f : 12582912.f + 8.f;
            const float t = __builtin_amdgcn_fmed3f(fmaf(f_[c], inv, mg), mg - 7.f, mg + 7.f);
            w[j >> 1] |= (__builtin_bit_cast(unsigned, t) & 15u) << (4 * (4 * (j & 1) + c)); } }
    typedef unsigned v2u_ __attribute__((ext_vector_type(2)));
    *(GAS v2u_*)(dst + (size_t)(lane >> 4) * ((size_t)NEXP * 128) + 8 * (lane & 15)) = (v2u_){w[0], w[1]};
    if (lane == 0) ((unsigned short*)scale_out)[0] = __builtin_bit_cast(unsigned short, (_Float16)(clipv > 0.f ? clipv * (1.f / 7.f) : 1.f));
}
__device__ __forceinline__ void p0_prologue(const Args& a, LAS unsigned char* lds, int gw, int NGW, int wave, int lane) {
    unsigned char* ws = a.ws;
    LAS float* scr = (LAS float*)(lds + wave * 17408);
    LAS float* scr2 = scr + 64 * 33;
    const float* w_in = a.in[2]; const float* w_pool = a.in[3]; const float* w_out = a.in[5]; const float* g_ffn = a.in[6]; const float* w_q = a.in[7];
    constexpr int I_IN = (D / 64) * (NPROJ / 32), I_OUT = (D / 64) * (D / 32), I_Q = (D / 64) * (NQ / 32), I_P = 4 * 2;
    constexpr int NITEMS = I_IN + I_OUT + I_Q + I_P;
    unsigned* cmax_ = (unsigned*)(ws + WS_CTL) + CW_CMAX; unsigned* ccnt_ = (unsigned*)(ws + WS_CTL) + CW_CCNT;
    const bool defer = gw < I_IN;
    if (defer) p0_quant_publish(w_in, a.in[1], NPROJ, cmax_, ccnt_, scr, gw, lane);
    for (int it = defer ? gw + NGW : gw; it < NITEMS; it += NGW) {
        int r = it;
        if (r < I_IN) { p0_quant_item(w_in, a.in[1], NPROJ, (signed char*)(ws + WS_WIN), (float*)(ws + WS_SWIN), cmax_, ccnt_, scr2, r, lane); continue; } r -= I_IN;
        if (r < I_OUT) { p0_transpose_item(w_out, D, D, (bf16*)(ws + WS_WOUT), nullptr, scr2, r, lane); continue; } r -= I_OUT;
        if (r < I_Q) { p0_transpose_item(w_q, D, NQ, (bf16*)(ws + WS_WQ), g_ffn, scr2, r, lane); continue; } r -= I_Q;
        p0_transpose_item(w_pool + (r >> 1) * 4096, 64, 64, (bf16*)(ws + WS_WPT) + (r >> 1) * 4096, nullptr, scr2, r & 1, lane);
    }
    constexpr int R_X = M, R_SK = 256, R_Z = 32, NROWS = R_X + R_SK + R_Z;
    for (int c4 = gw; c4 < R_X / 4; c4 += NGW) {
        const GAS f32x4* xr = (const GAS f32x4*)(a.in[0] + (size_t)c4 * 4 * D) + lane;
        f32x4 v[4][4]; float ssq[4];
#pragma unroll
        for (int rr = 0; rr < 4; ++rr)
#pragma unroll
            for (int j = 0; j < 4; ++j) v[rr][j] = xr[rr * (D / 4) + 64 * j];
#pragma unroll
        for (int rr = 0; rr < 4; ++rr) { float s_ = 0.f;
#pragma unroll
            for (int j = 0; j < 4; ++j) s_ += (v[rr][j].x * v[rr][j].x + v[rr][j].y * v[rr][j].y) + (v[rr][j].z * v[rr][j].z + v[rr][j].w * v[rr][j].w);
            ssq[rr] = s_; }
#pragma unroll
        for (int rr = 0; rr < 4; ++rr) ssq[rr] = wave_sum(ssq[rr]);
#pragma unroll
        for (int rr = 0; rr < 4; ++rr) { const float rs = rsqrtf(ssq[rr] * (1.f / D) + 1e-6f);
            GAS unsigned* o4 = (GAS unsigned*)((signed char*)(ws + WS_XN8) + ((size_t)c4 * 4 + rr) * D) + lane;
            f32x4 y[4]; float am = 0.f;
#pragma unroll
            for (int j = 0; j < 4; ++j) { y[j] = v[rr][j] * rs;
                am = fmaxf(am, fmaxf(fmaxf(fabsf(y[j].x), fabsf(y[j].y)), fmaxf(fabsf(y[j].z), fabsf(y[j].w)))); }
            am = wave_max(am); const float qi = am > 0.f ? 127.f / am : 0.f;
#pragma unroll
            for (int j = 0; j < 4; ++j) { const int q0 = (int)rintf(y[j].x * qi), q1 = (int)rintf(y[j].y * qi), q2 = (int)rintf(y[j].z * qi), q3 = (int)rintf(y[j].w * qi);
                o4[64 * j] = (unsigned)(q0 & 0xff) | ((unsigned)(q1 & 0xff) << 8) | ((unsigned)(q2 & 0xff) << 16) | ((unsigned)q3 << 24); }
            if (lane == 0) { const float sa_ = am > 0.f ? am * (1.f / 127.f) : 1.f; ((float*)(ws + WS_SA))[(size_t)c4 * 4 + rr] = sa_; ((float*)(ws + WS_XS))[(size_t)c4 * 4 + rr] = sa_ / rs; } }
    }
    for (int it = R_X + gw; it < NROWS; it += NGW) {
        int r = it - R_X;
        if (r < R_SK) { const GAS f32x4* p = (const GAS f32x4*)(a.in[8] + (size_t)r * 1024) + lane; GAS unsigned long long* o8 = (GAS unsigned long long*)((bf16*)(ws + WS_SK) + (size_t)r * 1024) + lane;
#pragma unroll
            for (int j = 0; j < 4; ++j) { const f32x4 v = p[64 * j]; o8[64 * j] = (unsigned long long)pk2(v.x, v.y) | ((unsigned long long)pk2(v.z, v.w) << 32); }
            continue; } r -= R_SK;
        { GAS f32x4* z = (GAS f32x4*)((float*)(ws + WS_ROWSS) + (size_t)r * 1024) + lane;
#pragma unroll
          for (int j = 0; j < 4; ++j) z[64 * j] = (f32x4){0.f, 0.f, 0.f, 0.f}; }
    }
    if (defer) p0_quant_finish(NPROJ, (signed char*)(ws + WS_WIN), (float*)(ws + WS_SWIN), cmax_, ccnt_, scr, gw, lane);
}
namespace attn {
typedef short bf16x8 __attribute__((ext_vector_type(8)));
typedef short s16x4 __attribute__((ext_vector_type(4)));
typedef float f32x16 __attribute__((ext_vector_type(16)));
typedef float f32x2_t __attribute__((ext_vector_type(2)));
typedef __bf16 bf16x2_t __attribute__((ext_vector_type(2)));
typedef unsigned u32x4 __attribute__((ext_vector_type(4)));
typedef unsigned u32x2 __attribute__((ext_vector_type(2)));
constexpr int KROW = 144;
constexpr int SLOT = 2 * 256 * KROW;
__device__ __forceinline__ unsigned cvtpk(float lo, float hi) { f32x2_t v = {lo, hi}; bf16x2_t b = __builtin_convertvector(v, bf16x2_t); return __builtin_bit_cast(unsigned, b); }
__device__ __forceinline__ s16x4 vtr(LAS const unsigned char* p) { return __builtin_bit_cast(s16x4, __builtin_amdgcn_ds_read_tr16_b64_v4i16((LAS s16x4*)p)); }

__device__ __forceinline__ void grp_barrier(volatile LAS unsigned* cnt, unsigned& target, int lane) {
    asm volatile("s_waitcnt lgkmcnt(0)" ::: "memory");
    target += 4u;
    if (lane == 0) (void)__hip_atomic_fetch_add((LAS unsigned*)cnt, 1u, __ATOMIC_RELAXED, __HIP_MEMORY_SCOPE_WORKGROUP);
    while ((unsigned)__builtin_amdgcn_readfirstlane((int)*cnt) < target) __builtin_amdgcn_s_sleep(0);
    asm volatile("" ::: "memory");
}
__device__ __forceinline__ void attn_phase(unsigned char* ws, LAS unsigned char* lds, int vcu, int G, int tid) {
    const int lane = tid & 63, wv = __builtin_amdgcn_readfirstlane(tid >> 6), grp = wv >> 2, w = wv & 3, tl = tid & 255;
    volatile LAS unsigned* gcnt = (volatile LAS unsigned*)(lds + RING_BYTES + 64 + 32 * grp); unsigned gtarget = 0u;
    const int ql = lane & 31, h = lane >> 5;
    LAS unsigned char* Ks = lds + grp * SLOT; LAS unsigned char* Vs = Ks + 256 * KROW;
    const bf16* Qd = (const bf16*)(ws + WS_Q); const bf16* Kd = (const bf16*)(ws + WS_K); const bf16* Vd = (const bf16*)(ws + WS_V);
    bf16* ORAW = (bf16*)(ws + WS_ORAW); float* LSE = (float*)(ws + WS_LSE);
#define ATT_UNIT(pi_) const int uid = 2 * (pi_) + grp, bh = uid >> 4, cu = uid & 15, hd = bh % 12, b = bh / 12, sh = 2 * (hd >> 2), L = 2048 >> sh; \
        const int r = cu >> (4 - sh), n = cu & ((16 >> sh) - 1), q0 = 128 * n; const size_t pbase = ((size_t)bh * 2048 + (size_t)r * L) * 64;
#define ATT_LOAD(pi_) do { ATT_UNIT(pi_) (void)b; (void)hd; const bf16* Kp = Kd + pbase; const bf16* Vp = Vd + pbase; const bf16* Qp = Qd + pbase; \
        _Pragma("unroll") for (int j = 0; j < 8; ++j) { const int row = 32 * w + 8 * (j & 3) + (lane >> 3) + 128 * (j >> 2), ch = lane & 7; int kr = q0 - 64 + row; kr = kr < 0 ? 0 : (kr > L - 1 ? L - 1 : kr); \
            kreg[j] = *(const u32x4*)(Kp + (size_t)kr * 64 + ch * 8); vreg[j] = *(const u32x4*)(Vp + (size_t)kr * 64 + ch * 8); } \
        _Pragma("unroll") for (int ks = 0; ks < 4; ++ks) qn[ks] = *(const bf16x8*)(Qp + (size_t)(q0 + 32 * w + ql) * 64 + 16 * ks + 8 * h); } while (0)
    u32x4 kreg[8], vreg[8]; bf16x8 qn[4];
    if (vcu < 1536) ATT_LOAD(vcu);
    for (int pi = vcu; pi < 1536; pi += G) {
        ATT_UNIT(pi)
        int hh = h, qll = ql; asm volatile("" : "+v"(hh), "+v"(qll));
#pragma unroll
        for (int j = 0; j < 8; ++j) { const int row = 32 * w + 8 * (j & 3) + (lane >> 3) + 128 * (j >> 2), ch = lane & 7; *(LAS u32x4*)(Ks + row * KROW + ch * 16) = kreg[j]; *(LAS u32x4*)(Vs + row * KROW + ch * 16) = vreg[j]; }
        bf16x8 qf[4];
#pragma unroll
        for (int ks = 0; ks < 4; ++ks) qf[ks] = qn[ks];
        grp_barrier(gcnt, gtarget, lane);
        if (pi + G < 1536) ATT_LOAD(pi + G);
        const float slope2 = exp2f(-8.f * (float)(hd + 1) / 12.f) * (float)(1 << sh) * 1.4426950408889634f;
        const int nb = qll - 4 * hh;
        const float sbp = -slope2 * (float)nb;
        bool tv[5];
#pragma unroll
        for (int kt = 0; kt < 5; ++kt) { const int klo = q0 + 32 * w + 32 * kt - 64; tv[kt] = (klo >= 0) && (klo + 32 <= L); }
        f32x16 sT[5]; float mx = -1e30f;
#pragma unroll
        for (int kt = 0; kt < 5; ++kt) {
            if (tv[kt]) {
                f32x16 acc;
#pragma unroll
                for (int rr = 0; rr < 16; ++rr) { const int c = (rr & 3) + 8 * (rr >> 2);
                    acc[rr] = kt < 2 ? fmaf(slope2, (float)(32 * kt - 64 + c), sbp) : (kt > 2 ? fmaf(-slope2, (float)(32 * kt - 64 + c), -sbp) : -slope2 * fabsf((float)c - (float)nb)); }
#pragma unroll
                for (int ks = 0; ks < 4; ++ks) { const bf16x8 af = *(LAS const bf16x8*)(Ks + (32 * w + 32 * kt + ql) * KROW + ks * 32 + h * 16);
                    acc = __builtin_amdgcn_mfma_f32_32x32x16_bf16(af, qf[ks], acc, 0, 0, 0); }
#pragma unroll
                for (int rr = 0; rr < 16; ++rr) { const int c = (rr & 3) + 8 * (rr >> 2); float sv = acc[rr];
                    if (kt == 0) sv = (c >= nb) ? sv : -1e30f;
                    if (kt == 4) sv = (c <= nb) ? sv : -1e30f;
                    acc[rr] = sv; mx = fmaxf(mx, sv); }
                sT[kt] = acc; } }
        { const auto rr_ = __builtin_amdgcn_permlane32_swap(__builtin_bit_cast(unsigned, mx), __builtin_bit_cast(unsigned, mx), false, false); mx = fmaxf(__builtin_bit_cast(float, (unsigned)rr_[0]), __builtin_bit_cast(float, (unsigned)rr_[1])); }
        float den = 0.f;
#pragma unroll
        for (int kt = 0; kt < 5; ++kt)
            if (tv[kt]) {
#pragma unroll
                for (int rr = 0; rr < 16; ++rr) { const float p = __builtin_amdgcn_exp2f(sT[kt][rr] - mx); sT[kt][rr] = p; den += p; } }
        { const auto rr_ = __builtin_amdgcn_permlane32_swap(__builtin_bit_cast(unsigned, den), __builtin_bit_cast(unsigned, den), false, false); den = __builtin_bit_cast(float, (unsigned)rr_[0]) + __builtin_bit_cast(float, (unsigned)rr_[1]); }
        f32x16 o[2]; o[0] = f32x16{}; o[1] = f32x16{};
        const int g4 = lane >> 4, i16 = lane & 15, qq = i16 >> 2, pp = i16 & 3;
        LAS const unsigned char* vb = Vs + (32 * w + 4 * h + qq) * KROW + (16 * (g4 & 1) + 4 * pp) * 2;
#pragma unroll
        for (int s2 = 0; s2 < 10; ++s2) { const int kt = s2 >> 1, rb = 8 * (s2 & 1);
            if (tv[kt]) {
            u32x4 pw; pw.x = cvtpk(sT[kt][rb + 0], sT[kt][rb + 1]); pw.y = cvtpk(sT[kt][rb + 2], sT[kt][rb + 3]); pw.z = cvtpk(sT[kt][rb + 4], sT[kt][rb + 5]); pw.w = cvtpk(sT[kt][rb + 6], sT[kt][rb + 7]);
            const bf16x8 pf = __builtin_bit_cast(bf16x8, pw);
#pragma unroll
            for (int ct = 0; ct < 2; ++ct) { const s16x4 lo = vtr(vb + (16 * s2) * KROW + ct * 64), hi4 = vtr(vb + (16 * s2 + 8) * KROW + ct * 64);
                const bf16x8 af = (bf16x8){lo[0], lo[1], lo[2], lo[3], hi4[0], hi4[1], hi4[2], hi4[3]};
                o[ct] = __builtin_amdgcn_mfma_f32_32x32x16_bf16(af, pf, o[ct], 0, 0, 0); } } }
        const float inv = 1.f / den;
        grp_barrier(gcnt, gtarget, lane);
        LAS unsigned char* ost = Ks + w * (32 * KROW);
#pragma unroll
        for (int ct = 0; ct < 2; ++ct)
#pragma unroll
            for (int a4 = 0; a4 < 4; ++a4) { u32x2 wv2; wv2.x = cvtpk(o[ct][4 * a4] * inv, o[ct][4 * a4 + 1] * inv); wv2.y = cvtpk(o[ct][4 * a4 + 2] * inv, o[ct][4 * a4 + 3] * inv);
                *(LAS u32x2*)(ost + ql * KROW + (32 * ct + 8 * a4 + 4 * h) * 2) = wv2; }
        {   const int pos = ((q0 + 32 * w + ql) << sh) + r; const size_t t = (size_t)b * 2048 + pos;
            if (h == 0) LSE[t * 12 + hd] = 0.6931471805599453f * (mx + __builtin_amdgcn_logf(den)); }
        asm volatile("s_waitcnt lgkmcnt(0)" ::: "memory");
#pragma unroll
        for (int i = 0; i < 4; ++i) { const int qr = 8 * i + (lane >> 3), ch = lane & 7;
            const u32x4 v = *(LAS const u32x4*)(ost + qr * KROW + ch * 16);
            const size_t t = (size_t)b * 2048 + (((q0 + 32 * w + qr) << sh) + r);
            *(u32x4*)(ORAW + t * 768 + hd * 64 + ch * 8) = v; }
    }
    __syncthreads();
#undef ATT_UNIT
#undef ATT_LOAD
}
}
namespace mixp {
typedef short bf16x8 __attribute__((ext_vector_type(8)));
typedef unsigned u32x4 __attribute__((ext_vector_type(4)));
__device__ __forceinline__ void unpack8(const u32x4 v, float (&f)[8]) {
#pragma unroll
    for (int i = 0; i < 4; ++i) { f[2 * i] = __builtin_bit_cast(float, v[i] << 16); f[2 * i + 1] = __builtin_bit_cast(float, v[i] & 0xffff0000u); }
}
__device__ __forceinline__ void mix_phase(const Args& a, LAS unsigned char* lds, int gw, int NGW, int wave, int lane_in) {
    unsigned char* ws = a.ws;
    LAS float* al = (LAS float*)(lds + wave * 1024);
    constexpr int PROW = 528;
    LAS unsigned char* pst = lds + 8192 + wave * (32 * PROW);
    const bf16* P = (const bf16*)(ws + WS_P); const bf16* ORAW = (const bf16*)(ws + WS_ORAW); const float* LSE = (const float*)(ws + WS_LSE);
    bf16* MIXIN = (bf16*)(ws + WS_MIXIN); const bf16* WpT = (const bf16*)(ws + WS_WPT); const float* pool_scale = a.in[4];
    for (int u = gw; u < M / 16; u += NGW) {
        int lane = lane_in; asm volatile("" : "+v"(lane));
        const int t0 = 16 * u;
        const int ti = lane & 15, kq = lane >> 4, pos = (t0 + ti) & 2047, b0 = t0 - (t0 & 2047);
        float l0_[3], l1_[3], l2_[3];
#pragma unroll
        for (int j = 0; j < 3; ++j) { const int id = lane + 64 * j, tk = id / 12, hd = id % 12, s = hd & 3;
            const float* lp = LSE + (size_t)(t0 + tk) * 12 + s; l0_[j] = lp[0]; l1_[j] = lp[4]; l2_[j] = lp[8]; }
        u32x4 pv[16], ov[12];
#pragma unroll
        for (int j = 0; j < 16; ++j) { const int rr = 2 * j + (lane >> 5), ch = lane & 31; int tr = t0 - 8 + rr; tr = tr < b0 ? b0 : (tr > b0 + 2047 ? b0 + 2047 : tr);
            pv[j] = *(const u32x4*)(P + (size_t)tr * 256 + ch * 8); }
        const int chv[3] = {lane, lane < 32 ? lane + 64 : lane - 32, lane + 32}, tko[3] = {0, lane < 32 ? 0 : 1, 1};
#pragma unroll
        for (int it = 0; it < 12; ++it) { const int tk = 2 * (it / 3) + tko[it % 3], ch = chv[it % 3]; ov[it] = *(const u32x4*)(ORAW + (size_t)(t0 + tk) * 768 + ch * 8); }
#pragma unroll
        for (int j = 0; j < 3; ++j) { const int id = lane + 64 * j, hd = id % 12, g = hd >> 2; const float l0 = l0_[j], l1 = l1_[j], l2 = l2_[j];
            const float mx = fmaxf(l0, fmaxf(l1, l2)); const float e0 = __expf(l0 - mx), e1 = __expf(l1 - mx), e2 = __expf(l2 - mx);
            al[id] = (g == 0 ? e0 : (g == 1 ? e1 : e2)) / (e0 + e1 + e2); }
#pragma unroll
        for (int j = 0; j < 16; ++j) { const int rr = 2 * j + (lane >> 5), ch = lane & 31; *(LAS u32x4*)(pst + rr * PROW + ch * 16) = pv[j]; }
        asm volatile("s_waitcnt lgkmcnt(0)" ::: "memory");
        u32x4 ov2[12];
#pragma unroll
        for (int it = 0; it < 12; ++it) { const int tk = 2 * ((it + 12) / 3) + tko[it % 3], ch = chv[it % 3]; ov2[it] = *(const u32x4*)(ORAW + (size_t)(t0 + tk) * 768 + ch * 8); }
#pragma unroll
        for (int it = 0; it < 24; ++it) { const int tk = 2 * (it / 3) + tko[it % 3], ch = chv[it % 3], hd = ch >> 3;
            const u32x4 v = it < 12 ? ov[it < 12 ? it : 0] : ov2[it >= 12 ? it - 12 : 0]; const float alpha = al[tk * 12 + hd];
            float f[8]; unpack8(v, f); u32x4 o;
#pragma unroll
            for (int i = 0; i < 4; ++i) o[i] = pk2(f[2 * i] * alpha, f[2 * i + 1] * alpha);
            *(u32x4*)(MIXIN + (size_t)(t0 + tk) * D + 256 + ch * 8) = o; }
        asm volatile("s_waitcnt lgkmcnt(0)" ::: "memory");
        f32x4 acc[4][4];
#pragma unroll
        for (int gi = 0; gi < 4; ++gi) { const int hw = 1 << gi;
#pragma unroll
            for (int dt = 0; dt < 4; ++dt) acc[gi][dt] = (f32x4){0.f, 0.f, 0.f, 0.f};
#pragma unroll
            for (int kk = 0; kk < 2; ++kk) { const int cg = 64 * gi + 32 * kk + 8 * kq;
                float sum[8]; int cnt = 0;
#pragma unroll
                for (int i = 0; i < 8; ++i) sum[i] = 0.f;
#pragma unroll
                for (int dj = -hw; dj < hw; ++dj) { const int p2 = pos + dj; const bool ok = (p2 >= 0) && (p2 < 2048);
                    const u32x4 v = *(LAS const u32x4*)(pst + (ti + 8 + dj) * PROW + cg * 2); float f[8]; unpack8(v, f);
                    if (ok) {
#pragma unroll
                        for (int i = 0; i < 8; ++i) sum[i] += f[i];
                        ++cnt; } }
                const u32x4 ov = *(LAS const u32x4*)(pst + (ti + 8) * PROW + cg * 2); float own[8]; unpack8(ov, own);
                const float rc = 1.f / (float)cnt; u32x4 aw;
#pragma unroll
                for (int i = 0; i < 4; ++i) aw[i] = pk2(sum[2 * i] * rc - own[2 * i], sum[2 * i + 1] * rc - own[2 * i + 1]);
                const bf16x8 af = __builtin_bit_cast(bf16x8, aw);
#pragma unroll
                for (int dt = 0; dt < 4; ++dt) { const bf16x8 bfr = *(const bf16x8*)(WpT + gi * 4096 + (16 * dt + ti) * 64 + 32 * kk + 8 * kq);
                    acc[gi][dt] = __builtin_amdgcn_mfma_f32_16x16x32_bf16(af, bfr, acc[gi][dt], 0, 0, 0); } } }
        asm volatile("s_waitcnt lgkmcnt(0)" ::: "memory");
#pragma unroll
        for (int gi = 0; gi < 4; ++gi)
#pragma unroll
            for (int dt = 0; dt < 4; ++dt) { const int d = 64 * gi + 16 * dt + ti; const float sc = pool_scale[d];
#pragma unroll
                for (int rg = 0; rg < 4; ++rg) { const float fv = acc[gi][dt][rg]; *(LAS unsigned short*)(pst + (4 * kq + rg) * PROW + d * 2) = (unsigned short)f2bf(fv * sc); } }
        asm volatile("s_waitcnt lgkmcnt(0)" ::: "memory");
#pragma unroll
        for (int j = 0; j < 8; ++j) { const int rr = 2 * j + (lane >> 5), ch = lane & 31;
            const u32x4 v = *(LAS const u32x4*)(pst + rr * PROW + ch * 16); *(u32x4*)(MIXIN + (size_t)(t0 + rr) * D + ch * 8) = v; }
        asm volatile("s_waitcnt lgkmcnt(0)" ::: "memory");
    }
}
}
namespace peer {
typedef unsigned u32x4 __attribute__((ext_vector_type(4)));
typedef unsigned u32x2 __attribute__((ext_vector_type(2)));
typedef int i32x4 __attribute__((ext_vector_type(4)));
constexpr int TOK_PER_BLK = 128, TOK_PER_WAVE = 16;
constexpr int L_SRT = 0, L_IDX = 0, L_SVP = 32768, L_ZW = 65536, L_XS = 65536, L_TOK = 131072, L_SS = 132096, L_TMP = 136192, L_XSUM = 136256;
constexpr size_t SLICE_BYTES = (size_t)NEXP * 128;
__device__ __forceinline__ float gelu_erf(float v) { return 0.5f * v * (1.f + erff(v * 0.70710678118654752f)); }
__device__ __forceinline__ int lane_xor1(int v) { return __builtin_amdgcn_mov_dpp(v, 0xB1, 0xF, 0xF, true); }
__device__ __forceinline__ int lane_xor2(int v) { return __builtin_amdgcn_mov_dpp(v, 0x4E, 0xF, 0xF, true); }
__device__ __forceinline__ int lane_hmirror(int v) { return __builtin_amdgcn_mov_dpp(v, 0x141, 0xF, 0xF, true); }
__device__ __forceinline__ float bf_lo(unsigned w) { return __builtin_bit_cast(float, w << 16); }
__device__ __forceinline__ float bf_hi(unsigned w) { return __builtin_bit_cast(float, w & 0xffff0000u); }

__device__ __forceinline__ void gather_phase(const Args& a, LAS unsigned char* lds, int vcu, int G, int wave, int lane) {
    unsigned char* ws = a.ws; float* out = a.out;
    const unsigned char* U8 = ws + WS_U8; const unsigned char* V8 = ws + WS_V8;
    const float* SU = (const float*)(ws + WS_SU); const float* SV = (const float*)(ws + WS_SV);
    const unsigned short* IDX = (const unsigned short*)(ws + WS_IDX); const float* GATE = (const float*)(ws + WS_GATE);
    unsigned char* X8 = ws + WS_X8; const float* g_final = a.in[11];
    bf16* X2B = (bf16*)(ws + WS_XN);
    for (int tb = vcu; tb < M / TOK_PER_BLK; tb += G) {
        __syncthreads();
        const int T0 = tb * TOK_PER_BLK + wave * TOK_PER_WAVE, tl0 = wave * TOK_PER_WAVE;
        LAS unsigned short* idxl = (LAS unsigned short*)(lds + L_IDX) + tl0 * 128;
        LAS int* zw = (LAS int*)(lds + L_ZW) + tl0 * 128;
        LAS float* tokf = (LAS float*)(lds + L_TOK) + tl0 * 2;
        LAS float* ssl = (LAS float*)(lds + L_SS) + tl0 * 8;
        const int tid = wave * 64 + lane;
        const unsigned short* IDXb = IDX + (size_t)tb * TOK_PER_BLK * 128;
        u32x4 iv[4];
#pragma unroll
        for (int j = 0; j < 4; ++j) iv[j] = *(const u32x4*)(IDXb + 32 * tid + 8 * j);
        for (int tk4 = 0; tk4 < TOK_PER_WAVE; tk4 += 4) {
          u32x4 xbA[4], xbB[4];
#pragma unroll
          for (int u = 0; u < 4; ++u) { const int t = T0 + tk4 + u; xbA[u] = *(const u32x4*)(X2B + (size_t)t * D + 16 * lane); xbB[u] = *(const u32x4*)(X2B + (size_t)t * D + 16 * lane + 8); }
#pragma unroll
          for (int u = 0; u < 4; ++u) { const int tk = tk4 + u, t = T0 + tk;
            f32x4 x2[4]; float ss = 0.f, amax = 0.f;
            const u32x4 xb0 = xbA[u], xb1 = xbB[u];
#pragma unroll
            for (int j = 0; j < 4; ++j) { const unsigned w0 = (j < 2 ? xb0 : xb1)[2 * (j & 1)], w1 = (j < 2 ? xb0 : xb1)[2 * (j & 1) + 1];
                x2[j] = (f32x4){bf_lo(w0), bf_hi(w0), bf_lo(w1), bf_hi(w1)};
                ss += (x2[j].x * x2[j].x + x2[j].y * x2[j].y) + (x2[j].z * x2[j].z + x2[j].w * x2[j].w);
                amax = fmaxf(amax, fmaxf(fmaxf(fabsf(x2[j].x), fabsf(x2[j].y)), fmaxf(fabsf(x2[j].z), fabsf(x2[j].w)))); }
            ss = wave_sum(ss); amax = wave_max(amax);
            const float rstd = rsqrtf(ss * (1.f / D) + 1e-6f), clipx = fminf(amax, 2.7f * sqrtf(ss * (1.f / D))), inv = clipx > 0.f ? 7.f / clipx : 0.f, sx = clipx * (1.f / 7.f);
            unsigned wh[2] = {0u, 0u}; float xs_ = 0.f;
#pragma unroll
            for (int j = 0; j < 4; ++j) { const float f_[4] = {x2[j].x, x2[j].y, x2[j].z, x2[j].w};
#pragma unroll
                for (int c = 0; c < 4; ++c) { const float t_ = __builtin_amdgcn_fmed3f(fmaf(f_[c], inv, 12582912.f), 12582912.f - 7.f, 12582912.f + 7.f);
                    wh[j >> 1] |= (__builtin_bit_cast(unsigned, t_) & 15u) << (4 * (4 * (j & 1) + c)); } }
            (void)xs_;
            *(u32x2*)(X8 + (size_t)t * 512 + 128 * (lane >> 4) + 8 * (lane & 15)) = (u32x2){wh[0], wh[1]};
            if (lane < 8) ssl[tk * 8 + lane] = 0.f;
            if (lane == 0) { tokf[tk * 2] = sx * rstd; tokf[tk * 2 + 1] = 0.f; } } }
        asm volatile("s_waitcnt vmcnt(0) lgkmcnt(0)" ::: "memory");
        const unsigned rot = (unsigned)(vcu & 31) * 64u + (unsigned)(vcu >> 5) * 8u;
        LAS unsigned* cnt = (LAS unsigned*)(lds + L_ZW);
        LAS unsigned* srt = (LAS unsigned*)(lds + L_SRT);
        const unsigned char* X8b = X8 + (size_t)tb * TOK_PER_BLK * 512;
        {
            unsigned zz_ = 0u; asm volatile("" : "+v"(zz_));
#pragma unroll
            for (int j = 0; j < 4; ++j) *(LAS u32x4*)(lds + L_ZW + 8192 * j + 16 * tid) = (u32x4){zz_, zz_, zz_, zz_};
            __syncthreads();
            unsigned er[32];
#pragma unroll
            for (int j = 0; j < 32; ++j) { const unsigned w_ = iv[j >> 3][(j >> 1) & 3]; const unsigned e = (j & 1) ? (w_ >> 16) : (w_ & 0xffffu); const unsigned ek = (e + rot) & 0x3fffu, sh = (ek & 1u) << 4;
                const unsigned old = __hip_atomic_fetch_add(cnt + (ek >> 1), 1u << sh, __ATOMIC_RELAXED, __HIP_MEMORY_SCOPE_WORKGROUP);
                er[j] = e | (((old >> sh) & 0xffffu) << 14); }
            __syncthreads();
            u32x4 cw[4]; unsigned tot = 0;
#pragma unroll
            for (int j = 0; j < 4; ++j) { cw[j] = *(LAS const u32x4*)(lds + L_ZW + 64 * tid + 16 * j);
#pragma unroll
                for (int i = 0; i < 4; ++i) tot += (cw[j][i] & 0xffffu) + (cw[j][i] >> 16); }
            unsigned inc = tot;
#pragma unroll
            for (int d = 1; d < 64; d <<= 1) { const unsigned t_ = (unsigned)__shfl_up((int)inc, d, 64); if (lane >= d) inc += t_; }
            LAS unsigned* tmp = (LAS unsigned*)(lds + L_TMP);
            if (lane == 63) tmp[wave] = inc;
            __syncthreads();
            unsigned run = inc - tot;
#pragma unroll
            for (int w_ = 0; w_ < 8; ++w_) { const unsigned t_ = tmp[w_]; if (w_ < wave) run += t_; }
#pragma unroll
            for (int j = 0; j < 4; ++j) {
#pragma unroll
                for (int i = 0; i < 4; ++i) { const unsigned w_ = cw[j][i]; const unsigned lo_ = run; run += w_ & 0xffffu; const unsigned hi_ = run; run += w_ >> 16; cw[j][i] = lo_ | (hi_ << 16); }
                *(LAS u32x4*)(lds + L_ZW + 64 * tid + 16 * j) = cw[j]; }
            __syncthreads();
#pragma unroll
            for (int j = 0; j < 32; ++j) { const unsigned e = er[j] & 0x3fffu, rank = er[j] >> 14, ek = (e + rot) & 0x3fffu; const unsigned w_ = cnt[ek >> 1]; const unsigned off = (w_ >> ((ek & 1u) << 4)) & 0xffffu;
                srt[off + rank] = (e << 14) | (unsigned)(32 * tid + j); }
            __syncthreads();
        }
        { const int g = lane >> 3, i8 = lane & 7;
#define PEER_ULOAD(buf, s, ea_, eb_) do { const unsigned char* Us_ = U8 + (size_t)(s) * SLICE_BYTES;     \
            _Pragma("unroll") for (int it = 0; it < 8; ++it) { const unsigned en_ = it < 4 ? ea_[it] : eb_[it - 4]; buf[it] = *(const u32x4*)(Us_ + (((en_ >> 7) & 0x1fff80u) | lo16u)); } } while (0)
#define PEER_SLOT(BL, sl, vl, BC, sc, vc) do { const u32x4 ean_ = *(LAS const u32x4*)(srt_g + (vl) * 256), ebn_ = *(LAS const u32x4*)(srt_g + (vl) * 256 + 16); \
            const unsigned xs_ = xbase | ((unsigned)(sc) * 16384u); u32x4 xv[8]; int d_[8], a_[4], b_[2];        \
            _Pragma("unroll") for (int it = 0; it < 8; ++it) { const unsigned en_ = it < 4 ? eac[it] : ebc[it - 4]; xv[it] = *(LAS const u32x4*)(xs_ | (en_ & 0x3f80u)); } \
            PEER_ULOAD(BL, sl, ean_, ebn_); \
            _Pragma("unroll") for (int it = 0; it < 8; ++it) { \
                int ah = __builtin_amdgcn_sdot8((int)BC[it].x, (int)xv[it].x, 0, false); ah = __builtin_amdgcn_sdot8((int)BC[it].y, (int)xv[it].y, ah, false); \
                ah = __builtin_amdgcn_sdot8((int)BC[it].z, (int)xv[it].z, ah, false); d_[it] = __builtin_amdgcn_sdot8((int)BC[it].w, (int)xv[it].w, ah, false); } \
              \
              \
            _Pragma("unroll") for (int p = 0; p < 4; ++p) { const int keep = q2 ? d_[4 + p] : d_[p], send = q2 ? d_[p] : d_[4 + p]; a_[p] = keep + lane_hmirror(send); } \
            _Pragma("unroll") for (int p = 0; p < 2; ++p) { const int keep = q0 ? a_[2 * p + 1] : a_[2 * p], send = q0 ? a_[2 * p] : a_[2 * p + 1]; b_[p] = keep + lane_xor1(send); } \
            { const int keep = q1 ? b_[1] : b_[0], send = q1 ? b_[0] : b_[1]; zreg[vc] += keep + lane_xor2(send); } \
            eac = ean_; ebc = ebn_; } while (0)
        {   const bool q0 = lane & 1, q1 = lane & 2, q2 = lane & 4; const unsigned lo16u = (unsigned)i8 << 4;
            LAS const unsigned char* srt_g = lds + L_SRT + (wave * 2048 + 8 * g) * 4;
            const unsigned xbase = (unsigned)(size_t)(lds + L_XS) | lo16u;
            int lane_b = lane; asm volatile("" : "+v"(lane_b));
            const unsigned char* xsrc = X8b + (size_t)(tl0 + (lane_b >> 3)) * 512 + 16 * (lane_b & 7);
#define PEER_XSTAGE(s, b) do { _Pragma("unroll") for (int i_ = 0; i_ < 2; ++i_) \
                __builtin_amdgcn_global_load_lds((const GAS unsigned*)(xsrc + (size_t)(8 * i_) * 512 + 128 * (s)), (LAS unsigned*)(lds + L_XS + (b) * 16384 + (tl0 + 8 * i_) * 128), 16, 0, 0); } while (0)
            PEER_XSTAGE(0, 0); PEER_XSTAGE(1, 1); PEER_XSTAGE(2, 2); PEER_XSTAGE(3, 3);
            int zreg[32];
#pragma unroll
            for (int vp = 0; vp < 32; ++vp) zreg[vp] = 0;
            u32x4 u0[8], u1[8];
            u32x4 eac = *(LAS const u32x4*)srt_g, ebc = *(LAS const u32x4*)(srt_g + 16);
            PEER_ULOAD(u0, 0, eac, ebc);
            asm volatile("s_waitcnt vmcnt(0) lgkmcnt(0)\n\ts_barrier" ::: "memory");
            for (int s = 0; s < 4; ++s) {
                const int sn = s + 1 < 4 ? s + 1 : 3;
#pragma unroll
                for (int vp = 0; vp < 32; vp += 2) {
                    PEER_SLOT(u1, s, vp + 1, u0, s, vp);
                    if (vp + 2 < 32) PEER_SLOT(u0, s, vp + 2, u1, s, vp + 1); else PEER_SLOT(u0, sn, 0, u1, s, vp + 1);
                }
                asm volatile("" ::: "memory");
            }
            unsigned pr_[32]; unsigned svh_[16];
#pragma unroll
            for (int c8 = 0; c8 < 32; c8 += 16) { unsigned en_[16], sp_[16];
#pragma unroll
                for (int i = 0; i < 16; ++i) { en_[i] = *(LAS const unsigned*)(lds + L_SRT + (wave * 2048 + 64 * (c8 + i) + lane) * 4); const unsigned e = en_[i] >> 14;
                    sp_[i] = ((const unsigned*)SU)[e]; }
#pragma unroll
                for (int i = 0; i < 16; ++i) { const int vp = c8 + i; pr_[vp] = en_[i] & 0x3fffu;
                    const float zf = (float)zreg[vp] * __builtin_bit_cast(float, sp_[i] & 0xffff0000u);
                    zreg[vp] = __builtin_bit_cast(int, zf);
                    const unsigned h_ = sp_[i] & 0xffffu;
                    if (i & 1) svh_[vp >> 1] |= h_ << 16; else svh_[vp >> 1] = h_; } }
            asm volatile("s_waitcnt lgkmcnt(0)\n\ts_barrier" ::: "memory");
#pragma unroll
            for (int vp = 0; vp < 32; ++vp) { ((LAS int*)(lds + L_ZW))[pr_[vp]] = zreg[vp];
                ((LAS unsigned short*)(lds + L_SVP))[pr_[vp]] = (unsigned short)((vp & 1) ? (svh_[vp >> 1] >> 16) : (svh_[vp >> 1] & 0xffffu)); }
            asm volatile("s_waitcnt lgkmcnt(0)\n\ts_barrier" ::: "memory");
            {   u32x4 iv[4];
#pragma unroll
                for (int j = 0; j < 4; ++j) iv[j] = *(const u32x4*)(IDXb + (size_t)tl0 * 128 + 32 * lane + 8 * j);
#pragma unroll
                for (int j = 0; j < 4; ++j) *(LAS u32x4*)((LAS unsigned char*)idxl + 64 * lane + 16 * j) = iv[j]; }
        }
#undef PEER_ULOAD
#undef PEER_SLOT
#undef PEER_XSTAGE
        }
        asm volatile("s_waitcnt lgkmcnt(0)" ::: "memory");
        float gt_[TOK_PER_WAVE][2];
#pragma unroll
        for (int tk = 0; tk < TOK_PER_WAVE; ++tk) { gt_[tk][0] = GATE[(size_t)(T0 + tk) * 128 + lane]; gt_[tk][1] = GATE[(size_t)(T0 + tk) * 128 + 64 + lane]; }
#pragma unroll
        for (int tk = 0; tk < TOK_PER_WAVE; ++tk) { const float cs = tokf[tk * 2];
            float w[2];
#pragma unroll
            for (int hf = 0; hf < 2; ++hf) { const int k = lane + 64 * hf;
                const float z = __builtin_bit_cast(float, zw[tk * 128 + k]) * cs;
                const float sv = (float)__builtin_bit_cast(_Float16, ((LAS const unsigned short*)(lds + L_SVP))[(tl0 + tk) * 128 + k]);
                w[hf] = gt_[tk][hf] * gelu_erf(z) * sv; }
            const float wm = wave_max(fmaxf(fabsf(w[0]), fabsf(w[1]))), winv = wm > 0.f ? 127.f / wm : 0.f;
            asm volatile("s_waitcnt lgkmcnt(0)" ::: "memory");
            LAS signed char* wpb = (LAS signed char*)(zw + tk * 128);
            const float wq0 = rintf(w[0] * winv), wq1 = rintf(w[1] * winv);
            wpb[lane] = (signed char)(int)wq0; wpb[64 + lane] = (signed char)(int)wq1;
            const float wsum_ = wave_sum(wq0 + wq1);
            if (lane == 0) { tokf[tk * 2 + 1] = wm * (1.f / 127.f); ((LAS float*)(lds + L_XSUM))[tl0 + tk] = wsum_; } }
        asm volatile("s_waitcnt lgkmcnt(0)" ::: "memory");
        {   int lane_d = lane; asm volatile("" : "+v"(lane_d));
            const int g = lane_d >> 3, i8 = lane_d & 7; const unsigned lo16 = (unsigned)i8 << 4;
#define PEER_DLOAD(QB, WP, qi) do { const int s_ = (qi) >> 6, tok_ = 8 * (((qi) >> 5) & 1) + g, q_ = (qi) & 31; \
            const u32x2 id_ = *(LAS const u32x2*)(idxl + tok_ * 128 + 4 * q_); WP = zw[tok_ * 128 + q_]; const unsigned char* Vs_ = V8 + (size_t)s_ * SLICE_BYTES; \
            QB[0] = *(const u32x4*)(Vs_ + (((id_.x << 7) & 0x7fff80u) | lo16)); QB[1] = *(const u32x4*)(Vs_ + (((id_.x >> 9) & 0x7fff80u) | lo16)); \
            QB[2] = *(const u32x4*)(Vs_ + (((id_.y << 7) & 0x7fff80u) | lo16)); QB[3] = *(const u32x4*)(Vs_ + (((id_.y >> 9) & 0x7fff80u) | lo16)); } while (0)
#define PEER_DACC(QB, WP) do { \
            _Pragma("unroll") for (int m = 0; m < 4; ++m) { const int A_ = (int)__builtin_amdgcn_perm(0u, (unsigned)(WP), selm[m]);        \
                _Pragma("unroll") for (int j = 0; j < 4; ++j) { const int wv_ = (int)QB[m][j]; accr[j] = __builtin_amdgcn_mfma_i32_4x4x4i8(A_, wv_, accr[j], 0, 0, 0); \
                    acch[j] = __builtin_amdgcn_mfma_i32_4x4x4i8(A_, wv_ & (int)0xf0f0f0f0u, acch[j], 0, 0, 0); } } } while (0)
#define PEER_DX2(qi) do { const int s_ = (qi) >> 6, tok_ = 8 * (((qi) >> 5) & 1) + g; const bf16* xp_ = X2B + (size_t)(T0 + tok_) * D + 256 * s_ + 32 * i8; \
            _Pragma("unroll") for (int j = 0; j < 4; ++j) x2v[j] = *(const u32x4*)(xp_ + 8 * j); } while (0)
#define PEER_DFIN(qi) do { const int s_ = (qi) >> 6, tok_ = 8 * (((qi) >> 5) & 1) + g; const float wsc = tokf[tok_ * 2 + 1], wsc16 = wsc * 0.0625f; const int ws8 = 8 * (int)((LAS const float*)(lds + L_XSUM))[tl0 + tok_]; \
            float ssq = 0.f; bf16* xp_ = X2B + (size_t)(T0 + tok_) * D + 256 * s_ + 32 * i8; \
            _Pragma("unroll") for (int j = 0; j < 4; ++j) { u32x4 o_; \
                _Pragma("unroll") for (int i = 0; i < 4; ++i) { const unsigned w_ = x2v[j][i];        \
                    const float f0 = bf_lo(w_) + (float)(accr[j][i] - acch[j][i] - ws8) * wsc, f1 = bf_hi(w_) + (float)acch[j][i] * wsc16; ssq += f0 * f0 + f1 * f1; o_[i] = pk2(f0, f1); } \
                *(u32x4*)(xp_ + 8 * j) = o_; } \
            __hip_atomic_fetch_add(ssl + tok_ * 8 + i8, ssq, __ATOMIC_RELAXED, __HIP_MEMORY_SCOPE_WORKGROUP); } while (0)
            u32x4 q0[4], q1[4], q2[4], q3[4], q4[4], q5[4], q6[4], q7[4], x2v[4]; int w0, w1, w2, w3, w4, w5, w6, w7; i32x4 accr[4], acch[4];
            unsigned selm[4];
#pragma unroll
            for (int m = 0; m < 4; ++m) selm[m] = (0x0c0c0c0cu & ~(0xffu << (8 * (lane_d & 3)))) | ((unsigned)m << (8 * (lane_d & 3)));
            PEER_DLOAD(q0, w0, 0); PEER_DLOAD(q1, w1, 1); PEER_DLOAD(q2, w2, 2); PEER_DLOAD(q3, w3, 3); PEER_DLOAD(q4, w4, 4); PEER_DLOAD(q5, w5, 5); PEER_DLOAD(q6, w6, 6);
            for (int i = 0; i < 256 / 8 - 1; ++i) {
                const int qi = 8 * i;
                if ((i & 3) == 0) {
#pragma unroll
                    for (int c = 0; c < 4; ++c) { accr[c] = (i32x4){0, 0, 0, 0}; acch[c] = (i32x4){0, 0, 0, 0}; } }
                if ((i & 3) == 3) PEER_DX2(qi);
                PEER_DLOAD(q7, w7, qi + 7); PEER_DACC(q0, w0); PEER_DLOAD(q0, w0, qi + 8); PEER_DACC(q1, w1); PEER_DLOAD(q1, w1, qi + 9); PEER_DACC(q2, w2); PEER_DLOAD(q2, w2, qi + 10); PEER_DACC(q3, w3); PEER_DLOAD(q3, w3, qi + 11); PEER_DACC(q4, w4); PEER_DLOAD(q4, w4, qi + 12); PEER_DACC(q5, w5); PEER_DLOAD(q5, w5, qi + 13); PEER_DACC(q6, w6); PEER_DLOAD(q6, w6, qi + 14); PEER_DACC(q7, w7);
                if ((i & 3) == 3) PEER_DFIN(qi);
            }
            PEER_DX2(248); PEER_DLOAD(q7, w7, 255); PEER_DACC(q0, w0); PEER_DACC(q1, w1); PEER_DACC(q2, w2); PEER_DACC(q3, w3); PEER_DACC(q4, w4); PEER_DACC(q5, w5); PEER_DACC(q6, w6); PEER_DACC(q7, w7); PEER_DFIN(248);
#undef PEER_DLOAD
#undef PEER_DACC
#undef PEER_DX2
#undef PEER_DFIN
#undef PEER_DSTEP
        }
        asm volatile("s_waitcnt vmcnt(0) lgkmcnt(0)" ::: "memory");
        {   f32x4 gg[4];
#pragma unroll
            for (int j = 0; j < 4; ++j) gg[j] = ((const f32x4*)g_final)[lane + 64 * j];
            for (int tk4 = 0; tk4 < TOK_PER_WAVE; tk4 += 4) { u32x2 xb[4][4];
#pragma unroll
                for (int u = 0; u < 4; ++u)
#pragma unroll
                    for (int j = 0; j < 4; ++j) xb[u][j] = *(const u32x2*)(X2B + (size_t)(T0 + tk4 + u) * D + 4 * (lane + 64 * j));
#pragma unroll
                for (int u = 0; u < 4; ++u) { const int tk = tk4 + u, t = T0 + tk;
                    float sq = ssl[tk * 8 + (lane & 7)]; sq += dpp_mov<0xB1>(sq); sq += dpp_mov<0x4E>(sq); sq += dpp_mov<0x141>(sq);
                    const float r3 = rsqrtf(sq * (1.f / D) + 1e-6f);
#pragma unroll
                    for (int j = 0; j < 4; ++j) { const u32x2 w_ = xb[u][j]; const f32x4 x3 = (f32x4){bf_lo(w_.x), bf_hi(w_.x), bf_lo(w_.y), bf_hi(w_.y)};
                        *((f32x4*)(out + (size_t)t * D) + lane + 64 * j) = x3 * gg[j] * r3; } } } }
    }
}
}
namespace topk {
typedef short bf16x8 __attribute__((ext_vector_type(8)));
typedef float f32x16 __attribute__((ext_vector_type(16)));
typedef unsigned u32x4 __attribute__((ext_vector_type(4)));
constexpr int SKROW = 272;
__device__ __forceinline__ float fmax_(float a, float b) { float t; asm("v_max_f32 %0, %1, %2" : "=v"(t) : "v"(a), "v"(b)); return t; }
__device__ __forceinline__ void cswap(float& a, float& b) { float t, u; asm("v_max_f32 %0, %1, %2" : "=v"(t) : "v"(a), "v"(b)); asm("v_min_f32 %0, %1, %2" : "=v"(u) : "v"(a), "v"(b)); a = t; b = u; }
__device__ __forceinline__ void merge16(float (&c)[16]) {
#pragma unroll
    for (int j = 8; j > 0; j >>= 1)
#pragma unroll
        for (int i = 0; i < 16; ++i) { const int l = i ^ j; if (l > i) cswap(c[i], c[l]); }
}
__device__ __forceinline__ void sort16(float (&v)[16]) {
    constexpr int SA[60] = {0,1,2,3,4,5,7,9, 0,1,2,3,6,8,10,11, 0,2,4,6,7,10,12,14, 0,1,4,5,6,8,12,13, 1,3,4,5,8,9,13, 1,2,5,7,9,11, 2,3,9,11, 3,6,7,10, 3,5,7,9,11, 6,8};
    constexpr int SB[60] = {13,12,15,14,8,6,11,10, 5,7,9,4,13,14,15,12, 1,3,5,8,9,11,13,15, 2,3,10,11,7,9,14,15, 2,12,6,7,10,11,14, 4,6,8,10,13,14, 4,6,12,13, 5,8,9,12, 4,6,8,10,12, 7,9};
#pragma unroll
    for (int i = 0; i < 60; ++i) cswap(v[SA[i]], v[SB[i]]);
}
__device__ __forceinline__ void topmerge(float (&a)[16], const float (&b)[16]) {
#pragma unroll
    for (int i = 0; i < 16; ++i) a[i] = fmax_(a[i], b[15 - i]);
    merge16(a);
}
__device__ __forceinline__ void insert16(float (&a)[16], float x) {
#pragma unroll
    for (int i = 0; i < 16; ++i) cswap(a[i], x);
}
__device__ __forceinline__ float cand(float a, float b, unsigned ca, unsigned cb) { return __builtin_bit_cast(float, (__builtin_bit_cast(unsigned, a + b) & ~0x3fffu) | ca | cb); }

__device__ __forceinline__ void qhalf_load(u32x4 (&q)[8], const bf16* QPw, int lane) {
#pragma unroll
    for (int j = 0; j < 8; ++j) q[j] = *(const u32x4*)(QPw + (size_t)(4 * j + (lane >> 4)) * NQ + (lane & 15) * 8);
}
__device__ __forceinline__ void qhalf_stage(const u32x4 (&q)[8], LAS unsigned char* qst, int lane) {
#pragma unroll
    for (int j = 0; j < 8; ++j) *(LAS u32x4*)(qst + (4 * j + (lane >> 4)) * SKROW + (lane & 15) * 16) = q[j];
}
__device__ __forceinline__ void half_top16(float (&e)[16], LAS const unsigned char* qst, LAS const unsigned char* sk, int ql, int hh) {
    unsigned qoff = (unsigned)(ql * SKROW + hh * 16);
    float m0[16], m1[16];
#pragma unroll
    for (int kt = 0; kt < 4; ++kt) { f32x16 acc = {}; float v[16];
        asm volatile("" : "+v"(qoff));
#pragma unroll
        for (int ks = 0; ks < 8; ++ks) { const bf16x8 af = *(LAS const bf16x8*)(sk + (32 * kt + ql) * SKROW + ks * 32 + hh * 16);
            const bf16x8 bfr = *(LAS const bf16x8*)(qst + qoff + ks * 32);
            acc = __builtin_amdgcn_mfma_f32_32x32x16_bf16(af, bfr, acc, 0, 0, 0); }
#pragma unroll
        for (int rr = 0; rr < 16; ++rr) { const unsigned key = (unsigned)(32 * kt + (rr & 3) + 8 * (rr >> 2)) + 4u * (unsigned)hh;
            const float fv = acc[rr];
            v[rr] = __builtin_bit_cast(float, (__builtin_bit_cast(unsigned, fv) & ~0x7fu) | key); }
        sort16(v);
        if (kt == 0) {
#pragma unroll
            for (int i = 0; i < 16; ++i) m0[i] = v[i]; }
        else if (kt == 1) topmerge(m0, v);
        else if (kt == 2) {
#pragma unroll
            for (int i = 0; i < 16; ++i) m1[i] = v[i]; }
        else topmerge(m1, v); }
    topmerge(m0, m1);
#pragma unroll
    for (int i = 0; i < 16; ++i) { const unsigned x = __builtin_bit_cast(unsigned, m0[15 - i]);
        const auto rr = __builtin_amdgcn_permlane32_swap(x, x, false, false);
        const unsigned lo_ = rr[0], hi_ = rr[1];
        e[i] = fmax_(m0[i], __builtin_bit_cast(float, hh ? lo_ : hi_)); }
    merge16(e);
}

__device__ __forceinline__ void topk_phase(const Args& a, LAS unsigned char* lds, int bx, int G, int tid) {
    unsigned char* ws = a.ws;
    const int lane = tid & 63, wave = __builtin_amdgcn_readfirstlane(tid >> 6);
    const bf16* QP = (const bf16*)(ws + WS_QP); const bf16* SK = (const bf16*)(ws + WS_SK);
    unsigned short* IDX = (unsigned short*)(ws + WS_IDX); float* GATE = (float*)(ws + WS_GATE);
    const float* pu = a.in[9]; const float* pv = a.in[10]; const float* g_ffn = a.in[6];
    unsigned char* U4 = ws + WS_U8; signed char* V8 = (signed char*)(ws + WS_V8); float* SU = (float*)(ws + WS_SU); float* SV = (float*)(ws + WS_SV); float* USUM = (float*)(ws + WS_USUM);
    pg8::StaticOrder So; So.init(M, NQ, G, bx); pg8::Unit un;
    int h_staged = -1;
    int nun = 0; while (So.next(nun, un)) ++nun;
    const int ne = (nun + 1) >> 1;
    LAS unsigned char* qst = lds + 256 * SKROW + wave * (32 * SKROW);
    u32x4 qa[8], qb[8];
    if (nun > 0) { So.next(0, un); qhalf_load(qa, QP + (size_t)(256 * un.pm + 32 * wave) * NQ + un.pn * 256, lane); }
    for (int uo = 0; uo < nun; ++uo) {
        const int ui = uo < ne ? 2 * uo : 2 * (uo - ne) + 1; So.next(ui, un);
        const int h = un.pn, tt = un.pm;
        int lane_ = lane; asm volatile("" : "+v"(lane_));
        const int ql = lane_ & 31, hh = lane_ >> 5, tid_ = wave * 64 + lane_;
        const int er0 = ((ui * G + bx) * 8 + wave) * 2;
        if (h != h_staged) {
            __syncthreads();
#pragma unroll
            for (int j = 0; j < 8; ++j) { const int id = tid_ + 512 * j, row = id >> 4, ch = id & 15;
                const u32x4 v = *(const u32x4*)(SK + ((size_t)h * 256 + row) * 128 + ch * 8); *(LAS u32x4*)(lds + row * SKROW + ch * 16) = v; }
            __syncthreads(); h_staged = h;
        }
        const int t = 256 * tt + 32 * wave + ql;
        const bf16* QPw = QP + (size_t)(256 * tt + 32 * wave) * NQ + h * 256;
        float A[16], B[16];
        f32x4 rw[4];
        qhalf_stage(qa, qst, lane_);
        qhalf_load(qb, QPw + 128, lane_);
        quant_row_load(pu + (size_t)er0 * D, rw, lane_);
        half_top16(A, qst, lds, ql, hh);
        quant_row_finish_u4(rw, g_ffn, U4 + (size_t)er0 * 128, SU + er0, USUM + er0, lane_);
        qhalf_stage(qb, qst, lane_);
        if (uo + 1 < nun) { const int un_ = uo + 1, ui2 = un_ < ne ? 2 * un_ : 2 * (un_ - ne) + 1; pg8::Unit u2; So.next(ui2, u2);
            qhalf_load(qa, QP + (size_t)(256 * u2.pm + 32 * wave) * NQ + u2.pn * 256, lane_); }
        quant_row_load(pv + (size_t)er0 * D, rw, lane_);
        half_top16(B, qst, lds + 128 * SKROW, ql, hh);
        quant_row_finish_v4(rw, (unsigned char*)V8 + (size_t)er0 * 128, SU + er0, lane_);
        f32x4 rw2[4];
        quant_row_load(pu + (size_t)(er0 + 1) * D, rw, lane_); quant_row_load(pv + (size_t)(er0 + 1) * D, rw2, lane_);
        unsigned ca[16], cb[16];
#pragma unroll
        for (int i = 0; i < 16; ++i) { ca[i] = (__builtin_bit_cast(unsigned, A[i]) & 0x7fu) << 7; cb[i] = __builtin_bit_cast(unsigned, B[i]) & 0x7fu; }
        float X0[16], X1[16], X2[16];
#pragma unroll
        for (int j = 0; j < 16; ++j) X0[j] = cand(A[0], B[j], ca[0], cb[j]);
#pragma unroll
        for (int j = 0; j < 8; ++j) X1[j] = cand(A[1], B[j], ca[1], cb[j]);
#pragma unroll
        for (int j = 0; j < 5; ++j) X1[8 + j] = cand(A[2], B[j], ca[2], cb[j]);
#pragma unroll
        for (int j = 0; j < 3; ++j) X1[13 + j] = cand(A[4], B[j], ca[4], cb[j]);
#pragma unroll
        for (int j = 0; j < 4; ++j) X2[j] = cand(A[3], B[j], ca[3], cb[j]);
#pragma unroll
        for (int i = 5; i < 8; ++i)
#pragma unroll
            for (int j = 0; j < 2; ++j) X2[4 + 2 * (i - 5) + j] = cand(A[i], B[j], ca[i], cb[j]);
#pragma unroll
        for (int i = 8; i < 14; ++i) X2[10 + (i - 8)] = cand(A[i], B[0], ca[i], cb[0]);
        const float x14 = cand(A[14], B[0], ca[14], cb[0]), x15 = cand(A[15], B[0], ca[15], cb[0]);
        sort16(X1); sort16(X2);
        topmerge(X1, X2); topmerge(X0, X1); insert16(X0, x14); insert16(X0, x15);
        float sc[16]; float den = 0.f;
#pragma unroll
        for (int i = 0; i < 16; ++i) { sc[i] = __builtin_bit_cast(float, __builtin_bit_cast(unsigned, X0[i]) & ~0x3fffu); }
        const float m0 = sc[0];
#pragma unroll
        for (int i = 0; i < 16; ++i) { sc[i] = __expf(sc[i] - m0); den += sc[i]; }
        const float rd = 1.f / den;
        if (hh == 0) { u32x4 w0, w1;
#pragma unroll
            for (int i = 0; i < 4; ++i) { w0[i] = (__builtin_bit_cast(unsigned, X0[2 * i]) & 0x3fffu) | ((__builtin_bit_cast(unsigned, X0[2 * i + 1]) & 0x3fffu) << 16);
                w1[i] = (__builtin_bit_cast(unsigned, X0[8 + 2 * i]) & 0x3fffu) | ((__builtin_bit_cast(unsigned, X0[8 + 2 * i + 1]) & 0x3fffu) << 16); }
            u32x4* ip = (u32x4*)(IDX + (size_t)t * 128 + h * 16); ip[0] = w0; ip[1] = w1;
        } else { f32x4* gp = (f32x4*)(GATE + (size_t)t * 128 + h * 16);
#pragma unroll
            for (int i = 0; i < 4; ++i) gp[i] = (f32x4){sc[4 * i] * rd, sc[4 * i + 1] * rd, sc[4 * i + 2] * rd, sc[4 * i + 3] * rd}; }
        quant_row_finish_u4(rw, g_ffn, U4 + (size_t)(er0 + 1) * 128, SU + er0 + 1, USUM + er0 + 1, lane_); quant_row_finish_v4(rw2, (unsigned char*)V8 + (size_t)(er0 + 1) * 128, SU + er0 + 1, lane_);
    }
    __syncthreads();
}
}
__global__ void __launch_bounds__(NWAVES * 64, 2) mega_fwd(Args a) {
    extern __shared__ __attribute__((aligned(16))) unsigned char lds_raw[];
    LAS unsigned char* lds = (LAS unsigned char*)lds_raw;
    volatile LAS unsigned* MISC = (volatile LAS unsigned*)(lds + MISC_OFF);
    const int wave = __builtin_amdgcn_readfirstlane((int)threadIdx.x >> 6);
#define TID_NOW (wave * 64 + lane_now())
    const int G = gridDim.x, bx = blockIdx.x, vcu = (G % 8 == 0) ? (bx % 8) * (G / 8) + bx / 8 : bx;
    unsigned char* ws = a.ws;
    if (threadIdx.x < 32) ((LAS unsigned*)(lds + LDSCTL_OFF))[threadIdx.x] = 0u;
    __syncthreads();
    XcdBarrier bar = xcd_barrier_post((unsigned*)(ws + WS_CTL) + CW_BAR + a.li * XCD_BAR_WORDS, MISC + 8);
    const int lo = a.ph_lo, hi = a.ph_hi;
#define IN(k) (lo <= (k) && (k) < hi)
#define BOTH(k) (IN(k) && IN((k) + 1))
    if (IN(0)) { p0_prologue(a, lds, vcu * NWAVES + wave, G * NWAVES, wave, lane_now()); if (BOTH(0)) xcd_barrier(bar, wave); }
    if (IN(1)) {
        pg8::Gemm g{(const bf16*)(ws + WS_XN8), (const bf16*)(ws + WS_WIN), M, NPROJ, D / 2}; pg8::StaticOrder So; So.init(M, NPROJ, G, bx);
        pg8::EpiInProj E{(bf16*)(ws + WS_P), (bf16*)(ws + WS_Q), (size_t)(WS_K - WS_Q) / 2, (const float*)(ws + WS_SA), (const float*)(ws + WS_SWIN)};
        pg8::gemm_phase<pg8::EpiInProj, pg8::StaticOrder, true, true, true>(lds, g, So, E, wave);
        if (BOTH(1)) xcd_barrier(bar, wave);
    }
    if (IN(2)) { attn::attn_phase(ws, lds, vcu, G, TID_NOW); if (BOTH(2)) xcd_barrier(bar, wave); }
    if (IN(3)) { mixp::mix_phase(a, lds, vcu * NWAVES + wave, G * NWAVES, wave, lane_now()); if (BOTH(3)) xcd_barrier(bar, wave); }
    if (IN(4)) {
        pg8::Gemm g{(const bf16*)(ws + WS_MIXIN), (const bf16*)(ws + WS_WOUT), M, D, D}; pg8::StaticOrder So; So.init(M, D, G, bx);
        pg8::EpiOutProj E{(const signed char*)(ws + WS_XN8), (const float*)(ws + WS_XS), (bf16*)(ws + WS_XN), (float*)(ws + WS_ROWSS)};
        pg8::gemm_phase<pg8::EpiOutProj, pg8::StaticOrder, true, true>(lds, g, So, E, wave);
        if (BOTH(4)) xcd_barrier(bar, wave);
    }
    if (IN(5)) {
        pg8::Gemm g{(const bf16*)(ws + WS_XN), (const bf16*)(ws + WS_WQ), M, NQ, D}; pg8::StaticOrder So; So.init(M, NQ, G, bx);
        pg8::EpiPeerQ E{(bf16*)(ws + WS_QP), (const float*)(ws + WS_ROWSS)};
        pg8::gemm_phase<pg8::EpiPeerQ, pg8::StaticOrder, true, true>(lds, g, So, E, wave);
    }
    if (IN(6)) { topk::topk_phase(a, lds, bx, G, TID_NOW); if (BOTH(6)) xcd_barrier(bar, wave); }
    if (IN(7)) { peer::gather_phase(a, lds, vcu, G, wave, lane_now()); }
#undef IN
#undef BOTH
#undef TID_NOW
}
extern "C" void kernel_launch(void* const* d_in, const int* in_sizes, int n_in, void* d_out, int out_size, void* d_ws, size_t ws_size, hipStream_t stream) {
    static int grid = 0;
    if (grid == 0) {
        if (n_in != 12 || in_sizes[0] != M * D || out_size != M * D || ws_size < WS_END) { fprintf(stderr, "kernel_launch: unexpected shapes (n_in %d, in0 %d, out %d, ws %zu)\n", n_in, n_in > 0 ? in_sizes[0] : -1, out_size, ws_size); grid = -1; return; }
        int dev = 0, cus = 0, per_cu = 0;
        if (hipGetDevice(&dev) != hipSuccess || hipDeviceGetAttribute(&cus, hipDeviceAttributeMultiprocessorCount, dev) != hipSuccess) { fprintf(stderr, "kernel_launch: device query failed\n"); grid = -1; return; }
        if (hipFuncSetAttribute((const void*)mega_fwd, hipFuncAttributeMaxDynamicSharedMemorySize, LDS_BYTES) != hipSuccess) { fprintf(stderr, "kernel_launch: hipFuncSetAttribute failed\n"); grid = -1; return; }
        if (hipOccupancyMaxActiveBlocksPerMultiprocessor(&per_cu, (const void*)mega_fwd, NWAVES * 64, LDS_BYTES) != hipSuccess || per_cu < 1) { fprintf(stderr, "kernel_launch: occupancy query says %d blocks per CU\n", per_cu); grid = -1; (void)hipGetLastError(); return; }
        grid = cus;
    }
    if (grid < 0) return;
    (void)hipMemsetAsync((char*)d_ws + WS_CTL + CW_BAR * 4, 0, (CW_END - CW_BAR) * 4, stream);
    Args a{};
    for (int i = 0; i < 12; ++i) a.in[i] = (const float*)d_in[i];
    a.out = (float*)d_out; a.ws = (unsigned char*)d_ws; a.ph_lo = 0; a.ph_hi = 8; a.li = 0;
    hipLaunchKernelGGL(mega_fwd, dim3(grid), dim3(NWAVES * 64), LDS_BYTES, stream, a);
#ifdef PROBE_LO
    a.ph_lo = PROBE_LO; a.ph_hi = PROBE_HI; a.li = 1;
    hipLaunchKernelGGL(mega_fwd, dim3(grid), dim3(NWAVES * 64), LDS_BYTES, stream, a);
#endif
}
```
